# Optimizing an MI355X kernel written in HIP

```python
import math
import jax
import jax.numpy as jnp
from jax import lax
import numpy as np

D_MODEL = 2048
BATCH = 2
SEQ = 4096
DEPTH = 1
DEC_BATCH = 32
DEC_SEQ = 8
PAST_LEN = 8192
PAGE_SIZE = 128

H_A = 8
DK_A = 128
DV_A = 128
HGRN_CHUNK = 64
H_B = 8
KV_B = 2
G_B = H_B // KV_B
HD_B = 128
CMP_STRIDE = 16
CMP_BLOCK = 2 * CMP_STRIDE
CMP_HID = 128
SEL_BLOCK = 64
N_SEL = 16
WINDOW = 512
Q_BLOCK = 128
FORCE_SCORE = 1.0e6
NUM_BUCKETS = 32
REL_MAX_DIST = 128
D_FF = 4 * D_MODEL
N_MOD = 6
EPS = 1e-6
W_A = H_A * DV_A
W_B = H_B * HD_B
IN_SPLITS = (H_A * DK_A, H_A * DK_A, H_A * DV_A, H_A * DV_A, H_B * HD_B) + (KV_B * HD_B,) * 6 + (3 * H_B, D_MODEL, D_MODEL)
IN_COLS = sum(IN_SPLITS)

kernel_name = 'hgrn2_nsa_hybrid_step'


def rmsnorm(x, gain):
    xf = x.astype(jnp.float32)
    return xf * lax.rsqrt(jnp.mean(xf * xf, axis=-1, keepdims=True) + EPS) * gain.astype(jnp.float32)


def masked_softmax(s, mask):
    s = jnp.where(mask, s.astype(jnp.float32), -jnp.inf)
    m = jnp.max(s, axis=-1, keepdims=True)
    m = jnp.where(jnp.isfinite(m), m, 0.0)
    e = jnp.exp(s - m)
    return e / jnp.maximum(jnp.sum(e, axis=-1, keepdims=True), 1e-30)


def rel_bucket(rel):
    n = jnp.maximum(rel, 0)
    exact = NUM_BUCKETS // 2
    nf = jnp.maximum(n, 1).astype(jnp.float32)
    large = exact + (jnp.log(nf / exact) / math.log(REL_MAX_DIST / exact) * (NUM_BUCKETS - exact)).astype(jnp.int32)
    return jnp.where(n < exact, n, jnp.minimum(large, NUM_BUCKETS - 1))


def hgrn_scan(q, k, logf, v, s0):
    b_sz, t_len, n_h, _ = q.shape
    dv = v.shape[-1]
    c = math.gcd(t_len, HGRN_CHUNK)
    n_c = t_len // c

    def chunks(a):
        return a.reshape(b_sz, n_c, c, n_h, a.shape[-1]).transpose(1, 0, 3, 2, 4)

    causal = jnp.tril(jnp.ones((c, c), dtype=bool))[:, :, None]

    def step(s, xs):
        qc, kc, lc, vc = xs
        b = jnp.cumsum(lc, axis=2)
        diff = b[:, :, :, None, :] - b[:, :, None, :, :]
        decay = jnp.exp(jnp.where(causal, diff, -jnp.inf))
        attn = jnp.einsum('bhtk,bhsk,bhtsk->bhts', qc, kc, decay)
        o = jnp.einsum('bhts,bhsv->bhtv', attn, vc) + jnp.einsum('bhtk,bhkv->bhtv', qc * jnp.exp(b), s)
        b_last = b[:, :, -1:, :]
        s = jnp.exp(b_last[:, :, 0, :, None]) * s + jnp.einsum('bhsk,bhsv->bhkv', kc * jnp.exp(b_last - b), vc)
        return s, o

    s_fin, o = lax.scan(step, s0, (chunks(q), chunks(k), chunks(logf), chunks(v)))
    return o.transpose(1, 0, 3, 2, 4).reshape(b_sz, t_len, n_h, dv), s_fin


def hgrn_mix(q, z, i, g, s0, lb, onorm):
    q, z, i, g = (a.astype(jnp.float32) for a in (q, z, i, g))
    logf = jnp.log(lb + (1.0 - lb) * jax.nn.sigmoid(z))
    k = (1.0 - lb) * jax.nn.sigmoid(-z)
    o, s_fin = hgrn_scan(q, k, logf, i, s0.astype(jnp.float32))
    o = rmsnorm(o, onorm) * jax.nn.silu(g)
    return o.reshape(o.shape[0], o.shape[1], W_A), s_fin


def compress(x, w1, b1, w2):
    b_sz, t_len = x.shape[:2]
    n_half = -(-t_len // CMP_STRIDE)
    x = jnp.pad(x.astype(jnp.float32), ((0, 0), (0, n_half * CMP_STRIDE - t_len), (0, 0), (0, 0)))
    xh = x.reshape(b_sz, n_half, CMP_STRIDE, KV_B, HD_B).transpose(0, 1, 3, 2, 4).reshape(b_sz, n_half, KV_B, CMP_STRIDE * HD_B)
    w1h = w1.reshape(2, CMP_STRIDE * HD_B, CMP_HID)
    pre = (xh @ w1h[0])[:, :-1] + (xh @ w1h[1])[:, 1:] + b1
    return jax.nn.silu(pre) @ w2


def compressed_attention(qg, k_cmp, v_cmp, q_pos, rel_table):
    n_c = k_cmp.shape[1]
    t_q = q_pos.shape[0]
    end = jnp.arange(n_c) * CMP_STRIDE + CMP_BLOCK - 1
    rel = q_pos[:, None] - end[None, :]
    s = jnp.einsum('bqkgd,bckd->bkgqc', qg, k_cmp)
    bias = rel_table[rel_bucket(rel)].reshape(t_q, n_c, KV_B, G_B).transpose(2, 3, 0, 1)
    p = masked_softmax(s + bias, rel >= 0)
    return jnp.einsum('bkgqc,bckd->bqkgd', p, v_cmp), p


def select_blocks(p_cmp, q_pos, t_k):
    n_c = p_cmp.shape[-1]
    n_s = -(-t_k // SEL_BLOCK)
    imp = jnp.sum(p_cmp, axis=2)
    cs = jnp.arange(n_c) * CMP_STRIDE
    ss = jnp.arange(n_s) * SEL_BLOCK
    overlap = ((cs[:, None] < ss[None, :] + SEL_BLOCK) & (cs[:, None] + CMP_BLOCK > ss[None, :])).astype(jnp.float32)
    imp = imp @ overlap
    cur = (q_pos // SEL_BLOCK)[:, None]
    blk = jnp.arange(n_s)[None, :]
    forced = (blk == 0) | (blk == cur) | (blk == cur - 1)
    score = jnp.where(blk <= cur, imp + jnp.where(forced, FORCE_SCORE, 0.0), -jnp.inf)
    _, idx = lax.top_k(score, min(N_SEL, n_s))
    return idx


def selected_attention(qg, idx, q_pos, kblk, vblk, rel_table):
    b_sz, t_q = qg.shape[:2]
    n_k = idx.shape[-1]
    b_ix = jnp.arange(b_sz)[:, None, None, None]
    h_ix = jnp.arange(KV_B)[None, :, None, None]
    kg = kblk[b_ix, h_ix, idx]
    vg = vblk[b_ix, h_ix, idx].reshape(b_sz, KV_B, t_q, n_k * SEL_BLOCK, HD_B)
    pos = idx[..., None] * SEL_BLOCK + jnp.arange(SEL_BLOCK)
    rel = q_pos[:, None, None] - pos
    s = jnp.einsum('bqkgd,bkqnsd->bkgqns', qg, kg)
    tab = rel_table.reshape(NUM_BUCKETS, KV_B, G_B).transpose(1, 0, 2)
    bias = jnp.moveaxis(tab[h_ix[..., None], rel_bucket(rel)], -1, 2)
    s = (s + bias).reshape(b_sz, KV_B, G_B, t_q, n_k * SEL_BLOCK)
    mask = (rel >= 0).reshape(b_sz, KV_B, 1, t_q, n_k * SEL_BLOCK)
    p = masked_softmax(s, mask)
    return jnp.einsum('bkgqm,bkqmd->bqkgd', p, vg)


def selected_attention_blocked(qg, idx, q_pos, ks_full, vs_full, rel_table):
    b_sz, t_k = ks_full.shape[:2]
    t_q = qg.shape[1]
    n_s = -(-t_k // SEL_BLOCK)
    pad = n_s * SEL_BLOCK - t_k

    def blocks(a):
        a = jnp.pad(a.astype(jnp.float32), ((0, 0), (0, pad), (0, 0), (0, 0)))
        return a.reshape(b_sz, n_s, SEL_BLOCK, KV_B, HD_B).transpose(0, 3, 1, 2, 4)

    kblk, vblk = blocks(ks_full), blocks(vs_full)
    qb = math.gcd(t_q, Q_BLOCK)
    n_q = t_q // qb
    qs = jnp.moveaxis(qg.reshape(b_sz, n_q, qb, KV_B, G_B, HD_B), 1, 0)
    ids = jnp.moveaxis(idx.reshape(b_sz, KV_B, n_q, qb, idx.shape[-1]), 2, 0)
    ps = q_pos.reshape(n_q, qb)
    o = lax.map(lambda a: selected_attention(a[0], a[1], a[2], kblk, vblk, rel_table), (qs, ids, ps))
    return jnp.moveaxis(o, 0, 1).reshape(b_sz, t_q, KV_B, G_B, HD_B)


def window_attention(qg, qw_pos, kvw_band, kw_pos, rel_table):
    b_sz = qg.shape[0]
    n_b, qb = qw_pos.shape
    kb = kw_pos.shape[1]
    q_blk = qg.reshape(b_sz, n_b, qb, KV_B, G_B, HD_B)
    s = jnp.einsum('bnqkgd,bnskd->bnkgqs', q_blk, kvw_band[:, :, :, 0])
    rel = qw_pos[:, :, None] - kw_pos[:, None, :]
    bias = rel_table[rel_bucket(rel)].reshape(n_b, qb, kb, KV_B, G_B).transpose(0, 3, 4, 1, 2)
    mask = (rel >= 0) & (rel < WINDOW) & (kw_pos[:, None, :] >= 0)
    p = masked_softmax(s + bias, mask[:, None, None])
    o = jnp.einsum('bnkgqs,bnskd->bnqkgd', p, kvw_band[:, :, :, 1])
    return o.reshape(b_sz, n_b * qb, KV_B, G_B, HD_B)


def prompt_band(kv):
    b_sz, t_len = kv.shape[:2]
    qb = math.gcd(t_len, Q_BLOCK)
    n_b = t_len // qb
    n_w = WINDOW // qb
    kp = jnp.pad(kv, ((0, 0), (WINDOW, 0), (0, 0), (0, 0), (0, 0)))
    kb = kp.reshape((b_sz, n_w + n_b, qb) + kv.shape[2:])
    band = jnp.concatenate([kb[:, j:j + n_b] for j in range(n_w + 1)], axis=2)
    pos = jnp.arange(-WINDOW, t_len).reshape(n_w + n_b, qb)
    band_pos = jnp.concatenate([pos[j:j + n_b] for j in range(n_w + 1)], axis=1)
    return band, jnp.arange(t_len).reshape(n_b, qb), band_pos


def nsa_core(q, gates, kc_full, vc_full, ks_full, vs_full, kvw_band, qw_pos, kw_pos, q_pos, nsa_w):
    (q_norm, kc_norm, ck_w1, ck_b1, ck_w2, cv_w1, cv_b1, cv_w2, rel_table) = nsa_w
    b_sz, t_len = q.shape[:2]
    rel_table = rel_table.astype(jnp.float32)
    qg = (rmsnorm(q, q_norm) * HD_B ** -0.5).reshape(b_sz, t_len, KV_B, G_B, HD_B)
    k_cmp = rmsnorm(compress(kc_full, ck_w1, ck_b1, ck_w2), kc_norm)
    v_cmp = compress(vc_full, cv_w1, cv_b1, cv_w2)
    o_cmp, p_cmp = compressed_attention(qg, k_cmp, v_cmp, q_pos, rel_table)
    idx = select_blocks(p_cmp, q_pos, ks_full.shape[1])
    o_sel = selected_attention_blocked(qg, idx, q_pos, ks_full, vs_full, rel_table)
    o_win = window_attention(qg, qw_pos, kvw_band, kw_pos, rel_table)
    gt = jax.nn.sigmoid(gates.astype(jnp.float32)).reshape(b_sz, t_len, KV_B, G_B, 3)
    o = gt[..., 0:1] * o_cmp + gt[..., 1:2] * o_sel + gt[..., 2:3] * o_win
    return o.reshape(b_sz, t_len, W_B)


def nsa_prompt(q, kc, vc, ks, vs, kw, vw, gates, ks_norm, kw_norm, nsa_w):
    b_sz, t_len = q.shape[:2]
    ks = rmsnorm(ks, ks_norm)
    kw = rmsnorm(kw, kw_norm)
    kvw = jnp.stack([kw, vw.astype(jnp.float32)], axis=2)
    band, qw_pos, kw_pos = prompt_band(kvw)
    o = nsa_core(q, gates, kc, vc, ks, vs, band, qw_pos, kw_pos, jnp.arange(t_len), nsa_w)
    pages = (b_sz, t_len // PAGE_SIZE, PAGE_SIZE, 2, KV_B, HD_B)
    cmp_new = jnp.stack([kc, vc], axis=2).reshape(pages)
    sel_new = jnp.stack([ks, vs.astype(jnp.float32)], axis=2).reshape(pages)
    win_new = kvw[:, t_len - min(WINDOW, t_len):]
    return o, (cmp_new, sel_new, win_new)


def nsa_sample(q, kc, vc, ks, vs, kw, vw, gates, ks_norm, kw_norm, nsa_w, cache_cmp, cache_sel, cache_win, page_table):
    b_sz, t_len = q.shape[:2]
    past = page_table.shape[1] * PAGE_SIZE
    wb = cache_win.shape[1]
    ks = rmsnorm(ks, ks_norm)
    kw = rmsnorm(kw, kw_norm)
    cmp_new = jnp.stack([kc, vc], axis=2).astype(jnp.float32)
    sel_new = jnp.stack([ks, vs.astype(jnp.float32)], axis=2)
    win_rows = jnp.stack([kw, vw.astype(jnp.float32)], axis=2)

    def gather_past(cache):
        return cache[page_table].reshape((b_sz, past) + cache.shape[2:]).astype(jnp.float32)

    cmp_full = jnp.concatenate([gather_past(cache_cmp), cmp_new], axis=1)
    sel_full = jnp.concatenate([gather_past(cache_sel), sel_new], axis=1)
    win_full = jnp.concatenate([cache_win.astype(jnp.float32), win_rows], axis=1)
    q_pos = past + jnp.arange(t_len)
    kw_pos = (past - wb + jnp.arange(wb + t_len))[None]
    o = nsa_core(q, gates, cmp_full[:, :, 0], cmp_full[:, :, 1], sel_full[:, :, 0], sel_full[:, :, 1],
                 win_full[:, None], q_pos[None], kw_pos, q_pos, nsa_w)
    return o, (cmp_new, sel_new, win_full[:, t_len:])


def trunk_layer(x, c, lw, lb, s0, nsa_fn):
    (ada_w, ada_b, norm1, norm2, w_in, hgrn_onorm, w_ba, w_bb, w_out, mlp_w1, mlp_w2) = lw
    b_sz, t_len, _ = x.shape
    mods = jax.nn.silu(c.astype(jnp.float32)) @ ada_w + ada_b
    sh1, sc1, g1, sh2, sc2, g2 = jnp.split(mods[:, None, :], N_MOD, axis=-1)
    h = rmsnorm(x, norm1) * (1.0 + sc1) + sh1
    cuts = np.cumsum(np.array(IN_SPLITS))[:-1].tolist()
    (q_a, z_a, i_a, g_a, q_b, kc, vc, ks, vs, kw, vw, gate_b, mg_a, mg_b) = jnp.split(h @ w_in, cuts, axis=-1)

    def heads(a, n, d):
        return a.reshape(b_sz, t_len, n, d)

    o_a, s_fin = hgrn_mix(heads(q_a, H_A, DK_A), heads(z_a, H_A, DK_A), heads(i_a, H_A, DV_A),
                          heads(g_a, H_A, DV_A), s0, lb, hgrn_onorm)
    kvh = [heads(a, KV_B, HD_B) for a in (kc, vc, ks, vs, kw, vw)]
    o_b, nsa_state = nsa_fn(heads(q_b, H_B, HD_B), *kvh, gate_b)
    merged = jax.nn.sigmoid(mg_a) * (o_a @ w_ba) + jax.nn.sigmoid(mg_b) * (o_b @ w_bb)
    x1 = x.astype(jnp.float32) + g1 * (merged @ w_out)
    h2 = rmsnorm(x1, norm2) * (1.0 + sc2) + sh2
    u = jax.nn.relu(h2 @ mlp_w1)
    y = x1 + g2 * ((u * u) @ mlp_w2)
    return y.astype(x.dtype), s_fin, nsa_state


def setup_inputs(seed: int = 0) -> dict:
    key = jax.random.key(seed)
    ks = iter(jax.random.split(key, 32))
    n_pages = PAST_LEN // PAGE_SIZE
    n_used = DEC_BATCH * n_pages
    n_phys = n_used + max(1, n_used // 4)
    win_buf = min(WINDOW, PAST_LEN)
    f32 = jnp.float32

    def nrm(shape, scale):
        return jax.random.normal(next(ks), shape, f32) * scale

    def gain(shape):
        return 1.0 + nrm(shape, 0.1)

    page_table = jax.random.permutation(next(ks), n_phys)[:n_used].astype(jnp.int32).reshape(DEC_BATCH, n_pages)
    return {
        'x_prompt': nrm((BATCH, SEQ, D_MODEL), 1.0),
        'x_sample': nrm((DEC_BATCH, DEC_SEQ, D_MODEL), 1.0),
        'c_prompt': nrm((BATCH, D_MODEL), 1.0),
        'c_sample': nrm((DEC_BATCH, D_MODEL), 1.0),
        'cache_cmp_kv': nrm((DEPTH, n_phys, PAGE_SIZE, 2, KV_B, HD_B), 1.0),
        'cache_sel_kv': nrm((DEPTH, n_phys, PAGE_SIZE, 2, KV_B, HD_B), 1.0),
        'cache_win_kv': nrm((DEPTH, DEC_BATCH, win_buf, 2, KV_B, HD_B), 1.0),
        'state_hgrn': nrm((DEPTH, DEC_BATCH, H_A, DK_A, DV_A), 0.5),
        'page_table': page_table,
        'hgrn_lb_logits': nrm((DEPTH + 1, H_A * DK_A), 0.5),
        'rel_bias': nrm((NUM_BUCKETS, H_B), 0.5),
        'ada_w': nrm((DEPTH, D_MODEL, N_MOD * D_MODEL), D_MODEL ** -0.5),
        'ada_b': nrm((DEPTH, N_MOD * D_MODEL), 0.02),
        'norm1': gain((DEPTH, D_MODEL)),
        'norm2': gain((DEPTH, D_MODEL)),
        'w_in': nrm((DEPTH, D_MODEL, IN_COLS), D_MODEL ** -0.5),
        'hgrn_onorm': gain((DEPTH, H_A, DV_A)),
        'nsa_q_norm': gain((DEPTH, HD_B)),
        'nsa_kc_norm': gain((DEPTH, HD_B)),
        'nsa_ks_norm': gain((DEPTH, HD_B)),
        'nsa_kw_norm': gain((DEPTH, HD_B)),
        'cmp_k_w1': nrm((DEPTH, CMP_BLOCK * HD_B, CMP_HID), (CMP_BLOCK * HD_B) ** -0.5),
        'cmp_k_b1': nrm((DEPTH, CMP_HID), 0.02),
        'cmp_k_w2': nrm((DEPTH, CMP_HID, HD_B), CMP_HID ** -0.5),
        'cmp_v_w1': nrm((DEPTH, CMP_BLOCK * HD_B, CMP_HID), (CMP_BLOCK * HD_B) ** -0.5),
        'cmp_v_b1': nrm((DEPTH, CMP_HID), 0.02),
        'cmp_v_w2': nrm((DEPTH, CMP_HID, HD_B), CMP_HID ** -0.5),
        'w_branch_a': nrm((DEPTH, W_A, D_MODEL), W_A ** -0.5),
        'w_branch_b': nrm((DEPTH, W_B, D_MODEL), W_B ** -0.5),
        'w_out': nrm((DEPTH, D_MODEL, D_MODEL), D_MODEL ** -0.5),
        'mlp_w1': nrm((DEPTH, D_MODEL, D_FF), D_MODEL ** -0.5),
        'mlp_w2': nrm((DEPTH, D_FF, D_MODEL), D_FF ** -0.5),
    }


def reference(x_prompt, x_sample, c_prompt, c_sample, cache_cmp_kv, cache_sel_kv, cache_win_kv, state_hgrn,
              page_table, hgrn_lb_logits, rel_bias, ada_w, ada_b, norm1, norm2, w_in, hgrn_onorm,
              nsa_q_norm, nsa_kc_norm, nsa_ks_norm, nsa_kw_norm, cmp_k_w1, cmp_k_b1, cmp_k_w2,
              cmp_v_w1, cmp_v_b1, cmp_v_w2, w_branch_a, w_branch_b, w_out, mlp_w1, mlp_w2):
    lb_all = jnp.cumsum(jax.nn.softmax(hgrn_lb_logits.astype(jnp.float32), axis=0), axis=0)
    y_p, y_s = x_prompt, x_sample
    cmp_p, cmp_s, sel_p, sel_s, win_p, win_s, hg_p, hg_s = [], [], [], [], [], [], [], []
    for l in range(DEPTH):
        lw = (ada_w[l], ada_b[l], norm1[l], norm2[l], w_in[l], hgrn_onorm[l], w_branch_a[l], w_branch_b[l],
              w_out[l], mlp_w1[l], mlp_w2[l])
        nsa_w = (nsa_q_norm[l], nsa_kc_norm[l], cmp_k_w1[l], cmp_k_b1[l], cmp_k_w2[l],
                 cmp_v_w1[l], cmp_v_b1[l], cmp_v_w2[l], rel_bias)
        lb = lb_all[l].reshape(H_A, DK_A)
        s0_p = jnp.zeros((x_prompt.shape[0], H_A, DK_A, DV_A), jnp.float32)
        y_p, hp, (cp, sp, wp) = trunk_layer(
            y_p, c_prompt, lw, lb, s0_p,
            lambda *a: nsa_prompt(*a, nsa_ks_norm[l], nsa_kw_norm[l], nsa_w))
        y_s, hs, (cs, ss, wsm) = trunk_layer(
            y_s, c_sample, lw, lb, state_hgrn[l],
            lambda *a: nsa_sample(*a, nsa_ks_norm[l], nsa_kw_norm[l], nsa_w,
                                  cache_cmp_kv[l], cache_sel_kv[l], cache_win_kv[l], page_table))
        cmp_p.append(cp)
        cmp_s.append(cs)
        sel_p.append(sp)
        sel_s.append(ss)
        win_p.append(wp)
        win_s.append(wsm)
        hg_p.append(hp)
        hg_s.append(hs)
    dt = x_prompt.dtype
    return (y_p, y_s,
            jnp.stack(cmp_p).astype(dt), jnp.stack(cmp_s).astype(dt),
            jnp.stack(sel_p).astype(dt), jnp.stack(sel_s).astype(dt),
            jnp.stack(win_p).astype(dt), jnp.stack(win_s).astype(dt),
            jnp.stack(hg_p).astype(dt), jnp.stack(hg_s).astype(dt))
```

```cpp
#include <hip/hip_runtime.h>
#include <stdint.h>
#include <math.h>

namespace pg8 {
#define PG8_LAS __attribute__((address_space(3)))
typedef unsigned short bf16_t;
typedef short bf16x8 __attribute__((ext_vector_type(8)));
typedef float f32x4 __attribute__((ext_vector_type(4)));
typedef unsigned u32x4 __attribute__((ext_vector_type(4)));
constexpr int BM = 256, BK = 64, HALF = 128, HTB = HALF * BK * 2  , STAGE_BYTES = 8 * HTB, NXCD = 8, WGM = 8;

__host__ __device__ __forceinline__ int lds_byte(int r, int c) { const int st = (r >> 4) * 2 + (c >> 5), rr = r & 15, cc = c & 31, ob = rr * 64 + cc * 2; return st * 1024 + (ob ^ (((ob >> 9) & 1) << 5)); }
__host__ __device__ __forceinline__ void stage_rc(int b, int& R, int& C) { const int st = b / 1024, sb = b % 1024, swz = sb ^ (((sb >> 9) & 1) << 5); R = (st >> 1) * 16 + swz / 64; C = (st & 1) * 32 + (swz % 64) / 2; }
__host__ __device__ __forceinline__ int perm32(int rho) { const int n = rho >> 4, i = rho & 15; return 8 * (i >> 2) + 4 * n + (i & 3); }

struct Unit { int pm, pn; };
struct Gemm { const bf16_t* A; const bf16_t* Bt; int M, N, K, pad; };

struct StaticOrder {
    int nM, nN, nwg, G, c;
    __host__ __device__ void init(int M, int N, int G_, int c_) { nM = M / BM; nN = N / BM; nwg = nM * nN; G = G_; c = c_; }
    __host__ __device__ bool next(int i, Unit& u) const {
        const long L = (long)i * G + c; if (L >= nwg) return false;
        int wgid = (int)L; { const int q = nwg / NXCD, r = nwg % NXCD, xcd = wgid % NXCD, off = wgid / NXCD; wgid = (xcd < r ? xcd * (q + 1) : r * (q + 1) + (xcd - r) * q) + off; }
        const int nig = WGM * nN, gid = wgid / nig, fm = gid * WGM, gsz = (nM - fm) < WGM ? (nM - fm) : WGM;
        u.pm = fm + ((wgid % nig) % gsz); u.pn = (wgid % nig) / gsz; return true;
    }
    __device__ __forceinline__ void a_ready(const Unit&) const {}
    __device__ __forceinline__ void done(const Unit&) const {}
};
template <class Epi, class Sched, bool STAMP = false>
__device__ __forceinline__ void gemm_phase(PG8_LAS unsigned char* lds, const Gemm g, const Sched& S, const Epi& E, unsigned long long* stamps) {
    const int tid = threadIdx.x, wid = __builtin_amdgcn_readfirstlane(tid >> 6), lane = tid & 63, wr = wid >> 2, wc = wid & 3, fr = lane & 15, fq = lane >> 4;
    const int K = g.K, nt = K / BK;
    int ts_lo = 0, ts_hi = 0, nts = 0; const unsigned long long rt_entry = STAMP ? (unsigned long long)wall_clock64() : 0ull;
#define PG8_STAMP() do { if (STAMP && wid == 0 && nts < 64) { const unsigned long long _c = (unsigned long long)clock64(); \
        ts_lo = (lane == nts) ? (int)(unsigned)_c : ts_lo; ts_hi = (lane == nts) ? (int)(unsigned)(_c >> 32) : ts_hi; ++nts; } } while (0)
    PG8_STAMP();
    unsigned voffA[2], voffB[2];
#pragma unroll
    for (int i = 0; i < 2; ++i) { int R, C; stage_rc(tid * 16 + i * 8192, R, C); const int Rb = Epi::PERM ? ((R & ~31) + perm32(R & 31)) : R;
        voffA[i] = (unsigned)(R * K + C) * 2u; voffB[i] = (unsigned)(Rb * K + C) * 2u; }
    const size_t kstep = (size_t)(BK * 2);
    const size_t hstep = (size_t)HALF * K * 2;
    const size_t tstep = 2 * hstep;
    const unsigned ldsw = (unsigned)wid * 1024u;
    const int aoff = lds_byte(wr * 64 + fr, fq * 8), boff = lds_byte(wc * 32 + fr, fq * 8);
#define PG8_SA(b, h) (((b) * 2 + (h)) * HTB)
#define PG8_SB(b, h) ((4 + (b) * 2 + (h)) * HTB)
#define PG8_STAGE(bufoff, gbase, voff) do { _Pragma("unroll") for (int _i = 0; _i < 2; ++_i) \
        __builtin_amdgcn_global_load_lds((const unsigned*)((const char*)(gbase) + (voff)[_i]), (PG8_LAS unsigned*)(lds + (bufoff) + ldsw + _i * 8192), 16, 0, 0); } while (0)
#define PG8_LDA(dst, b, h) do { _Pragma("unroll") for (int m = 0; m < 4; ++m) _Pragma("unroll") for (int k = 0; k < 2; ++k) dst[m][k] = *(const PG8_LAS bf16x8*)(lds + PG8_SA(b, h) + aoff + m * 2048 + k * 1024); } while (0)
#define PG8_LDB(dst, b, h) do { _Pragma("unroll") for (int n = 0; n < 2; ++n) _Pragma("unroll") for (int k = 0; k < 2; ++k) dst[n][k] = *(const PG8_LAS bf16x8*)(lds + PG8_SB(b, h) + boff + n * 2048 + k * 1024); } while (0)
#define PG8_MMA(ai, bj, At, Bt) do { __builtin_amdgcn_s_setprio(1); _Pragma("unroll") for (int m = 0; m < 4; ++m) _Pragma("unroll") for (int n = 0; n < 2; ++n) _Pragma("unroll") for (int k = 0; k < 2; ++k) \
        acc[ai][bj][m][n] = __builtin_amdgcn_mfma_f32_16x16x32_bf16(Bt[n][k], At[m][k], acc[ai][bj][m][n], 0, 0, 0); __builtin_amdgcn_s_setprio(0); } while (0)
#define PG8_WAIT_V(n) asm volatile("s_waitcnt vmcnt(" #n ")" ::: "memory")
#define PG8_WAIT_L(n) asm volatile("s_waitcnt lgkmcnt(" #n ")" ::: "memory")
#define PG8_BAR __builtin_amdgcn_s_barrier()
#define PG8_SCHED __builtin_amdgcn_sched_barrier(0)
    Unit cur, nxt; int ui = 0;
    if (!S.next(0, cur)) return;
    f32x4 acc[2][2][4][2];
#pragma unroll
    for (int a = 0; a < 2; ++a)
#pragma unroll
        for (int b = 0; b < 2; ++b)
#pragma unroll
            for (int m = 0; m < 4; ++m)
#pragma unroll
                for (int n = 0; n < 2; ++n) acc[a][b][m][n] = (f32x4){0.f, 0.f, 0.f, 0.f};
    bf16x8 At[4][2], B0[2][2], B1[2][2];
    const char* cA = (const char*)g.A + (size_t)cur.pm * tstep; const char* cB = (const char*)g.Bt + (size_t)cur.pn * tstep;
    S.a_ready(cur);
    PG8_STAGE(PG8_SB(0, 0), cB, voffB); PG8_STAGE(PG8_SA(0, 0), cA, voffA); PG8_STAGE(PG8_SB(0, 1), cB + hstep, voffB); PG8_STAGE(PG8_SA(0, 1), cA + hstep, voffA);
    if (wr == 1) PG8_BAR;
    PG8_WAIT_V(4); PG8_BAR;
    PG8_STAGE(PG8_SB(1, 0), cB + kstep, voffB); PG8_STAGE(PG8_SA(1, 0), cA + kstep, voffA); PG8_STAGE(PG8_SB(1, 1), cB + hstep + kstep, voffB);
    PG8_WAIT_V(6); PG8_BAR;
    PG8_STAMP();
    for (;;) {
        const bool has_next = S.next(ui + 1, nxt);
        const char* nA = has_next ? (const char*)g.A + (size_t)nxt.pm * tstep : cA; const char* nB = has_next ? (const char*)g.Bt + (size_t)nxt.pn * tstep : cB;
        for (int t = 0; t < nt; t += 2) {
            const bool last = (t == nt - 2);
            const char* a1 = cA + (size_t)(t + 1) * kstep;
            const char* a2 = last ? nA : cA + (size_t)(t + 2) * kstep; const char* b2 = last ? nB : cB + (size_t)(t + 2) * kstep;
            const char* a3 = a2 + kstep; const char* b3 = b2 + kstep;
            if (last && has_next) S.a_ready(nxt);
            PG8_LDB(B0, 0, 0); PG8_SCHED; PG8_LDA(At, 0, 0); PG8_STAGE(PG8_SA(1, 1), a1 + hstep, voffA);
            PG8_WAIT_L(8); PG8_BAR; PG8_WAIT_L(0); PG8_MMA(0, 0, At, B0); PG8_BAR; PG8_SCHED;
            PG8_LDB(B1, 0, 1); PG8_STAGE(PG8_SB(0, 0), b2, voffB);
            PG8_BAR; PG8_WAIT_L(0); PG8_MMA(0, 1, At, B1); PG8_BAR;
            PG8_LDA(At, 0, 1); PG8_STAGE(PG8_SA(0, 0), a2, voffA);
            PG8_BAR; PG8_WAIT_L(0); PG8_MMA(1, 0, At, B0); PG8_BAR; PG8_SCHED;
            PG8_STAGE(PG8_SB(0, 1), b2 + hstep, voffB);
            PG8_WAIT_V(6); PG8_BAR; PG8_MMA(1, 1, At, B1); PG8_BAR;
            PG8_LDB(B0, 1, 0); PG8_SCHED; PG8_LDA(At, 1, 0); PG8_STAGE(PG8_SA(0, 1), a2 + hstep, voffA);
            PG8_WAIT_L(8); PG8_BAR; PG8_WAIT_L(0); PG8_MMA(0, 0, At, B0); PG8_BAR; PG8_SCHED;
            PG8_LDB(B1, 1, 1); PG8_STAGE(PG8_SB(1, 0), b3, voffB);
            PG8_BAR; PG8_WAIT_L(0); PG8_MMA(0, 1, At, B1); PG8_BAR;
            PG8_LDA(At, 1, 1); PG8_STAGE(PG8_SA(1, 0), a3, voffA);
            PG8_BAR; PG8_WAIT_L(0); PG8_MMA(1, 0, At, B0); PG8_BAR; PG8_SCHED;
            PG8_STAGE(PG8_SB(1, 1), b3 + hstep, voffB);
            PG8_WAIT_V(6); PG8_BAR; PG8_MMA(1, 1, At, B1); PG8_BAR;
        }
        PG8_STAMP();
        if constexpr (!Epi::AFTER_DRAIN) { E(acc, cur, wr, wc, fr, fq); S.done(cur); }
        PG8_STAMP();
        if (!has_next) break;
#pragma unroll
        for (int a = 0; a < 2; ++a)
#pragma unroll
            for (int b = 0; b < 2; ++b)
#pragma unroll
                for (int m = 0; m < 4; ++m)
#pragma unroll
                    for (int n = 0; n < 2; ++n) acc[a][b][m][n] = (f32x4){0.f, 0.f, 0.f, 0.f};
        cur = nxt; cA = nA; cB = nB; ++ui;
    }
    PG8_WAIT_V(0);
    if (wr == 0) PG8_BAR;
    PG8_BAR;
    if constexpr (Epi::AFTER_DRAIN) { E.fused(acc, cur, wr, wc, fr, fq, lds, wid, lane); S.done(cur); }
    PG8_STAMP();
    if (STAMP && wid == 0) { stamps[lane] = lane < nts ? (((unsigned long long)(unsigned)ts_hi << 32) | (unsigned)ts_lo) : 0ull;
        if (lane == 62) stamps[62] = rt_entry; if (lane == 63) stamps[63] = (unsigned long long)wall_clock64(); }
#undef PG8_STAMP
#undef PG8_SA
#undef PG8_SB
#undef PG8_STAGE
#undef PG8_LDA
#undef PG8_LDB
#undef PG8_MMA
#undef PG8_WAIT_V
#undef PG8_WAIT_L
#undef PG8_BAR
#undef PG8_SCHED
}
}

typedef unsigned short bf16;
typedef float f32x4 __attribute__((ext_vector_type(4)));
typedef float f32x2 __attribute__((ext_vector_type(2)));
constexpr int D = 2048, TP = 4096, MP = 8192, BS = 32, TS = 8, MS = 256, MT = 8448;
constexpr int PAST = 8192, NPAGE = 64, PAGE = 128, NMOD = 12288, DFF = 8192;
constexpr int NPROJ = 11008;
constexpr int C_QA = 0, C_ZA = 1024, C_IA = 2048, C_GA = 3072, C_QB = 4096, C_KC = 5120, C_VC = 5376, C_KS = 5632, C_VS = 5888, C_KW = 6144, C_VW = 6400, C_MGA = 6656, C_MGB = 8704, C_GATE = 10752;
constexpr int IN_COLS = 10776;
constexpr size_t O_YP = 0, O_YS = 16777216, O_CMPP = 17301504, O_CMPS = 21495808, O_SELP = 21626880, O_SELS = 25821184, O_WINP = 25952256, O_WINS = 26476544, O_HGP = 34865152, O_HGS = 35127296, O_END = 39321600;
constexpr float EPS = 1e-6f;

__device__ __forceinline__ bf16 f2bf(float f) { unsigned u = __float_as_uint(f); u += 0x7FFFu + ((u >> 16) & 1u); return (bf16)(u >> 16); }
__device__ __forceinline__ float bf2f(bf16 b) { return __uint_as_float(((unsigned)b) << 16); }
__device__ __forceinline__ float sigmoidf_(float x) { return 1.0f / (1.0f + __expf(-x)); }
__device__ __forceinline__ float siluf_(float x) { return x / (1.0f + __expf(-x)); }
__device__ __forceinline__ int modrow(int r) { return r < MP ? (r >> 12) : 2 + ((r - MP) >> 3); }
__device__ __forceinline__ int win_col(int n) {
    if (n < C_MGA) return n;
    if (n < C_MGB) return 6680 + (n - C_MGA);
    if (n < C_GATE) return 8728 + (n - C_MGB);
    if (n < C_GATE + 24) return 6656 + (n - C_GATE);
    return -1;
}
__device__ __forceinline__ int rel_bucket(int rel) {
    const int n = rel > 0 ? rel : 0;
    if (n < 16) return n;
    const float nf = (float)n;
    const int large = 16 + (int)(logf(nf / 16.0f) / 2.0794415416798357f * 16.0f);
    return large < 31 ? large : 31;
}
__device__ __forceinline__ float wave_sum(float v) {
#pragma unroll
    for (int o = 32; o >= 1; o >>= 1) v += __shfl_xor(v, o);
    return v;
}
__device__ __forceinline__ float wave_max(float v) {
#pragma unroll
    for (int o = 32; o >= 1; o >>= 1) v = fmaxf(v, __shfl_xor(v, o));
    return v;
}

__global__ void __launch_bounds__(256) k_transpose(const float* __restrict__ W, int K, int N, bf16* __restrict__ Wt, int Np, int mode) {
    __shared__ float tile[64][65];
    const int n0 = blockIdx.x * 64, k0 = blockIdx.y * 64, tid = threadIdx.x;
    {
        const int nn = tid & 63, n = n0 + nn; const int col = mode ? win_col(n) : (n < N ? n : -1);
        for (int p = 0; p < 16; ++p) { const int kk = (tid >> 6) + 4 * p; tile[kk][nn] = col >= 0 ? W[(size_t)(k0 + kk) * N + col] : 0.f; }
    }
    __syncthreads();
    {
        const int nn = tid >> 2, ks = (tid & 3) * 16; bf16* o = Wt + (size_t)(n0 + nn) * K + k0 + ks;
        for (int j = 0; j < 16; ++j) o[j] = f2bf(tile[ks + j][nn]);
    }
}
__global__ void __launch_bounds__(256) k_mods(const float* __restrict__ cp, const float* __restrict__ cs, const float* __restrict__ ada_w, const float* __restrict__ ada_b, float* __restrict__ mods) {
    const int col = blockIdx.x * 256 + threadIdx.x, r = blockIdx.y;
    const float* c = r < 2 ? cp + r * D : cs + (r - 2) * D;
    float acc = 0.f;
    for (int k = 0; k < D; ++k) acc += siluf_(c[k]) * ada_w[(size_t)k * NMOD + col];
    mods[(size_t)r * NMOD + col] = acc + ada_b[col];
}
__global__ void __launch_bounds__(256) k_hnorm(const float* __restrict__ xa, const float* __restrict__ xb, const float* __restrict__ gain, const float* __restrict__ mods, int sh_idx, int sc_idx, bf16* __restrict__ out) {
    __shared__ float red[4];
    const int row = blockIdx.x, tid = threadIdx.x;
    const float* x = row < MP ? xa + (size_t)row * D : xb + (size_t)(row - MP) * D;
    float v[8]; float ss = 0.f;
#pragma unroll
    for (int j = 0; j < 8; ++j) { v[j] = x[tid * 8 + j]; ss += v[j] * v[j]; }
    ss = wave_sum(ss); if ((tid & 63) == 0) red[tid >> 6] = ss; __syncthreads();
    ss = red[0] + red[1] + red[2] + red[3];
    const float r = rsqrtf(ss * (1.0f / D) + EPS);
    const float* m = mods + (size_t)modrow(row) * NMOD;
#pragma unroll
    for (int j = 0; j < 8; ++j) { const int c = tid * 8 + j; out[(size_t)row * D + c] = f2bf(v[j] * r * gain[c] * (1.0f + m[sc_idx * D + c]) + m[sh_idx * D + c]); }
}
__global__ void __launch_bounds__(256) k_post_proj(const float* __restrict__ proj, const float* __restrict__ lbl, const float* __restrict__ qn_g, const float* __restrict__ ks_g, const float* __restrict__ kw_g,
                                                   float* __restrict__ out, float* __restrict__ winkv, float* __restrict__ QN, float* __restrict__ F) {
    __shared__ float red[8];
    const int row = blockIdx.x, tid = threadIdx.x;
    const float* p = proj + (size_t)row * NPROJ;
    const bool pr = row < MP; const int lrow = pr ? row : row - MP;
    { float* o = out + (pr ? O_CMPP : O_CMPS) + (size_t)lrow * 512; o[tid] = p[C_KC + tid]; o[tid + 256] = p[C_VC + tid]; }
    {
        const float k = p[C_KS + tid]; float ss = wave_sum(k * k); if ((tid & 63) == 0) red[tid >> 6] = ss; __syncthreads();
        ss = (tid < 128) ? red[0] + red[1] : red[2] + red[3];
        float* o = out + (pr ? O_SELP : O_SELS) + (size_t)lrow * 512;
        o[tid] = k * rsqrtf(ss * (1.0f / 128) + EPS) * ks_g[tid & 127]; o[tid + 256] = p[C_VS + tid];
        __syncthreads();
    }
    {
        const float k = p[C_KW + tid]; float ss = wave_sum(k * k); if ((tid & 63) == 0) red[4 + (tid >> 6)] = ss; __syncthreads();
        ss = (tid < 128) ? red[4] + red[5] : red[6] + red[7];
        const float kn = k * rsqrtf(ss * (1.0f / 128) + EPS) * kw_g[tid & 127], vv = p[C_VW + tid];
        float* w = winkv + (size_t)row * 512; w[tid] = kn; w[tid + 256] = vv;
        if (pr) { const int b = row >> 12, t = row & 4095; if (t >= TP - 512) { float* o = out + O_WINP + ((size_t)b * 512 + (t - (TP - 512))) * 512; o[tid] = kn; o[tid + 256] = vv; } }
        else { const int b = lrow >> 3, t = lrow & 7; float* o = out + O_WINS + ((size_t)b * 512 + 504 + t) * 512; o[tid] = kn; o[tid + 256] = vv; }
    }
    {
        float q[4]; float ss = 0.f;
#pragma unroll
        for (int j = 0; j < 4; ++j) { q[j] = p[C_QB + tid * 4 + j]; ss += q[j] * q[j]; }
#pragma unroll
        for (int o = 16; o >= 1; o >>= 1) ss += __shfl_xor(ss, o);
        const float r = rsqrtf(ss * (1.0f / 128) + EPS) * 0.08838834764831845f;
#pragma unroll
        for (int j = 0; j < 4; ++j) QN[(size_t)row * 1024 + tid * 4 + j] = q[j] * r * qn_g[(tid * 4 + j) & 127];
    }
#pragma unroll
    for (int j = 0; j < 4; ++j) { const int c = tid * 4 + j; const float lb = sigmoidf_(lbl[c] - lbl[1024 + c]); F[(size_t)row * 1024 + c] = lb + (1.0f - lb) * sigmoidf_(p[C_ZA + c]); }
}
__global__ void __launch_bounds__(256) k_win_roll(const float* __restrict__ cw, float* __restrict__ out) {
    const size_t n = (size_t)BS * 504 * 512;
    for (size_t i = (size_t)blockIdx.x * 256 + threadIdx.x; i < n; i += (size_t)gridDim.x * 256) { const size_t b = i / (504 * 512), r = i % (504 * 512); out[O_WINS + b * 512 * 512 + r] = cw[b * 512 * 512 + 8 * 512 + r]; }
}
__global__ void __launch_bounds__(128) k_hgrn_seq(const float* __restrict__ proj, const float* __restrict__ F, const float* __restrict__ state, float* __restrict__ oraw, float* __restrict__ out) {
    const int x = blockIdx.x, v = threadIdx.x; const bool pr = x < 16;
    const int b = pr ? (x >> 3) : ((x - 16) >> 3), h = x & 7;
    const int T = pr ? TP : TS; const size_t row0 = pr ? (size_t)b * TP : (size_t)MP + b * TS;
    float S[128];
#pragma unroll
    for (int k = 0; k < 128; ++k) S[k] = pr ? 0.f : state[(((size_t)b * 8 + h) * 128 + k) * 128 + v];
    for (int t = 0; t < T; ++t) {
        const float* p = proj + (row0 + t) * NPROJ; const float* f = F + (row0 + t) * 1024 + h * 128;
        const float vi = p[C_IA + h * 128 + v]; float o = 0.f;
#pragma unroll
        for (int k = 0; k < 128; ++k) { const float fk = f[k]; S[k] = fk * S[k] + (1.0f - fk) * vi; o += S[k] * p[C_QA + h * 128 + k]; }
        oraw[(row0 + t) * 1024 + h * 128 + v] = o;
    }
    float* so = out + (pr ? O_HGP : O_HGS) + ((size_t)b * 8 + h) * 16384;
#pragma unroll
    for (int k = 0; k < 128; ++k) so[k * 128 + v] = S[k];
}
__global__ void __launch_bounds__(256) k_hgrn_out(const float* __restrict__ oraw, const float* __restrict__ proj, const float* __restrict__ onorm, bf16* __restrict__ OA) {
    const int row = blockIdx.x, tid = threadIdx.x;
    float o[4]; float ss = 0.f;
#pragma unroll
    for (int j = 0; j < 4; ++j) { o[j] = oraw[(size_t)row * 1024 + tid * 4 + j]; ss += o[j] * o[j]; }
#pragma unroll
    for (int s = 16; s >= 1; s >>= 1) ss += __shfl_xor(ss, s);
    const float r = rsqrtf(ss * (1.0f / 128) + EPS);
#pragma unroll
    for (int j = 0; j < 4; ++j) { const int c = tid * 4 + j; OA[(size_t)row * 1024 + c] = f2bf(o[j] * r * onorm[c] * siluf_(proj[(size_t)row * NPROJ + C_GA + c])); }
}
__device__ __forceinline__ const float* cmp_src(const float* proj, const float* cache, const int* pt, bool pr, int b, int p, int w, int kv) {
    if (pr) return proj + ((size_t)b * TP + p) * NPROJ + (w ? C_VC : C_KC) + kv * 128;
    if (p < PAST) return cache + ((size_t)pt[b * NPAGE + (p >> 7)] * PAGE + (p & 127)) * 512 + w * 256 + kv * 128;
    if (p < PAST + TS) return proj + ((size_t)MP + b * TS + (p - PAST)) * NPROJ + (w ? C_VC : C_KC) + kv * 128;
    return nullptr;
}
__global__ void __launch_bounds__(128) k_compress(const float* __restrict__ proj, const float* __restrict__ cache, const int* __restrict__ pt,
                                                  const float* __restrict__ kw1, const float* __restrict__ kb1, const float* __restrict__ kw2,
                                                  const float* __restrict__ vw1, const float* __restrict__ vb1, const float* __restrict__ vw2, const float* __restrict__ kc_g,
                                                  float* __restrict__ KCP, float* __restrict__ VCP, float* __restrict__ KCS, float* __restrict__ VCS) {
    __shared__ float hid[128]; __shared__ float red[2];
    int x = blockIdx.x; const int tid = threadIdx.x;
    const int NP = 2 * 2 * 255 * 2; bool pr; int w, b, i, kv;
    if (x < NP) { pr = true; kv = x & 1; x >>= 1; i = x % 255; x /= 255; b = x & 1; w = x >> 1; }
    else { x -= NP; pr = false; kv = x & 1; x >>= 1; i = x & 511; x >>= 9; b = x & 31; w = x >> 5; }
    const float* w1 = w ? vw1 : kw1; const float* b1 = w ? vb1 : kb1; const float* w2 = w ? vw2 : kw2;
    float acc = b1[tid];
    for (int jj = 0; jj < 32; ++jj) {
        const float* src = cmp_src(proj, cache, pt, pr, b, 16 * i + jj, w, kv);
        if (src) { const float* wr = w1 + (size_t)jj * 128 * 128 + tid; for (int d = 0; d < 128; ++d) acc += src[d] * wr[(size_t)d * 128]; }
    }
    hid[tid] = siluf_(acc); __syncthreads();
    float o = 0.f;
    for (int k = 0; k < 128; ++k) o += hid[k] * w2[k * 128 + tid];
    if (w == 0) {
        float ss = wave_sum(o * o); if ((tid & 63) == 0) red[tid >> 6] = ss; __syncthreads(); ss = red[0] + red[1];
        o = o * rsqrtf(ss * (1.0f / 128) + EPS) * kc_g[tid];
    }
    float* dst = pr ? (w ? VCP : KCP) + (((size_t)b * 256 + i) * 2 + kv) * 128 : (w ? VCS : KCS) + (((size_t)b * 512 + i) * 2 + kv) * 128;
    dst[tid] = o;
}
__global__ void __launch_bounds__(64) k_cmp_attn(const float* __restrict__ QN, const float* __restrict__ KCP, const float* __restrict__ VCP, const float* __restrict__ KCS, const float* __restrict__ VCS,
                                                 const float* __restrict__ relb, float* __restrict__ PCMP, float* __restrict__ OCMP) {
    __shared__ float q[128]; __shared__ float pl[512];
    const int row = blockIdx.x >> 3, head = blockIdx.x & 7, kv = head >> 2, lane = threadIdx.x;
    const bool pr = row < MP; const int b = pr ? (row >> 12) : ((row - MP) >> 3), qpos = pr ? (row & 4095) : PAST + ((row - MP) & 7);
    const int NC = pr ? 255 : 512; const float* KC = pr ? KCP + (size_t)b * 256 * 256 : KCS + (size_t)b * 512 * 256; const float* VC = pr ? VCP + (size_t)b * 256 * 256 : VCS + (size_t)b * 512 * 256;
    q[lane] = QN[(size_t)row * 1024 + head * 128 + lane]; q[lane + 64] = QN[(size_t)row * 1024 + head * 128 + lane + 64]; __syncthreads();
    float s[8]; float m = -INFINITY;
#pragma unroll
    for (int j = 0; j < 8; ++j) {
        const int c = lane + 64 * j; s[j] = -INFINITY;
        if (c < NC) { const int rel = qpos - (16 * c + 31); if (rel >= 0) { const float* k = KC + ((size_t)c * 2 + kv) * 128; float a = 0.f; for (int d = 0; d < 128; ++d) a += q[d] * k[d]; s[j] = a + relb[rel_bucket(rel) * 8 + head]; } }
        m = fmaxf(m, s[j]);
    }
    m = wave_max(m); if (m == -INFINITY) m = 0.f;
    float sum = 0.f;
#pragma unroll
    for (int j = 0; j < 8; ++j) { s[j] = (s[j] == -INFINITY) ? 0.f : __expf(s[j] - m); sum += s[j]; }
    sum = wave_sum(sum); const float inv = 1.0f / fmaxf(sum, 1e-30f);
#pragma unroll
    for (int j = 0; j < 8; ++j) { const int c = lane + 64 * j; const float pv = s[j] * inv; pl[c] = pv; PCMP[((size_t)row * 8 + head) * 512 + c] = pv; }
    __syncthreads();
    float o0 = 0.f, o1 = 0.f;
    for (int c = 0; c < NC; ++c) { const float pv = pl[c]; if (pv != 0.f) { const float* v = VC + ((size_t)c * 2 + kv) * 128; o0 += pv * v[lane]; o1 += pv * v[lane + 64]; } }
    OCMP[(size_t)row * 1024 + head * 128 + lane] = o0; OCMP[(size_t)row * 1024 + head * 128 + lane + 64] = o1;
}
__global__ void __launch_bounds__(64) k_select(const float* __restrict__ PCMP, int* __restrict__ IDX) {
    __shared__ float sc[192];
    const int row = blockIdx.x >> 1, kv = blockIdx.x & 1, lane = threadIdx.x;
    const bool pr = row < MP; const int qpos = pr ? (row & 4095) : PAST + ((row - MP) & 7);
    const int NC = pr ? 255 : 512, NS = pr ? 64 : 129, cur = qpos >> 6;
    const float* P = PCMP + ((size_t)row * 8 + kv * 4) * 512;
#pragma unroll
    for (int j = 0; j < 3; ++j) {
        const int s = lane + 64 * j; float v = -INFINITY;
        if (s < NS && s <= cur) {
            float imp = 0.f;
            for (int c = 4 * s - 1; c <= 4 * s + 3; ++c) if (c >= 0 && c < NC) imp += (P[c] + P[512 + c]) + (P[1024 + c] + P[1536 + c]);
            const bool forced = (s == 0) || (s == cur) || (s == cur - 1);
            v = imp + (forced ? 1.0e6f : 0.f);
        }
        sc[s] = v;
    }
    __syncthreads();
#pragma unroll
    for (int j = 0; j < 3; ++j) {
        const int s = lane + 64 * j;
        if (s < NS) { const float v = sc[s]; int rank = 0; for (int t = 0; t < NS; ++t) { const float u = sc[t]; rank += (u > v || (u == v && t < s)) ? 1 : 0; } if (rank < 16) IDX[((size_t)row * 2 + kv) * 16 + rank] = s; }
    }
}
__device__ __forceinline__ const float* sel_src(const float* out, const float* cache, const int* pt, bool pr, int b, int pos, int which, int kv) {
    if (pr) return out + O_SELP + ((size_t)b * TP + pos) * 512 + which * 256 + kv * 128;
    if (pos < PAST) return cache + ((size_t)pt[b * NPAGE + (pos >> 7)] * PAGE + (pos & 127)) * 512 + which * 256 + kv * 128;
    return out + O_SELS + ((size_t)b * TS + (pos - PAST)) * 512 + which * 256 + kv * 128;
}
__global__ void __launch_bounds__(64) k_sel_attn(const float* __restrict__ QN, const float* out, const float* __restrict__ cache, const int* __restrict__ pt, const int* __restrict__ IDX, const float* __restrict__ relb, float* __restrict__ OSEL) {
    __shared__ float q[128]; __shared__ float pl[1024];
    const int row = blockIdx.x >> 3, head = blockIdx.x & 7, kv = head >> 2, lane = threadIdx.x;
    const bool pr = row < MP; const int b = pr ? (row >> 12) : ((row - MP) >> 3), qpos = pr ? (row & 4095) : PAST + ((row - MP) & 7);
    q[lane] = QN[(size_t)row * 1024 + head * 128 + lane]; q[lane + 64] = QN[(size_t)row * 1024 + head * 128 + lane + 64]; __syncthreads();
    const int* idx = IDX + ((size_t)row * 2 + kv) * 16;
    float s[16]; float m = -INFINITY;
#pragma unroll
    for (int i = 0; i < 16; ++i) {
        const int pos = idx[i] * 64 + lane, rel = qpos - pos; s[i] = -INFINITY;
        if (rel >= 0) { const float* k = sel_src(out, cache, pt, pr, b, pos, 0, kv); float a = 0.f; for (int d = 0; d < 128; ++d) a += q[d] * k[d]; s[i] = a + relb[rel_bucket(rel) * 8 + head]; }
        m = fmaxf(m, s[i]);
    }
    m = wave_max(m); if (m == -INFINITY) m = 0.f;
    float sum = 0.f;
#pragma unroll
    for (int i = 0; i < 16; ++i) { s[i] = (s[i] == -INFINITY) ? 0.f : __expf(s[i] - m); sum += s[i]; }
    sum = wave_sum(sum); const float inv = 1.0f / fmaxf(sum, 1e-30f);
#pragma unroll
    for (int i = 0; i < 16; ++i) pl[i * 64 + lane] = s[i] * inv;
    __syncthreads();
    float o0 = 0.f, o1 = 0.f;
    for (int i = 0; i < 16; ++i) { const int base = idx[i] * 64;
        for (int j = 0; j < 64; ++j) { const float pv = pl[i * 64 + j]; if (pv != 0.f) { const float* v = sel_src(out, cache, pt, pr, b, base + j, 1, kv); o0 += pv * v[lane]; o1 += pv * v[lane + 64]; } } }
    OSEL[(size_t)row * 1024 + head * 128 + lane] = o0; OSEL[(size_t)row * 1024 + head * 128 + lane + 64] = o1;
}
__device__ __forceinline__ const float* win_src(const float* winkv, const float* cache, bool pr, int b, int t, int rel, int which, int kv) {
    if (pr) return winkv + ((size_t)b * TP + (t - rel)) * 512 + which * 256 + kv * 128;
    const int j = 512 + t - rel;
    if (j < 512) return cache + ((size_t)b * 512 + j) * 512 + which * 256 + kv * 128;
    return winkv + ((size_t)MP + b * TS + (j - 512)) * 512 + which * 256 + kv * 128;
}
__global__ void __launch_bounds__(64) k_win_attn(const float* __restrict__ QN, const float* __restrict__ winkv, const float* __restrict__ cache, const float* __restrict__ relb, float* __restrict__ OWIN) {
    __shared__ float q[128]; __shared__ float pl[512];
    const int row = blockIdx.x >> 3, head = blockIdx.x & 7, kv = head >> 2, lane = threadIdx.x;
    const bool pr = row < MP; const int b = pr ? (row >> 12) : ((row - MP) >> 3), t = pr ? (row & 4095) : ((row - MP) & 7);
    q[lane] = QN[(size_t)row * 1024 + head * 128 + lane]; q[lane + 64] = QN[(size_t)row * 1024 + head * 128 + lane + 64]; __syncthreads();
    float s[8]; float m = -INFINITY;
#pragma unroll
    for (int i = 0; i < 8; ++i) {
        const int rel = lane + 64 * i; s[i] = -INFINITY;
        const bool ok = pr ? (t - rel >= 0) : true;
        if (ok) { const float* k = win_src(winkv, cache, pr, b, t, rel, 0, kv); float a = 0.f; for (int d = 0; d < 128; ++d) a += q[d] * k[d]; s[i] = a + relb[rel_bucket(rel) * 8 + head]; }
        m = fmaxf(m, s[i]);
    }
    m = wave_max(m); if (m == -INFINITY) m = 0.f;
    float sum = 0.f;
#pragma unroll
    for (int i = 0; i < 8; ++i) { s[i] = (s[i] == -INFINITY) ? 0.f : __expf(s[i] - m); sum += s[i]; }
    sum = wave_sum(sum); const float inv = 1.0f / fmaxf(sum, 1e-30f);
#pragma unroll
    for (int i = 0; i < 8; ++i) pl[lane + 64 * i] = s[i] * inv;
    __syncthreads();
    float o0 = 0.f, o1 = 0.f;
    for (int rel = 0; rel < 512; ++rel) { const float pv = pl[rel]; if (pv != 0.f) { const float* v = win_src(winkv, cache, pr, b, t, rel, 1, kv); o0 += pv * v[lane]; o1 += pv * v[lane + 64]; } }
    OWIN[(size_t)row * 1024 + head * 128 + lane] = o0; OWIN[(size_t)row * 1024 + head * 128 + lane + 64] = o1;
}
__global__ void __launch_bounds__(256) k_nsa_combine(const float* __restrict__ proj, const float* __restrict__ OCMP, const float* __restrict__ OSEL, const float* __restrict__ OWIN, bf16* __restrict__ OB) {
    const int row = blockIdx.x, tid = threadIdx.x;
#pragma unroll
    for (int j = 0; j < 4; ++j) { const int c = tid * 4 + j, head = c >> 7; const float* g = proj + (size_t)row * NPROJ + C_GATE + head * 3; const size_t i = (size_t)row * 1024 + c;
        OB[i] = f2bf(sigmoidf_(g[0]) * OCMP[i] + sigmoidf_(g[1]) * OSEL[i] + sigmoidf_(g[2]) * OWIN[i]); }
}

template <class F> struct EpiGen {
    static constexpr bool PERM = false, AFTER_DRAIN = false;
    F f;
    __device__ __forceinline__ void operator()(const pg8::f32x4 (&acc)[2][2][4][2], const pg8::Unit& u, int wr, int wc, int fr, int fq) const {
        const int row0 = u.pm * 256 + wr * 64 + fr, col0 = u.pn * 256 + wc * 32 + 4 * fq;
#pragma unroll
        for (int ai = 0; ai < 2; ++ai)
#pragma unroll
            for (int m = 0; m < 4; ++m)
#pragma unroll
                for (int bj = 0; bj < 2; ++bj)
#pragma unroll
                    for (int n = 0; n < 2; ++n) f(row0 + ai * 128 + m * 16, col0 + bj * 128 + n * 16, acc[ai][bj][m][n]);
    }
};
struct FStoreF32 { float* C; int ldc; int pad;
    __device__ __forceinline__ void operator()(int r, int c, f32x4 v) const { *(f32x4*)(C + (size_t)r * ldc + c) = v; } };
struct FGateA { const float* proj; float* T;
    __device__ __forceinline__ void operator()(int r, int c, f32x4 v) const { const f32x4 g = *(const f32x4*)(proj + (size_t)r * NPROJ + C_MGA + c); f32x4 o;
#pragma unroll
        for (int j = 0; j < 4; ++j) o[j] = sigmoidf_(g[j]) * v[j];
        *(f32x4*)(T + (size_t)r * D + c) = o; } };
struct FGateB { const float* proj; const float* T; bf16* merged;
    __device__ __forceinline__ void operator()(int r, int c, f32x4 v) const { const f32x4 g = *(const f32x4*)(proj + (size_t)r * NPROJ + C_MGB + c); const f32x4 t = *(const f32x4*)(T + (size_t)r * D + c); ushort4 o;
        o.x = f2bf(t[0] + sigmoidf_(g[0]) * v[0]); o.y = f2bf(t[1] + sigmoidf_(g[1]) * v[1]); o.z = f2bf(t[2] + sigmoidf_(g[2]) * v[2]); o.w = f2bf(t[3] + sigmoidf_(g[3]) * v[3]);
        *(ushort4*)(merged + (size_t)r * D + c) = o; } };
struct FRes1 { const float* xp; const float* xs; const float* mods; float* X1;
    __device__ __forceinline__ void operator()(int r, int c, f32x4 v) const { const float* x = r < MP ? xp + (size_t)r * D : xs + (size_t)(r - MP) * D; const f32x4 xv = *(const f32x4*)(x + c);
        const f32x4 g = *(const f32x4*)(mods + (size_t)modrow(r) * NMOD + 2 * D + c); *(f32x4*)(X1 + (size_t)r * D + c) = xv + g * v; } };
struct FRelu2 { bf16* U;
    __device__ __forceinline__ void operator()(int r, int c, f32x4 v) const { ushort4 o; float a;
        a = fmaxf(v[0], 0.f); o.x = f2bf(a * a); a = fmaxf(v[1], 0.f); o.y = f2bf(a * a); a = fmaxf(v[2], 0.f); o.z = f2bf(a * a); a = fmaxf(v[3], 0.f); o.w = f2bf(a * a);
        *(ushort4*)(U + (size_t)r * DFF + c) = o; } };
struct FRes2 { const float* X1; const float* mods; float* out;
    __device__ __forceinline__ void operator()(int r, int c, f32x4 v) const { const f32x4 xv = *(const f32x4*)(X1 + (size_t)r * D + c);
        const f32x4 g = *(const f32x4*)(mods + (size_t)modrow(r) * NMOD + 5 * D + c); *(f32x4*)(out + (size_t)r * D + c) = xv + g * v; } };

template <class Epi> __global__ __launch_bounds__(512, 2) void k_gemm(pg8::Gemm g, Epi E) {
    extern __shared__ __attribute__((aligned(16))) unsigned char shm[];
    pg8::StaticOrder S; S.init(g.M, g.N, (int)gridDim.x, (int)blockIdx.x);
    pg8::gemm_phase<Epi, pg8::StaticOrder, false>((PG8_LAS unsigned char*)shm, g, S, E, nullptr);
}
template <class Epi> static void launch_gemm(const bf16* A, const bf16* Bt, int M, int N, int K, const Epi& E, hipStream_t st) {
    static bool attr = false;
    if (!attr) { (void)hipFuncSetAttribute((const void*)k_gemm<Epi>, hipFuncAttributeMaxDynamicSharedMemorySize, pg8::STAGE_BYTES); attr = true; }
    pg8::Gemm g{A, Bt, M, N, K};
    hipLaunchKernelGGL((k_gemm<Epi>), dim3(256), dim3(512), pg8::STAGE_BYTES, st, g, E);
}

extern "C" void kernel_launch(void* const* d_in, const int* in_sizes, int n_in, void* d_out, int out_size, void* d_ws, size_t ws_size, hipStream_t stream) {
    (void)in_sizes; (void)n_in; (void)out_size; (void)ws_size;
    const float* x_p = (const float*)d_in[0]; const float* x_s = (const float*)d_in[1]; const float* c_p = (const float*)d_in[2]; const float* c_s = (const float*)d_in[3];
    const float* cache_cmp = (const float*)d_in[4]; const float* cache_sel = (const float*)d_in[5]; const float* cache_win = (const float*)d_in[6]; const float* state = (const float*)d_in[7];
    const int* pt = (const int*)d_in[8]; const float* lbl = (const float*)d_in[9]; const float* relb = (const float*)d_in[10]; const float* ada_w = (const float*)d_in[11]; const float* ada_b = (const float*)d_in[12];
    const float* norm1 = (const float*)d_in[13]; const float* norm2 = (const float*)d_in[14]; const float* w_in = (const float*)d_in[15]; const float* onorm = (const float*)d_in[16];
    const float* qn_g = (const float*)d_in[17]; const float* kc_g = (const float*)d_in[18]; const float* ks_g = (const float*)d_in[19]; const float* kw_g = (const float*)d_in[20];
    const float* kw1 = (const float*)d_in[21]; const float* kb1 = (const float*)d_in[22]; const float* kw2 = (const float*)d_in[23]; const float* vw1 = (const float*)d_in[24]; const float* vb1 = (const float*)d_in[25]; const float* vw2 = (const float*)d_in[26];
    const float* w_ba = (const float*)d_in[27]; const float* w_bb = (const float*)d_in[28]; const float* w_out = (const float*)d_in[29]; const float* w1 = (const float*)d_in[30]; const float* w2 = (const float*)d_in[31];
    float* out = (float*)d_out;
    size_t off = 0; auto alloc = [&](size_t bytes) { void* p = (char*)d_ws + off; off += (bytes + 255) & ~(size_t)255; return p; };
    bf16* Wt_in = (bf16*)alloc((size_t)NPROJ * D * 2); bf16* Wt_ba = (bf16*)alloc((size_t)D * 1024 * 2); bf16* Wt_bb = (bf16*)alloc((size_t)D * 1024 * 2);
    bf16* Wt_out = (bf16*)alloc((size_t)D * D * 2); bf16* Wt_1 = (bf16*)alloc((size_t)DFF * D * 2); bf16* Wt_2 = (bf16*)alloc((size_t)D * DFF * 2);
    float* mods = (float*)alloc((size_t)34 * NMOD * 4); bf16* H = (bf16*)alloc((size_t)MT * D * 2); float* proj = (float*)alloc((size_t)MT * NPROJ * 4);
    float* winkv = (float*)alloc((size_t)MT * 512 * 4); float* QN = (float*)alloc((size_t)MT * 1024 * 4); float* F = (float*)alloc((size_t)MT * 1024 * 4); float* oraw = (float*)alloc((size_t)MT * 1024 * 4);
    bf16* OA = (bf16*)alloc((size_t)MT * 1024 * 2); bf16* OB = (bf16*)alloc((size_t)MT * 1024 * 2);
    float* KCP = (float*)alloc((size_t)2 * 256 * 256 * 4); float* VCP = (float*)alloc((size_t)2 * 256 * 256 * 4); float* KCS = (float*)alloc((size_t)32 * 512 * 256 * 4); float* VCS = (float*)alloc((size_t)32 * 512 * 256 * 4);
    float* PCMP = (float*)alloc((size_t)MT * 8 * 512 * 4); int* IDX = (int*)alloc((size_t)MT * 2 * 16 * 4);
    float* OCMP = (float*)alloc((size_t)MT * 1024 * 4); float* OSEL = (float*)alloc((size_t)MT * 1024 * 4); float* OWIN = (float*)alloc((size_t)MT * 1024 * 4);
    float* T = (float*)alloc((size_t)MT * D * 4); bf16* MERGED = (bf16*)alloc((size_t)MT * D * 2); float* X1 = (float*)alloc((size_t)MT * D * 4); bf16* U = (bf16*)alloc((size_t)MT * DFF * 2);

    hipLaunchKernelGGL(k_transpose, dim3(NPROJ / 64, D / 64), dim3(256), 0, stream, w_in, D, IN_COLS, Wt_in, NPROJ, 1);
    hipLaunchKernelGGL(k_transpose, dim3(D / 64, 1024 / 64), dim3(256), 0, stream, w_ba, 1024, D, Wt_ba, D, 0);
    hipLaunchKernelGGL(k_transpose, dim3(D / 64, 1024 / 64), dim3(256), 0, stream, w_bb, 1024, D, Wt_bb, D, 0);
    hipLaunchKernelGGL(k_transpose, dim3(D / 64, D / 64), dim3(256), 0, stream, w_out, D, D, Wt_out, D, 0);
    hipLaunchKernelGGL(k_transpose, dim3(DFF / 64, D / 64), dim3(256), 0, stream, w1, D, DFF, Wt_1, DFF, 0);
    hipLaunchKernelGGL(k_transpose, dim3(D / 64, DFF / 64), dim3(256), 0, stream, w2, DFF, D, Wt_2, D, 0);
    hipLaunchKernelGGL(k_mods, dim3(NMOD / 256, 34), dim3(256), 0, stream, c_p, c_s, ada_w, ada_b, mods);
    hipLaunchKernelGGL(k_hnorm, dim3(MT), dim3(256), 0, stream, x_p, x_s, norm1, (const float*)mods, 0, 1, H);
    { EpiGen<FStoreF32> E{}; E.f.C = proj; E.f.ldc = NPROJ; E.f.pad = 0; launch_gemm(H, Wt_in, MT, NPROJ, D, E, stream); }
    hipLaunchKernelGGL(k_post_proj, dim3(MT), dim3(256), 0, stream, (const float*)proj, lbl, qn_g, ks_g, kw_g, out, winkv, QN, F);
    hipLaunchKernelGGL(k_win_roll, dim3(2048), dim3(256), 0, stream, cache_win, out);
    hipLaunchKernelGGL(k_hgrn_seq, dim3(16 + 256), dim3(128), 0, stream, (const float*)proj, (const float*)F, state, oraw, out);
    hipLaunchKernelGGL(k_hgrn_out, dim3(MT), dim3(256), 0, stream, (const float*)oraw, (const float*)proj, onorm, OA);
    hipLaunchKernelGGL(k_compress, dim3(2040 + 65536), dim3(128), 0, stream, (const float*)proj, cache_cmp, pt, kw1, kb1, kw2, vw1, vb1, vw2, kc_g, KCP, VCP, KCS, VCS);
    hipLaunchKernelGGL(k_cmp_attn, dim3(MT * 8), dim3(64), 0, stream, (const float*)QN, (const float*)KCP, (const float*)VCP, (const float*)KCS, (const float*)VCS, relb, PCMP, OCMP);
    hipLaunchKernelGGL(k_select, dim3(MT * 2), dim3(64), 0, stream, (const float*)PCMP, IDX);
    hipLaunchKernelGGL(k_sel_attn, dim3(MT * 8), dim3(64), 0, stream, (const float*)QN, (const float*)out, cache_sel, pt, (const int*)IDX, relb, OSEL);
    hipLaunchKernelGGL(k_win_attn, dim3(MT * 8), dim3(64), 0, stream, (const float*)QN, (const float*)winkv, cache_win, relb, OWIN);
    hipLaunchKernelGGL(k_nsa_combine, dim3(MT), dim3(256), 0, stream, (const float*)proj, (const float*)OCMP, (const float*)OSEL, (const float*)OWIN, OB);
    { EpiGen<FGateA> E{}; E.f.proj = proj; E.f.T = T; launch_gemm(OA, Wt_ba, MT, D, 1024, E, stream); }
    { EpiGen<FGateB> E{}; E.f.proj = proj; E.f.T = T; E.f.merged = MERGED; launch_gemm(OB, Wt_bb, MT, D, 1024, E, stream); }
    { EpiGen<FRes1> E{}; E.f.xp = x_p; E.f.xs = x_s; E.f.mods = mods; E.f.X1 = X1; launch_gemm(MERGED, Wt_out, MT, D, D, E, stream); }
    hipLaunchKernelGGL(k_hnorm, dim3(MT), dim3(256), 0, stream, (const float*)X1, (const float*)(X1 + (size_t)MP * D), norm2, (const float*)mods, 3, 4, H);
    { EpiGen<FRelu2> E{}; E.f.U = U; launch_gemm(H, Wt_1, MT, DFF, D, E, stream); }
    { EpiGen<FRes2> E{}; E.f.X1 = X1; E.f.mods = mods; E.f.out = out; launch_gemm(U, Wt_2, MT, D, DFF, E, stream); }
}
```

```cpp
#include <hip/hip_runtime.h>
#include <stdint.h>
#include <math.h>
#include <cstdio>

namespace pg8 {
#define PG8_LAS __attribute__((address_space(3)))
typedef unsigned short bf16_t;
typedef short bf16x8 __attribute__((ext_vector_type(8)));
typedef float f32x4 __attribute__((ext_vector_type(4)));
typedef unsigned u32x4 __attribute__((ext_vector_type(4)));
constexpr int BM = 256, BK = 64, HALF = 128, HTB = HALF * BK * 2  , STAGE_BYTES = 8 * HTB, NXCD = 8, WGM = 8;

__host__ __device__ __forceinline__ int lds_byte(int r, int c) { const int st = (r >> 4) * 2 + (c >> 5), rr = r & 15, cc = c & 31, ob = rr * 64 + cc * 2; return st * 1024 + (ob ^ (((ob >> 9) & 1) << 5)); }
__host__ __device__ __forceinline__ void stage_rc(int b, int& R, int& C) { const int st = b / 1024, sb = b % 1024, swz = sb ^ (((sb >> 9) & 1) << 5); R = (st >> 1) * 16 + swz / 64; C = (st & 1) * 32 + (swz % 64) / 2; }
__host__ __device__ __forceinline__ int perm32(int rho) { const int n = rho >> 4, i = rho & 15; return 8 * (i >> 2) + 4 * n + (i & 3); }

struct Unit { int pm, pn, k0, nt, sel; };
struct Gemm { const bf16_t* A; const bf16_t* Bt; int M, N, K, ld; const bf16_t* A2; const bf16_t* Bt2; };

struct StaticOrder {
    int nM, nN, nwg, G, c, nt0;
    __host__ __device__ void init(int M, int N, int G_, int c_, int K_ = 0) { nM = M / BM; nN = N / BM; nwg = nM * nN; G = G_; c = c_; nt0 = K_ / BK; }
    __host__ __device__ bool next(int i, Unit& u) const {
        const long L = (long)i * G + c; if (L >= nwg) return false;
        int wgid = (int)L; { const int q = nwg / NXCD, r = nwg % NXCD, xcd = wgid % NXCD, off = wgid / NXCD; wgid = (xcd < r ? xcd * (q + 1) : r * (q + 1) + (xcd - r) * q) + off; }
        const int nig = WGM * nN, gid = wgid / nig, fm = gid * WGM, gsz = (nM - fm) < WGM ? (nM - fm) : WGM;
        u.pm = fm + ((wgid % nig) % gsz); u.pn = (wgid % nig) / gsz; u.k0 = 0; u.nt = nt0; u.sel = 0; return true;
    }
    __device__ __forceinline__ void a_ready(const Unit&) const {}
    __device__ __forceinline__ void done(const Unit&) const {}
};
template <class Epi, class Sched, bool STAMP = false>
__device__ __forceinline__ void gemm_phase(PG8_LAS unsigned char* lds, const Gemm g, const Sched& S, const Epi& E, unsigned long long* stamps, int pg8_wave_id) {
    const int wid = __builtin_amdgcn_readfirstlane(pg8_wave_id), lane = (int)__builtin_amdgcn_mbcnt_hi(~0u, __builtin_amdgcn_mbcnt_lo(~0u, 0u)), tid = wid * 64 + lane, wr = wid >> 2, wc = wid & 3, fr = lane & 15, fq = lane >> 4;
    const int K = g.ld;
    int ts_lo = 0, ts_hi = 0, nts = 0; const unsigned long long rt_entry = STAMP ? (unsigned long long)wall_clock64() : 0ull;
#define PG8_STAMP() do { if (STAMP && wid == 0 && nts < 64) { const unsigned long long _c = (unsigned long long)clock64(); \
        ts_lo = (lane == nts) ? (int)(unsigned)_c : ts_lo; ts_hi = (lane == nts) ? (int)(unsigned)(_c >> 32) : ts_hi; ++nts; } } while (0)
    PG8_STAMP();
    unsigned voffA[2], voffB[2];
#pragma unroll
    for (int i = 0; i < 2; ++i) { int R, C; stage_rc(tid * 16 + i * 8192, R, C); const int Rb = Epi::PERM ? ((R & ~31) + perm32(R & 31)) : R;
        voffA[i] = (unsigned)(R * K + C) * 2u; voffB[i] = (unsigned)(Rb * K + C) * 2u; }
    const size_t kstep = (size_t)(BK * 2);
    const size_t hstep = (size_t)HALF * K * 2;
    const size_t tstep = 2 * hstep;
    const unsigned ldsw = (unsigned)wid * 1024u;
    const int aoff = lds_byte(wr * 64 + fr, fq * 8), boff = lds_byte(wc * 32 + fr, fq * 8);
#define PG8_SA(b, h) (((b) * 2 + (h)) * HTB)
#define PG8_SB(b, h) ((4 + (b) * 2 + (h)) * HTB)
#define PG8_STAGE(bufoff, gbase, voff) do { _Pragma("unroll") for (int _i = 0; _i < 2; ++_i) \
        __builtin_amdgcn_global_load_lds((const unsigned*)((const char*)(gbase) + (voff)[_i]), (PG8_LAS unsigned*)(lds + (bufoff) + ldsw + _i * 8192), 16, 0, 0); } while (0)
#define PG8_LDA(dst, b, h) do { _Pragma("unroll") for (int m = 0; m < 4; ++m) _Pragma("unroll") for (int k = 0; k < 2; ++k) dst[m][k] = *(const PG8_LAS bf16x8*)(lds + PG8_SA(b, h) + aoff + m * 2048 + k * 1024); } while (0)
#define PG8_LDB(dst, b, h) do { _Pragma("unroll") for (int n = 0; n < 2; ++n) _Pragma("unroll") for (int k = 0; k < 2; ++k) dst[n][k] = *(const PG8_LAS bf16x8*)(lds + PG8_SB(b, h) + boff + n * 2048 + k * 1024); } while (0)
#define PG8_MMA(ai, bj, At, Bt) do { __builtin_amdgcn_s_setprio(1); _Pragma("unroll") for (int m = 0; m < 4; ++m) _Pragma("unroll") for (int n = 0; n < 2; ++n) _Pragma("unroll") for (int k = 0; k < 2; ++k) \
        acc[ai][bj][m][n] = __builtin_amdgcn_mfma_f32_16x16x32_bf16(Bt[n][k], At[m][k], acc[ai][bj][m][n], 0, 0, 0); __builtin_amdgcn_s_setprio(0); } while (0)
#define PG8_WAIT_V(n) asm volatile("s_waitcnt vmcnt(" #n ")" ::: "memory")
#define PG8_WAIT_L(n) asm volatile("s_waitcnt lgkmcnt(" #n ")" ::: "memory")
#define PG8_BAR __builtin_amdgcn_s_barrier()
#define PG8_SCHED __builtin_amdgcn_sched_barrier(0)
    Unit cur, nxt; int ui = 0;
    if (!S.next(0, cur)) return;
    f32x4 acc[2][2][4][2];
#pragma unroll
    for (int a = 0; a < 2; ++a)
#pragma unroll
        for (int b = 0; b < 2; ++b)
#pragma unroll
            for (int m = 0; m < 4; ++m)
#pragma unroll
                for (int n = 0; n < 2; ++n) acc[a][b][m][n] = (f32x4){0.f, 0.f, 0.f, 0.f};
    bf16x8 At[4][2], B0[2][2], B1[2][2];
    const char* cA = (const char*)(cur.sel ? g.A2 : g.A) + (size_t)cur.pm * tstep + (size_t)cur.k0 * 2; const char* cB = (const char*)(cur.sel ? g.Bt2 : g.Bt) + (size_t)cur.pn * tstep + (size_t)cur.k0 * 2;
    S.a_ready(cur);
    PG8_STAGE(PG8_SB(0, 0), cB, voffB); PG8_STAGE(PG8_SA(0, 0), cA, voffA); PG8_STAGE(PG8_SB(0, 1), cB + hstep, voffB); PG8_STAGE(PG8_SA(0, 1), cA + hstep, voffA);
    if (wr == 1) PG8_BAR;
    PG8_WAIT_V(4); PG8_BAR;
    PG8_STAGE(PG8_SB(1, 0), cB + kstep, voffB); PG8_STAGE(PG8_SA(1, 0), cA + kstep, voffA); PG8_STAGE(PG8_SB(1, 1), cB + hstep + kstep, voffB);
    PG8_WAIT_V(6); PG8_BAR;
    PG8_STAMP();
    for (;;) {
        const bool has_next = S.next(ui + 1, nxt);
        const char* nA = has_next ? (const char*)(nxt.sel ? g.A2 : g.A) + (size_t)nxt.pm * tstep + (size_t)nxt.k0 * 2 : cA; const char* nB = has_next ? (const char*)(nxt.sel ? g.Bt2 : g.Bt) + (size_t)nxt.pn * tstep + (size_t)nxt.k0 * 2 : cB;
        const int nt = cur.nt;
        for (int t = 0; t < nt; t += 2) {
            const bool last = (t == nt - 2);
            const char* a1 = cA + (size_t)(t + 1) * kstep;
            const char* a2 = last ? nA : cA + (size_t)(t + 2) * kstep; const char* b2 = last ? nB : cB + (size_t)(t + 2) * kstep;
            const char* a3 = a2 + kstep; const char* b3 = b2 + kstep;
            if (last && has_next) S.a_ready(nxt);
            PG8_LDB(B0, 0, 0); PG8_SCHED; PG8_LDA(At, 0, 0); PG8_STAGE(PG8_SA(1, 1), a1 + hstep, voffA);
            PG8_WAIT_L(8); PG8_BAR; PG8_WAIT_L(0); PG8_MMA(0, 0, At, B0); PG8_BAR; PG8_SCHED;
            PG8_LDB(B1, 0, 1); PG8_STAGE(PG8_SB(0, 0), b2, voffB);
            PG8_BAR; PG8_WAIT_L(0); PG8_MMA(0, 1, At, B1); PG8_BAR;
            PG8_LDA(At, 0, 1); PG8_STAGE(PG8_SA(0, 0), a2, voffA);
            PG8_BAR; PG8_WAIT_L(0); PG8_MMA(1, 0, At, B0); PG8_BAR; PG8_SCHED;
            PG8_STAGE(PG8_SB(0, 1), b2 + hstep, voffB);
            PG8_WAIT_V(6); PG8_BAR; PG8_MMA(1, 1, At, B1); PG8_BAR;
            PG8_LDB(B0, 1, 0); PG8_SCHED; PG8_LDA(At, 1, 0); PG8_STAGE(PG8_SA(0, 1), a2 + hstep, voffA);
            PG8_WAIT_L(8); PG8_BAR; PG8_WAIT_L(0); PG8_MMA(0, 0, At, B0); PG8_BAR; PG8_SCHED;
            PG8_LDB(B1, 1, 1); PG8_STAGE(PG8_SB(1, 0), b3, voffB);
            PG8_BAR; PG8_WAIT_L(0); PG8_MMA(0, 1, At, B1); PG8_BAR;
            PG8_LDA(At, 1, 1); PG8_STAGE(PG8_SA(1, 0), a3, voffA);
            PG8_BAR; PG8_WAIT_L(0); PG8_MMA(1, 0, At, B0); PG8_BAR; PG8_SCHED;
            PG8_STAGE(PG8_SB(1, 1), b3 + hstep, voffB);
            PG8_WAIT_V(6); PG8_BAR; PG8_MMA(1, 1, At, B1); PG8_BAR;
        }
        PG8_STAMP();
        if constexpr (!Epi::AFTER_DRAIN) { E(acc, cur, wr, wc, fr, fq); S.done(cur); }
        PG8_STAMP();
        if (!has_next) break;
#pragma unroll
        for (int a = 0; a < 2; ++a)
#pragma unroll
            for (int b = 0; b < 2; ++b)
#pragma unroll
                for (int m = 0; m < 4; ++m)
#pragma unroll
                    for (int n = 0; n < 2; ++n) acc[a][b][m][n] = (f32x4){0.f, 0.f, 0.f, 0.f};
        cur = nxt; cA = nA; cB = nB; ++ui;
    }
    PG8_WAIT_V(0);
    if (wr == 0) PG8_BAR;
    PG8_BAR;
    if constexpr (Epi::AFTER_DRAIN) { E.fused(acc, cur, wr, wc, fr, fq, lds, wid, lane); S.done(cur); }
    PG8_STAMP();
    if (STAMP && wid == 0) { stamps[lane] = lane < nts ? (((unsigned long long)(unsigned)ts_hi << 32) | (unsigned)ts_lo) : 0ull;
        if (lane == 62) stamps[62] = rt_entry; if (lane == 63) stamps[63] = (unsigned long long)wall_clock64(); }
#undef PG8_STAMP
#undef PG8_SA
#undef PG8_SB
#undef PG8_STAGE
#undef PG8_LDA
#undef PG8_LDB
#undef PG8_MMA
#undef PG8_WAIT_V
#undef PG8_WAIT_L
#undef PG8_BAR
#undef PG8_SCHED
}
}

#define XB_TMO      128
#define XB_XCNT(j)  (256  + 64 * (j))
#define XB_XSUB(j)  (1280 + 64 * (j))
#define XB_XGEN(j)  (2304 + 64 * (j))
#define XB_TOP      3328
#define XB_TOPGEN   3392
#define XCD_BAR_WORDS 3456
#define XB_SPIN_CAP (1u << 22)
#define LAS __attribute__((address_space(3)))

__device__ __forceinline__ unsigned xb_ld(unsigned* p)              { return __hip_atomic_load(p, __ATOMIC_RELAXED, __HIP_MEMORY_SCOPE_AGENT); }
__device__ __forceinline__ unsigned xb_add(unsigned* p, unsigned v) { return __hip_atomic_fetch_add(p, v, __ATOMIC_RELAXED, __HIP_MEMORY_SCOPE_AGENT); }
__device__ __forceinline__ unsigned xb_xcc_id() { return (unsigned)__builtin_amdgcn_s_getreg((3 << 11) | 20) & 0xFu; }
#define XB_SPIN(cond, bar) do { unsigned _sp = 0; while (cond) { __builtin_amdgcn_s_sleep(1); \
    if ((++_sp & 255u) == 0u) { if (xb_ld(&(bar)[XB_TMO])) break; if (_sp > XB_SPIN_CAP) { atomicAdd(&(bar)[XB_TMO], 1u); break; } } } } while (0)

#define xb_thread0() (xb_wave_s == 0 && __builtin_amdgcn_mbcnt_hi(~0u, __builtin_amdgcn_mbcnt_lo(~0u, 0u)) == 0u)
struct XcdBarrier {
    unsigned* bar; unsigned x;
    volatile LAS unsigned* st;
};

__device__ __forceinline__ XcdBarrier xcd_barrier_post(unsigned* bar, volatile LAS unsigned* st, int xb_wave_s) {
    XcdBarrier b; b.bar = bar; b.x = xb_xcc_id(); b.st = st;
    if (xb_thread0()) (void)xb_add(&bar[XB_XCNT(b.x)], 1u);
    return b;
}
__device__ __forceinline__ void xcd_barrier_complete(unsigned* bar, unsigned x, unsigned& nloc, unsigned& nx) {
    const unsigned G = gridDim.x * gridDim.y * gridDim.z;
    unsigned sum, cnt, mine, sp = 0u;
    for (;;) {
        sum = 0u; cnt = 0u; mine = 0u;
#pragma unroll
        for (unsigned j = 0; j < 16; ++j) { const unsigned c = xb_ld(&bar[XB_XCNT(j)]); sum += c; cnt += (c > 0u) ? 1u : 0u; mine = (j == x) ? c : mine; }
        if (sum == G) break;
        __builtin_amdgcn_s_sleep(1);
        if ((++sp & 255u) == 0u) { if (xb_ld(&bar[XB_TMO])) break; if (sp > XB_SPIN_CAP) { atomicAdd(&bar[XB_TMO], 1u); break; } }
    }
    nloc = mine > 0u ? mine : 1u; nx = cnt > 0u ? cnt : 1u;
}

__device__ __forceinline__ void xcd_barrier(const XcdBarrier& b, int xb_wave_s) {
    asm volatile("s_waitcnt vmcnt(0)" ::: "memory");
    __syncthreads();
    if (xb_thread0()) {
        unsigned* bar = b.bar;
        __builtin_amdgcn_s_waitcnt(0);
        unsigned nloc = b.st[0], nx = b.st[1];
        if (nloc == 0u) { xcd_barrier_complete(bar, b.x, nloc, nx); b.st[0] = nloc; b.st[1] = nx; }
        const unsigned old = xb_add(&bar[XB_XSUB(b.x)], 1u);
        const unsigned gen = old / nloc;
        if (old + 1u == (gen + 1u) * nloc) {
            __builtin_amdgcn_fence(__ATOMIC_RELEASE, "agent");
            asm volatile("s_waitcnt vmcnt(0)" ::: "memory");
            const unsigned og = xb_add(&bar[XB_TOP], 1u);
            const unsigned tg = og / nx;
            if (og + 1u == (tg + 1u) * nx) xb_add(&bar[XB_TOPGEN], 1u);
            else XB_SPIN(xb_ld(&bar[XB_TOPGEN]) == tg, bar);
            __builtin_amdgcn_fence(__ATOMIC_ACQUIRE, "agent");
            xb_add(&bar[XB_XGEN(b.x)], 1u);
            asm volatile("s_waitcnt vmcnt(0)" ::: "memory");
        } else {
            XB_SPIN(xb_ld(&bar[XB_XGEN(b.x)]) == gen, bar);
            __builtin_amdgcn_fence(__ATOMIC_ACQUIRE, "agent");
            asm volatile("s_waitcnt vmcnt(0)" ::: "memory");
        }
    }
    __syncthreads();
}

typedef unsigned short bf16;
typedef float f32x4 __attribute__((ext_vector_type(4)));
typedef float f32x2 __attribute__((ext_vector_type(2)));
constexpr int D = 2048, TP = 4096, MP = 8192, BS = 32, TS = 8, MS = 256, MT = 8448;
constexpr int PAST = 8192, NPAGE = 64, PAGE = 128, NMOD = 12288, DFF = 8192;
constexpr int NPROJ = 11008;
constexpr int C_QA = 0, C_ZA = 1024, C_IA = 2048, C_GA = 3072, C_QB = 4096, C_KC = 5120, C_VC = 5376, C_KS = 5632, C_VS = 5888, C_KW = 6144, C_VW = 6400, C_MGA = 6656, C_MGB = 8704, C_GATE = 10752;
constexpr int IN_COLS = 10776;
constexpr int LQ = 1024 + 64, LMG = 2048 + 64;
constexpr size_t O_YP = 0, O_YS = 16777216, O_CMPP = 17301504, O_CMPS = 21495808, O_SELP = 21626880, O_SELS = 25821184, O_WINP = 25952256, O_WINS = 26476544, O_HGP = 34865152, O_HGS = 35127296, O_END = 39321600;
constexpr float EPS = 1e-6f;
typedef short bf16x8 __attribute__((ext_vector_type(8)));
typedef float f32x16 __attribute__((ext_vector_type(16)));
typedef float f32x2_t __attribute__((ext_vector_type(2))); typedef __bf16 bf16x2_t __attribute__((ext_vector_type(2)));
typedef unsigned u32x4 __attribute__((ext_vector_type(4)));
constexpr float LOG2E = 1.4426950408889634f;
__device__ __forceinline__ unsigned cvtpk(float lo, float hi) { f32x2_t v = {lo, hi}; bf16x2_t b = __builtin_convertvector(v, bf16x2_t); return __builtin_bit_cast(unsigned, b); }

__device__ __forceinline__ bf16 f2bf(float f) { unsigned u = __float_as_uint(f); u += 0x7FFFu + ((u >> 16) & 1u); return (bf16)(u >> 16); }
__device__ __forceinline__ float bf2f(bf16 b) { return __uint_as_float(((unsigned)b) << 16); }
__device__ __forceinline__ float sigmoidf_(float x) { return __builtin_amdgcn_rcpf(1.0f + __builtin_amdgcn_exp2f(-1.4426950408889634f * x)); }
__device__ __forceinline__ float siluf_(float x) { return x * sigmoidf_(x); }
__device__ __forceinline__ int modrow(int r) { return r < MP ? (r >> 12) : 2 + ((r - MP) >> 3); }
__device__ __forceinline__ int win_col(int n) {
    if (n < C_MGA) return n;
    if (n < C_MGB) return 6680 + (n - C_MGA);
    if (n < C_GATE) return 8728 + (n - C_MGB);
    if (n < C_GATE + 24) return 6656 + (n - C_GATE);
    return -1;
}
__device__ __forceinline__ int rel_bucket(int rel) {
    const int n = rel > 0 ? rel : 0;
    if (n < 16) return n;
    const float nf = (float)n;
    const int large = 16 + (int)(logf(nf / 16.0f) / 2.0794415416798357f * 16.0f);
    return large < 31 ? large : 31;
}
__device__ __forceinline__ float wave_sum(float v) {
#pragma unroll
    for (int o = 32; o >= 1; o >>= 1) v += __shfl_xor(v, o);
    return v;
}
__device__ __forceinline__ float wave_max(float v) {
#pragma unroll
    for (int o = 32; o >= 1; o >>= 1) v = fmaxf(v, __shfl_xor(v, o));
    return v;
}

__device__ __forceinline__ void b_transpose128(const float* __restrict__ W, int ldw, int c0, int lim, bf16* __restrict__ Wt, int K, int n0, int k0, int tid, float* tile) {
#pragma unroll
    for (int p = 0; p < 8; ++p) { const int k = p * 16 + (tid >> 5), n4 = (tid & 31) * 4; f32x4 v = {0.f, 0.f, 0.f, 0.f};
        if (n4 < lim) v = *(const f32x4*)(W + (size_t)(k0 + k) * ldw + c0 + n4);
        float* t = tile + k * 129 + n4; t[0] = v[0]; t[1] = v[1]; t[2] = v[2]; t[3] = v[3]; }
    __syncthreads();
#pragma unroll
    for (int p = 0; p < 4; ++p) { const int n = p * 32 + (tid >> 4), kg = tid & 15; const float* t = tile + (8 * kg) * 129 + n;
        u32x4 w; w.x = cvtpk(t[0], t[129]); w.y = cvtpk(t[2 * 129], t[3 * 129]); w.z = cvtpk(t[4 * 129], t[5 * 129]); w.w = cvtpk(t[6 * 129], t[7 * 129]);
        *(u32x4*)(Wt + (size_t)(n0 + n) * K + k0 + 8 * kg) = w; }
    __syncthreads();
}
__device__ __forceinline__ void b_mods_part(const float* __restrict__ cp, const float* __restrict__ cs, const float* __restrict__ ada_w, float* __restrict__ MODP, int cg, int kc, int tid, float* tbl) {
    float* accl = tbl + 34 * 256;
    for (int u = tid; u < 34 * 256; u += 512) { const int r = u >> 8, k = 256 * kc + (u & 255); const float* c = r < 2 ? cp + r * D : cs + (r - 2) * D; tbl[u] = siluf_(c[k]); }
    __syncthreads();
    const int col = cg * 512 + tid;
#pragma unroll 1
    for (int k0 = 0; k0 < 256; k0 += 64) {
        float w[64];
        const float* wp = ada_w + (size_t)(256 * kc + k0) * NMOD + col;
#pragma unroll
        for (int j = 0; j < 64; ++j) w[j] = wp[(size_t)j * NMOD];
#pragma unroll 1
        for (int r = 0; r < 34; ++r) {
            float a0 = (k0 == 0) ? 0.f : accl[r * 512 + tid], a1 = 0.f;
#pragma unroll
            for (int j = 0; j < 64; j += 8) { const f32x4 s4 = *(const f32x4*)(tbl + r * 256 + k0 + j), t4 = *(const f32x4*)(tbl + r * 256 + k0 + j + 4);
                a0 += (s4[0] * w[j] + s4[1] * w[j + 1]) + (s4[2] * w[j + 2] + s4[3] * w[j + 3]); a1 += (t4[0] * w[j + 4] + t4[1] * w[j + 5]) + (t4[2] * w[j + 6] + t4[3] * w[j + 7]); }
            accl[r * 512 + tid] = a0 + a1;
        }
    }
    for (int r = 0; r < 34; ++r) MODP[((size_t)kc * 34 + r) * NMOD + col] = accl[r * 512 + tid];
    __syncthreads();
}
__device__ __forceinline__ void b_hnorm_wave(const float* __restrict__ xa, const float* __restrict__ xb, const float* __restrict__ gain, const float* __restrict__ mods, int sh_idx, int sc_idx, bf16* __restrict__ out, int row, int lane) {
    const float* x = row < MP ? xa + (size_t)row * D : xb + (size_t)(row - MP) * D;
    f32x4 v[8]; float ss = 0.f;
#pragma unroll
    for (int j = 0; j < 8; ++j) { v[j] = *(const f32x4*)(x + j * 256 + lane * 4); ss += (v[j][0] * v[j][0] + v[j][1] * v[j][1]) + (v[j][2] * v[j][2] + v[j][3] * v[j][3]); }
    ss = wave_sum(ss);
    const float r = rsqrtf(ss * (1.0f / D) + EPS);
    const float* m = mods + (size_t)modrow(row) * NMOD;
#pragma unroll
    for (int j = 0; j < 8; ++j) { const int c = j * 256 + lane * 4; const f32x4 g = *(const f32x4*)(gain + c), sc = *(const f32x4*)(m + sc_idx * D + c), sh = *(const f32x4*)(m + sh_idx * D + c);
        typedef unsigned u32x2v __attribute__((ext_vector_type(2))); u32x2v w;
        w.x = cvtpk(v[j][0] * r * g[0] * (1.0f + sc[0]) + sh[0], v[j][1] * r * g[1] * (1.0f + sc[1]) + sh[1]); w.y = cvtpk(v[j][2] * r * g[2] * (1.0f + sc[2]) + sh[2], v[j][3] * r * g[3] * (1.0f + sc[3]) + sh[3]);
        *(u32x2v*)(out + (size_t)row * D + c) = w; }
}
__device__ __forceinline__ void b_hnorm(const float* __restrict__ xa, const float* __restrict__ xb, const float* __restrict__ gain, const float* __restrict__ mods, int sh_idx, int sc_idx, bf16* __restrict__ out, int row, int lt, float* red) {
    const float* x = row < MP ? xa + (size_t)row * D : xb + (size_t)(row - MP) * D;
    float v[8]; float ss = 0.f;
#pragma unroll
    for (int j = 0; j < 8; ++j) { v[j] = x[lt * 8 + j]; ss += v[j] * v[j]; }
    ss = wave_sum(ss); if ((lt & 63) == 0) red[lt >> 6] = ss; __syncthreads();
    ss = red[0] + red[1] + red[2] + red[3];
    const float r = rsqrtf(ss * (1.0f / D) + EPS);
    const float* m = mods + (size_t)modrow(row) * NMOD;
#pragma unroll
    for (int j = 0; j < 8; ++j) { const int c = lt * 8 + j; out[(size_t)row * D + c] = f2bf(v[j] * r * gain[c] * (1.0f + m[sc_idx * D + c]) + m[sh_idx * D + c]); }
    __syncthreads();
}
__device__ __forceinline__ void b_norm2_sample(const float* __restrict__ xs, const float* __restrict__ slab, const float* __restrict__ gain, const float* __restrict__ mods, float* __restrict__ X1, bf16* __restrict__ out, int row, int lt, float* red) {
    const int r = row - MP; const float* m = mods + (size_t)modrow(row) * NMOD;
    float v[8]; float ss = 0.f;
#pragma unroll
    for (int j = 0; j < 8; ++j) { const int c = lt * 8 + j; float s = 0.f;
#pragma unroll
        for (int ks = 0; ks < 8; ++ks) s += slab[((size_t)ks * 256 + r) * 2048 + c];
        v[j] = xs[(size_t)r * D + c] + m[2 * D + c] * s; X1[(size_t)row * D + c] = v[j]; ss += v[j] * v[j]; }
    ss = wave_sum(ss); if ((lt & 63) == 0) red[lt >> 6] = ss; __syncthreads();
    ss = red[0] + red[1] + red[2] + red[3];
    const float rn = rsqrtf(ss * (1.0f / D) + EPS);
#pragma unroll
    for (int j = 0; j < 8; ++j) { const int c = lt * 8 + j; out[(size_t)row * D + c] = f2bf(v[j] * rn * gain[c] * (1.0f + m[4 * D + c]) + m[3 * D + c]); }
    __syncthreads();
}
__device__ __forceinline__ void b_hgrn_seq(const bf16* __restrict__ QAb, const bf16* __restrict__ IAb, const float* __restrict__ F, const float* __restrict__ state, float* __restrict__ oraw, float* __restrict__ out, int x, int v) {
    const bool pr = x < 16;
    const int b = pr ? (x >> 3) : ((x - 16) >> 3), h = x & 7;
    const int T = pr ? TP : TS; const size_t row0 = pr ? (size_t)b * TP : (size_t)MP + b * TS;
    float S[128];
#pragma unroll
    for (int k = 0; k < 128; ++k) S[k] = pr ? 0.f : state[(((size_t)b * 8 + h) * 128 + k) * 128 + v];
    for (int t = 0; t < T; ++t) {
        const bf16* qp = QAb + (row0 + t) * LQ + h * 128; const float* f = F + (row0 + t) * LQ + h * 128;
        const float vi = bf2f(IAb[(row0 + t) * LQ + h * 128 + v]); float o = 0.f;
#pragma unroll
        for (int k = 0; k < 128; ++k) { const float fk = f[k]; S[k] = fk * S[k] + (1.0f - fk) * vi; o += S[k] * bf2f(qp[k]); }
        oraw[(row0 + t) * 1024 + h * 128 + v] = o;
    }
    float* so = out + (pr ? O_HGP : O_HGS) + ((size_t)b * 8 + h) * 16384;
#pragma unroll
    for (int k = 0; k < 128; ++k) so[k * 128 + v] = S[k];
}
__device__ __forceinline__ void b_hgrn_out(const float* __restrict__ oraw, const bf16* __restrict__ GAs, const float* __restrict__ onorm, bf16* __restrict__ OA, int row, int tid) {
    float o[4]; float ss = 0.f;
#pragma unroll
    for (int j = 0; j < 4; ++j) { o[j] = oraw[(size_t)row * 1024 + tid * 4 + j]; ss += o[j] * o[j]; }
#pragma unroll
    for (int s = 16; s >= 1; s >>= 1) ss += __shfl_xor(ss, s);
    const float r = rsqrtf(ss * (1.0f / 128) + EPS);
#pragma unroll
    for (int j = 0; j < 4; ++j) { const int c = tid * 4 + j; OA[(size_t)row * 1024 + c] = f2bf(o[j] * r * onorm[c] * bf2f(GAs[(size_t)row * LQ + c])); }
}

template <class F> struct EpiGen {
    static constexpr bool PERM = false, AFTER_DRAIN = false;
    F f; float* slab; int slab_n, kslice;
    __device__ __forceinline__ void operator()(const pg8::f32x4 (&acc)[2][2][4][2], const pg8::Unit& u, int wr, int wc, int fr0, int fq0) const {
        int fr = fr0, fq = fq0; asm volatile("" : "+v"(fr), "+v"(fq));
        const int row0 = u.pm * 256 + wr * 64 + fr, col0 = u.pn * 256 + wc * 32 + 4 * fq;
        if (slab != nullptr && u.pm == 32) {
            float* sp = slab + ((size_t)(u.k0 / kslice) * 256 + (row0 - MP)) * slab_n + col0;
#pragma unroll
            for (int ai = 0; ai < 2; ++ai)
#pragma unroll
                for (int m = 0; m < 4; ++m)
#pragma unroll
                    for (int bj = 0; bj < 2; ++bj)
#pragma unroll
                        for (int n = 0; n < 2; ++n) *(f32x4*)(sp + (size_t)(ai * 128 + m * 16) * slab_n + bj * 128 + n * 16) = acc[ai][bj][m][n];
            return;
        }
#pragma unroll
        for (int ai = 0; ai < 2; ++ai)
#pragma unroll
            for (int m = 0; m < 4; ++m)
#pragma unroll
                for (int bj = 0; bj < 2; ++bj)
#pragma unroll
                    for (int n = 0; n < 2; ++n) f(row0 + ai * 128 + m * 16, col0 + bj * 128 + n * 16, acc[ai][bj][m][n]);
    }
};
struct MixOrder {
    pg8::StaticOrder P; int nN, nsl, ntS, kslice;
    __device__ __forceinline__ void init(int N, int K, int nsl_, int G, int c) { P.init(MP, N, G, c, K); nN = N / 256; nsl = nsl_; kslice = K / nsl_; ntS = kslice / 64; }
    __device__ __forceinline__ bool next(int i, pg8::Unit& u) const {
        const int L = i * P.G + P.c; if (L < P.nwg) return P.next(i, u);
        const int idx = L - P.nwg; if (idx >= nN * nsl) return false;
        u.pm = 32; u.pn = idx % nN; u.k0 = (idx / nN) * kslice; u.nt = ntS; u.sel = 0; return true; }
    __device__ __forceinline__ void a_ready(const pg8::Unit&) const {}
    __device__ __forceinline__ void done(const pg8::Unit&) const {}
};
template <class Base> struct RangeOrder {
    Base B; int i0, i1;
    __device__ __forceinline__ bool next(int i, pg8::Unit& u) const { return (i0 + i < i1) ? B.next(i0 + i, u) : false; }
    __device__ __forceinline__ void a_ready(const pg8::Unit&) const {}
    __device__ __forceinline__ void done(const pg8::Unit&) const {}
};
struct PairOrder {
    pg8::StaticOrder P; int nN, nsl, ntS, kslice;
    __device__ __forceinline__ void init(int N, int K, int nsl_, int G, int c) { P.init(MP, N, G, c, K); nN = N / 256; nsl = nsl_; kslice = K / nsl_; ntS = kslice / 64; }
    __device__ __forceinline__ bool next(int i, pg8::Unit& u) const {
        if (i < 2) { const bool ok = P.next(0, u); u.sel = i; return ok; }
        const int idx = (i - 2) * P.G + P.c; if (idx >= 2 * nN * nsl) return false;
        const int half = nN * nsl, w = idx >= half ? 1 : 0, id2 = idx - w * half;
        u.pm = 32; u.pn = id2 % nN; u.k0 = (id2 / nN) * kslice; u.nt = ntS; u.sel = w; return true; }
    __device__ __forceinline__ void a_ready(const pg8::Unit&) const {}
    __device__ __forceinline__ void done(const pg8::Unit&) const {}
};
struct EpiBranch {
    static constexpr bool PERM = false, AFTER_DRAIN = false;
    const bf16* mga; const bf16* mgb; float* T; bf16* merged; float* slab; int kslice, pad;
    __device__ __forceinline__ void operator()(const pg8::f32x4 (&acc)[2][2][4][2], const pg8::Unit& u, int wr, int wc, int fr0, int fq0) const {
        int fr = fr0, fq = fq0; asm volatile("" : "+v"(fr), "+v"(fq));
        const int row0 = u.pm * 256 + wr * 64 + fr, col0 = u.pn * 256 + wc * 32 + 4 * fq;
#define EB_LOOP(...) _Pragma("unroll") for (int ai = 0; ai < 2; ++ai) _Pragma("unroll") for (int m = 0; m < 4; ++m) _Pragma("unroll") for (int bj = 0; bj < 2; ++bj) _Pragma("unroll") for (int n = 0; n < 2; ++n) { \
            const int r = row0 + ai * 128 + m * 16, c = col0 + bj * 128 + n * 16; const f32x4 v = acc[ai][bj][m][n]; __VA_ARGS__ }
        if (u.pm == 32) { float* sp = slab + ((size_t)u.sel * 4 * 256 + (size_t)(u.k0 / kslice) * 256) * D; EB_LOOP( *(f32x4*)(sp + (size_t)(r - MP) * D + c) = v; ) }
        else if (u.sel == 0) { EB_LOOP( const ushort4 g = *(const ushort4*)(mga + (size_t)r * LMG + c); f32x4 o; o[0] = bf2f(g.x) * v[0]; o[1] = bf2f(g.y) * v[1]; o[2] = bf2f(g.z) * v[2]; o[3] = bf2f(g.w) * v[3]; *(f32x4*)(T + (size_t)r * D + c) = o; ) }
        else { EB_LOOP( const ushort4 g = *(const ushort4*)(mgb + (size_t)r * LMG + c); const f32x4 t = *(const f32x4*)(T + (size_t)r * D + c); ushort4 o;
                        o.x = f2bf(t[0] + bf2f(g.x) * v[0]); o.y = f2bf(t[1] + bf2f(g.y) * v[1]); o.z = f2bf(t[2] + bf2f(g.z) * v[2]); o.w = f2bf(t[3] + bf2f(g.w) * v[3]); *(ushort4*)(merged + (size_t)r * D + c) = o; ) }
#undef EB_LOOP
    }
};
struct FStoreF32 { float* C; int ldc; int pad;
    __device__ __forceinline__ void operator()(int r, int c, f32x4 v) const { *(f32x4*)(C + (size_t)r * ldc + c) = v; } };
struct FGateA { const bf16* mga; float* T;
    __device__ __forceinline__ void operator()(int r, int c, f32x4 v) const { const ushort4 g = *(const ushort4*)(mga + (size_t)r * LMG + c); f32x4 o;
        o[0] = bf2f(g.x) * v[0]; o[1] = bf2f(g.y) * v[1]; o[2] = bf2f(g.z) * v[2]; o[3] = bf2f(g.w) * v[3];
        *(f32x4*)(T + (size_t)r * D + c) = o; } };
struct FGateB { const bf16* mgb; const float* T; bf16* merged;
    __device__ __forceinline__ void operator()(int r, int c, f32x4 v) const { const ushort4 g = *(const ushort4*)(mgb + (size_t)r * LMG + c); const f32x4 t = *(const f32x4*)(T + (size_t)r * D + c); ushort4 o;
        o.x = f2bf(t[0] + bf2f(g.x) * v[0]); o.y = f2bf(t[1] + bf2f(g.y) * v[1]); o.z = f2bf(t[2] + bf2f(g.z) * v[2]); o.w = f2bf(t[3] + bf2f(g.w) * v[3]);
        *(ushort4*)(merged + (size_t)r * D + c) = o; } };
struct FRes1 { const float* xp; const float* xs; const float* mods; float* X1;
    __device__ __forceinline__ void operator()(int r, int c, f32x4 v) const { const float* x = r < MP ? xp + (size_t)r * D : xs + (size_t)(r - MP) * D; const f32x4 xv = *(const f32x4*)(x + c);
        const f32x4 g = *(const f32x4*)(mods + (size_t)modrow(r) * NMOD + 2 * D + c); *(f32x4*)(X1 + (size_t)r * D + c) = xv + g * v; } };
struct FRelu2 { bf16* U;
    __device__ __forceinline__ void operator()(int r, int c, f32x4 v) const { ushort4 o; float a;
        a = fmaxf(v[0], 0.f); o.x = f2bf(a * a); a = fmaxf(v[1], 0.f); o.y = f2bf(a * a); a = fmaxf(v[2], 0.f); o.z = f2bf(a * a); a = fmaxf(v[3], 0.f); o.w = f2bf(a * a);
        *(ushort4*)(U + (size_t)r * DFF + c) = o; } };
struct FRes2 { const float* X1; const float* mods; float* out;
    __device__ __forceinline__ void operator()(int r, int c, f32x4 v) const { const f32x4 xv = *(const f32x4*)(X1 + (size_t)r * D + c);
        const f32x4 g = *(const f32x4*)(mods + (size_t)modrow(r) * NMOD + 5 * D + c); *(f32x4*)(out + (size_t)r * D + c) = xv + g * v; } };

struct InProjOut { bf16* QAb; float* F; bf16* IAb; bf16* GAs; float* QBr; float* out; bf16* XHP; float* WINKV; bf16* MGAb; bf16* MGBb; float* GATES; const float* lbl; };
__device__ __forceinline__ void st_bf16x4(bf16* p, f32x4 v) { typedef unsigned u32x2v __attribute__((ext_vector_type(2))); u32x2v w; w.x = cvtpk(v[0], v[1]); w.y = cvtpk(v[2], v[3]); *(u32x2v*)p = w; }
struct EpiInProj {
    static constexpr bool PERM = false, AFTER_DRAIN = false;
    InProjOut o;
#define EPI_LOOP(...) _Pragma("unroll") for (int bj = 0; bj < 2; ++bj) _Pragma("unroll") for (int n = 0; n < 2; ++n) { const int c = ct0 + bj * 128 + n * 16; \
        _Pragma("unroll") for (int ai = 0; ai < 2; ++ai) _Pragma("unroll") for (int m = 0; m < 4; ++m) { const int row = row0 + ai * 128 + m * 16; const f32x4 v = acc[ai][bj][m][n]; __VA_ARGS__ } }
    __device__ __forceinline__ void operator()(const pg8::f32x4 (&acc)[2][2][4][2], const pg8::Unit& u, int wr, int wc, int fr0, int fq0) const {
        int fr = fr0, fq = fq0; asm volatile("" : "+v"(fr), "+v"(fq));
        const int row0 = u.pm * 256 + wr * 64 + fr, ct0 = wc * 32 + 4 * fq, pn = u.pn;
        if (pn < 4) { bf16* p = o.QAb + pn * 256; EPI_LOOP( st_bf16x4(p + (size_t)row * LQ + c, v); ) }
        else if (pn < 8) {
            float* p = o.F + (pn - 4) * 256;
#pragma unroll
            for (int bj = 0; bj < 2; ++bj)
#pragma unroll
                for (int n = 0; n < 2; ++n) { const int c = ct0 + bj * 128 + n * 16; const int cc = (pn - 4) * 256 + c; const f32x4 l0 = *(const f32x4*)(o.lbl + cc), l1 = *(const f32x4*)(o.lbl + 1024 + cc); f32x4 lb;
#pragma unroll
                    for (int j = 0; j < 4; ++j) lb[j] = sigmoidf_(l0[j] - l1[j]);
#pragma unroll
                    for (int ai = 0; ai < 2; ++ai)
#pragma unroll
                        for (int m = 0; m < 4; ++m) { const int row = row0 + ai * 128 + m * 16; const f32x4 v = acc[ai][bj][m][n]; f32x4 f;
#pragma unroll
                            for (int j = 0; j < 4; ++j) f[j] = lb[j] + (1.0f - lb[j]) * sigmoidf_(v[j]);
                            *(f32x4*)(p + (size_t)row * LQ + c) = f; } }
        }
        else if (pn < 12) { bf16* p = o.IAb + (pn - 8) * 256; EPI_LOOP( st_bf16x4(p + (size_t)row * LQ + c, v); ) }
        else if (pn < 16) { bf16* p = o.GAs + (pn - 12) * 256; EPI_LOOP( f32x4 s; s[0] = siluf_(v[0]); s[1] = siluf_(v[1]); s[2] = siluf_(v[2]); s[3] = siluf_(v[3]); st_bf16x4(p + (size_t)row * LQ + c, s); ) }
        else if (pn < 20) { float* p = o.QBr + (pn - 16) * 256; EPI_LOOP( *(f32x4*)(p + (size_t)row * LQ + c) = v; ) }
        else if (pn < 22) { const int w = pn & 1; const bool pr = u.pm < 32; float* p = o.out + (pr ? O_CMPP : O_CMPS) + w * 256 - (pr ? (size_t)0 : (size_t)MP * 512); bf16* xp = o.XHP + (size_t)w * 1280 * 2048;
            EPI_LOOP( *(f32x4*)(p + (size_t)row * 512 + c) = v;
                      { const int kv = c >> 7, d = c & 127; size_t r; int j; if (pr) { const int b = row >> 12, t = row & 4095; r = ((size_t)b * 256 + (t >> 4)) * 2 + kv; j = t & 15; } else { const int lrow = row - MP; r = 1024 + (size_t)(lrow >> 3) * 2 + kv; j = lrow & 7; }
                        st_bf16x4(xp + r * 2048 + j * 128 + d, v); } ) }
        else if (pn < 24) { const int w = pn & 1; const bool pr = u.pm < 32; float* p = o.out + (pr ? O_SELP : O_SELS) + w * 256 - (pr ? (size_t)0 : (size_t)MP * 512); EPI_LOOP( *(f32x4*)(p + (size_t)row * 512 + c) = v; ) }
        else if (pn < 26) { float* p = o.WINKV + (pn & 1) * 256; EPI_LOOP( *(f32x4*)(p + (size_t)row * 512 + c) = v; ) }
        else if (pn < 42) { bf16* p = (pn < 34) ? o.MGAb + (pn - 26) * 256 : o.MGBb + (pn - 34) * 256;
            EPI_LOOP( f32x4 s; s[0] = sigmoidf_(v[0]); s[1] = sigmoidf_(v[1]); s[2] = sigmoidf_(v[2]); s[3] = sigmoidf_(v[3]); st_bf16x4(p + (size_t)row * LMG + c, s); ) }
        else { EPI_LOOP( if (c < 24) { f32x4 s; s[0] = sigmoidf_(v[0]); s[1] = sigmoidf_(v[1]); s[2] = sigmoidf_(v[2]); s[3] = sigmoidf_(v[3]); *(f32x4*)(o.GATES + (size_t)row * 24 + c) = s; } ) }
    }
#undef EPI_LOOP
};

constexpr int NTHR = 512;
constexpr int LDS_STAGE = 131072;
constexpr int LDS_CTL = LDS_STAGE;
constexpr int LDS_BYTES = 163840;
enum { PH_PRO = 0, PH_MRED, PH_NORM1, PH_INPROJ, PH_MIX1, PH_CFIN, PH_ATTN, PH_SATTN, PH_SCOMB, PH_BR, PH_RMERGE, PH_OUT, PH_NORM2, PH_MLP1, PH_RU, PH_MLP2, PH_RY, N_PHASES };


__device__ __forceinline__ int crow(int r, int hi) { return (r & 3) + 8 * (r >> 2) + 4 * hi; }
constexpr int AL_BIAS = LDS_CTL + 64;
constexpr int AL_LX = AL_BIAS + 4 * 132 * 4;
constexpr int AL_FX = AL_LX + 8 * 32 * 4;
constexpr int AL_SEL = AL_FX + 8 * 32 * 4;
constexpr int AL_IMPA = AL_SEL + 32 * 2 * 4;
constexpr int AL_IMPB = AL_IMPA + 32 * 64 * 4;
constexpr int AL_SCT = AL_IMPB + 32 * 64 * 4;
constexpr int AL_END = AL_SCT + 32 * 64 * 4;
static_assert(AL_END <= LDS_BYTES, "attention LDS control region");

struct AttnP { const float* QBr; const float* qn_g; const bf16* KSf; const bf16* VSf; const bf16* KWf; const bf16* VWf; const bf16* KCf; const bf16* VCf; const float* gates; const float* relb; bf16* OB; float* OT; float* IMP; };

__device__ __forceinline__ void dma_copy(LAS unsigned char* dst, const bf16* src, int nchunks  , int wave, int lane) {
    for (int c = wave; c < nchunks; c += 8) __builtin_amdgcn_global_load_lds((const unsigned*)((const char*)src + c * 1024 + lane * 16), (LAS unsigned*)(dst + c * 1024), 16, 0, 0);
}
#define AT_WAITV0() asm volatile("s_waitcnt vmcnt(0)" ::: "memory")
#define AT_BAR() do { asm volatile("s_waitcnt vmcnt(0) lgkmcnt(0)" ::: "memory"); __builtin_amdgcn_s_barrier(); asm volatile("" ::: "memory"); } while (0)

__device__ __forceinline__ f32x16 at_qk(const LAS unsigned char* kb, const bf16x8 (&qf)[8], int lane) {
    f32x16 p = {0.f, 0.f, 0.f, 0.f, 0.f, 0.f, 0.f, 0.f, 0.f, 0.f, 0.f, 0.f, 0.f, 0.f, 0.f, 0.f};
#pragma unroll
    for (int s = 0; s < 8; ++s) { const bf16x8 kf = *(const LAS bf16x8*)(kb + s * 1024 + lane * 16); p = __builtin_amdgcn_mfma_f32_32x32x16_bf16(kf, qf[s], p, 0, 0, 0); if (s == 3) __builtin_amdgcn_sched_barrier(0); }
    return p;
}
__device__ __forceinline__ void at_pv(f32x16 (&o)[4], const f32x16& e, const LAS unsigned char* vb, int lane) {
#pragma unroll
    for (int ks = 0; ks < 2; ++ks) {
        u32x4 w; w.x = cvtpk(e[8 * ks + 0], e[8 * ks + 1]); w.y = cvtpk(e[8 * ks + 2], e[8 * ks + 3]); w.z = cvtpk(e[8 * ks + 4], e[8 * ks + 5]); w.w = cvtpk(e[8 * ks + 6], e[8 * ks + 7]);
        const bf16x8 pf = __builtin_bit_cast(bf16x8, w);
#pragma unroll
        for (int dt = 0; dt < 4; ++dt) { const bf16x8 vf = *(const LAS bf16x8*)(vb + (ks * 4 + dt) * 1024 + lane * 16); o[dt] = __builtin_amdgcn_mfma_f32_32x32x16_bf16(pf, vf, o[dt], 0, 0, 0); }
    }
}
template <int MODE> __device__ __forceinline__ float at_exp(f32x16& p, int tok, int key0  , int hi, const LAS float* bias_g, float b31, int maxrel, bool keep) {
    float sum = 0.f;
#pragma unroll
    for (int r = 0; r < 16; ++r) {
        float e;
        if (MODE == 0) e = __builtin_amdgcn_exp2f(p[r] + b31);
        else { const int rel = tok - (key0 + crow(r, hi)); const bool ok = rel >= 0 && rel < maxrel; const int ix = rel < 0 ? 0 : (rel > 128 ? 128 : rel); e = ok ? __builtin_amdgcn_exp2f(p[r] + bias_g[ix]) : 0.f; }
        e = keep ? e : 0.f; p[r] = e; sum += e;
    }
    return sum;
}

__device__ __forceinline__ void load_q_frags(bf16x8 (&qf)[8], const float* qrow, const float* qn_g, int hi) {
    f32x4 x[8], y[8]; float ss = 0.f;
#pragma unroll
    for (int s = 0; s < 8; ++s) { x[s] = *(const f32x4*)(qrow + 16 * s + 8 * hi); y[s] = *(const f32x4*)(qrow + 16 * s + 8 * hi + 4);
        ss += (x[s][0] * x[s][0] + x[s][1] * x[s][1]) + (x[s][2] * x[s][2] + x[s][3] * x[s][3]) + (y[s][0] * y[s][0] + y[s][1] * y[s][1]) + (y[s][2] * y[s][2] + y[s][3] * y[s][3]); }
    ss += __shfl_xor(ss, 32);
    const float r = rsqrtf(ss * (1.0f / 128) + EPS) * (0.08838834764831845f * LOG2E);
#pragma unroll
    for (int s = 0; s < 8; ++s) { const f32x4 g0 = *(const f32x4*)(qn_g + 16 * s + 8 * hi), g1 = *(const f32x4*)(qn_g + 16 * s + 8 * hi + 4);
        u32x4 w; w.x = cvtpk(x[s][0] * g0[0] * r, x[s][1] * g0[1] * r); w.y = cvtpk(x[s][2] * g0[2] * r, x[s][3] * g0[3] * r); w.z = cvtpk(y[s][0] * g1[0] * r, y[s][1] * g1[1] * r); w.w = cvtpk(y[s][2] * g1[2] * r, y[s][3] * g1[3] * r);
        qf[s] = __builtin_bit_cast(bf16x8, w); }
}
__device__ __forceinline__ void at_stage_tile(LAS unsigned char* slot, const bf16* Kf, const bf16* Vf, int j, int wave, int lane) {
#pragma unroll
    for (int c = 0; c < 2; ++c) { const int ch = wave + 8 * c;
        __builtin_amdgcn_global_load_lds((const unsigned*)((const char*)(Kf + (size_t)j * 8192) + ch * 1024 + lane * 16), (LAS unsigned*)(slot + ch * 1024), 16, 0, 0);
        __builtin_amdgcn_global_load_lds((const unsigned*)((const char*)(Vf + (size_t)j * 8192) + ch * 1024 + lane * 16), (LAS unsigned*)(slot + 16384 + ch * 1024), 16, 0, 0); }
}
__device__ __forceinline__ void attn_prompt_unit(const AttnP& P0, int b, int kv, int i, LAS unsigned char* lds, int wave, int lane0) {
    int lane = lane0; asm volatile("" : "+v"(lane));
    AttnP P = P0;
    asm volatile("" : "+s"(P.QBr), "+s"(P.qn_g), "+s"(P.KSf), "+s"(P.VSf), "+s"(P.KWf), "+s"(P.VWf), "+s"(P.KCf), "+s"(P.VCf));
    asm volatile("" : "+s"(P.gates), "+s"(P.relb), "+s"(P.OB), "+s"(P.OT));
    const int rg = wave & 3, par = wave >> 2, q = lane & 31, hi = lane >> 5, tid = wave * 64 + lane;
    const int tok = 32 * i + 8 * rg + (q >> 2), g = q & 3, head = kv * 4 + g, cur = i >> 1;
    const size_t row = (size_t)b * TP + tok;
    LAS float* biasT = (LAS float*)(lds + AL_BIAS); LAS float* lx = (LAS float*)(lds + AL_LX); LAS float* fx = (LAS float*)(lds + AL_FX); LAS unsigned* selw = (LAS unsigned*)(lds + AL_SEL);
    LAS float* impA = (LAS float*)(lds + AL_IMPA); LAS float* impB = (LAS float*)(lds + AL_IMPB); LAS float* scT = (LAS float*)(lds + AL_SCT);
    for (int u = tid; u < 4 * 129; u += NTHR) { const int gg = u / 129, r = u % 129; biasT[gg * 132 + r] = P.relb[rel_bucket(r) * 8 + kv * 4 + gg] * LOG2E; }
    bf16x8 qf[8];
    load_q_frags(qf, P.QBr + row * LQ + head * 128, P.qn_g, hi);
    const float g0 = P.gates[row * 24 + head * 3 + 0], g1 = P.gates[row * 24 + head * 3 + 1], g2 = P.gates[row * 24 + head * 3 + 2];
    const LAS float* bias_g = biasT + g * 132;
    f32x16 ob[4], ot[4];
#pragma unroll
    for (int dt = 0; dt < 4; ++dt) { ob[dt] = (f32x16){0.f, 0.f, 0.f, 0.f, 0.f, 0.f, 0.f, 0.f, 0.f, 0.f, 0.f, 0.f, 0.f, 0.f, 0.f, 0.f}; ot[dt] = ob[dt]; }
    const size_t seqkv = (size_t)b * 2 + kv;

    {
        int nct = ((2 * i + 3) >> 6) + 1; nct = nct > 4 ? 4 : nct;
        dma_copy(lds, P.KCf + seqkv * 8 * 4096, nct * 16, wave, lane);
        dma_copy(lds + 65536, P.VCf + seqkv * 8 * 4096, nct * 16, wave, lane);
        AT_BAR();
        float lsum = 0.f;
#pragma unroll 1
        for (int t = 0; t < 2; ++t) {
            const int ct = par + 2 * t;
            if (ct < nct) {
#pragma unroll 1
                for (int sub = 0; sub < 2; ++sub) {
                    f32x16 sc = at_qk(lds + ct * 16384 + sub * 8192, qf, lane);
#pragma unroll
                    for (int r = 0; r < 16; ++r) { const int c = 64 * ct + 32 * sub + crow(r, hi); const int rel = tok - (16 * c + 31); const int ix = rel < 0 ? 0 : (rel > 128 ? 128 : rel);
                        const float e = rel >= 0 ? __builtin_amdgcn_exp2f(sc[r] + bias_g[ix]) : 0.f; lsum += e; }
                }
            }
        }
        lsum += __shfl_xor(lsum, 32);
        if (hi == 0) lx[wave * 32 + q] = lsum;
        AT_BAR();
        const float ltot = lx[rg * 32 + q] + lx[(rg + 4) * 32 + q];
        const float inv = 1.0f / fmaxf(ltot, 1e-30f);
#pragma unroll 1
        for (int t = 0; t < 2; ++t) {
            const int ct = par + 2 * t;
            if (ct < nct) {
#pragma unroll 1
                for (int sub = 0; sub < 2; ++sub) {
                    f32x16 sc = at_qk(lds + ct * 16384 + sub * 8192, qf, lane);
#pragma unroll
                    for (int r = 0; r < 16; ++r) { const int c = 64 * ct + 32 * sub + crow(r, hi); const int rel = tok - (16 * c + 31); const int ix = rel < 0 ? 0 : (rel > 128 ? 128 : rel);
                        sc[r] = (rel >= 0 ? __builtin_amdgcn_exp2f(sc[r] + bias_g[ix]) : 0.f) * inv; }
#pragma unroll
                    for (int m = 0; m < 4; ++m) { float sa = (sc[4 * m] + sc[4 * m + 1]) + (sc[4 * m + 2] + sc[4 * m + 3]), sb = sc[4 * m + 3];
                        sa += __shfl_xor(sa, 1); sa += __shfl_xor(sa, 2); sb += __shfl_xor(sb, 1); sb += __shfl_xor(sb, 2);
                        if (g == 0) { const int s = 16 * ct + 8 * sub + 2 * m + hi; impA[(8 * rg + (q >> 2)) * 64 + s] = sa; impB[(8 * rg + (q >> 2)) * 64 + s] = sb; } }
#pragma unroll
                    for (int r = 0; r < 16; ++r) sc[r] *= g0;
                    at_pv(ot, sc, lds + 65536 + ct * 16384 + sub * 8192, lane);
                }
            }
        }
        AT_BAR();
#pragma unroll 1
        for (int tt = 0; tt < 4; ++tt) {
            const int tl = 4 * wave + tt, s = lane; float score = -INFINITY;
            if (s <= cur) { const float a = impA[tl * 64 + s] + (s > 0 ? impB[tl * 64 + s - 1] : 0.f); const bool forced = (s == 0) || (s == cur) || (s == cur - 1); score = a + (forced ? 1.0e6f : 0.f); }
            scT[tl * 64 + s] = score;
        }
        asm volatile("s_waitcnt lgkmcnt(0)" ::: "memory"); __builtin_amdgcn_wave_barrier();
#pragma unroll 1
        for (int tt = 0; tt < 4; ++tt) {
            const int tl = 4 * wave + tt, s = lane; const float score = scT[tl * 64 + s]; int rank = 0;
#pragma unroll 2
            for (int t4 = 0; t4 < 16; ++t4) { const f32x4 u4 = *(const LAS f32x4*)(scT + tl * 64 + 4 * t4);
#pragma unroll
                for (int e = 0; e < 4; ++e) { const int t = 4 * t4 + e; rank += (u4[e] > score || (u4[e] == score && t < s)) ? 1 : 0; } }
            const unsigned long long m = __ballot(rank < 16);
            if (lane == 0) { selw[tl * 2] = (unsigned)m; selw[tl * 2 + 1] = (unsigned)(m >> 32); }
        }
        AT_BAR();
    }
    const unsigned long long smask = ((unsigned long long)selw[(8 * rg + (q >> 2)) * 2 + 1] << 32) | selw[(8 * rg + (q >> 2)) * 2];
    const float b31 = bias_g[128];
    const int t0 = 32 * i + 8 * rg;

#pragma unroll 1
    for (int br = 1; br <= 2; ++br) {
        const bf16* Kf = (br == 1 ? P.KSf : P.KWf) + seqkv * 128 * 4096; const bf16* Vf = (br == 1 ? P.VSf : P.VWf) + seqkv * 128 * 4096;
        const int j0 = (br == 1) ? 0 : ((32 * i >= 511) ? ((32 * i - 511) >> 6) : 0);
        const int ntile = cur - j0 + 1; const int maxrel = (br == 1) ? 0x40000000 : 512;
        float lsum = 0.f;
        at_stage_tile(lds, Kf, Vf, j0, wave, lane);
        if (ntile > 1) at_stage_tile(lds + 32768, Kf, Vf, j0 + 1, wave, lane);
        if (ntile > 2) at_stage_tile(lds + 65536, Kf, Vf, j0 + 2, wave, lane);
#pragma unroll 1
        for (int t = 0; t < ntile; ++t) {
            const int ahead = ntile - 1 - t;
            if (ahead >= 2) asm volatile("s_waitcnt vmcnt(8)" ::: "memory"); else if (ahead == 1) asm volatile("s_waitcnt vmcnt(4)" ::: "memory"); else asm volatile("s_waitcnt vmcnt(0)" ::: "memory");
            asm volatile("s_waitcnt lgkmcnt(0)" ::: "memory"); __builtin_amdgcn_s_barrier(); asm volatile("" ::: "memory");
            if (t + 3 < ntile) at_stage_tile(lds + ((t + 3) & 3) * 32768, Kf, Vf, j0 + t + 3, wave, lane);
            const int j = j0 + t;
            const bool keep = (br == 1) ? (((smask >> j) & 1ull) != 0ull) : true;
            const int relmin = t0 - (64 * j + 63), relmax = t0 + 7 - 64 * j;
            const bool skip = (br == 2) && (relmin > 511);
            if (__ballot(keep) != 0ull && !skip) {
                const LAS unsigned char* kb = lds + (t & 3) * 32768 + par * 8192; const LAS unsigned char* vb = kb + 16384;
                f32x16 p0 = at_qk(kb, qf, lane);
                if (relmin >= 128 && relmax < maxrel) lsum += at_exp<0>(p0, tok, 64 * j + 32 * par, hi, bias_g, b31, maxrel, keep);
                else lsum += at_exp<1>(p0, tok, 64 * j + 32 * par, hi, bias_g, b31, maxrel, keep);
                at_pv(ob, p0, vb, lane);
            }
        }
        lsum += __shfl_xor(lsum, 32);
        if (hi == 0) lx[wave * 32 + q] = lsum;
        AT_BAR();
        { const float ltot = lx[rg * 32 + q] + lx[(rg + 4) * 32 + q]; const float f = (br == 1 ? g1 : g2) / fmaxf(ltot, 1e-30f); if (hi == 0) fx[wave * 32 + q] = f; }
        asm volatile("s_waitcnt lgkmcnt(0)" ::: "memory"); __builtin_amdgcn_wave_barrier();
#pragma unroll
        for (int m = 0; m < 4; ++m) { const f32x4 fv = *(const LAS f32x4*)(fx + wave * 32 + 8 * m + 4 * hi);
#pragma unroll
            for (int dt = 0; dt < 4; ++dt)
#pragma unroll
                for (int e = 0; e < 4; ++e) { ot[dt][4 * m + e] += fv[e] * ob[dt][4 * m + e]; ob[dt][4 * m + e] = 0.f; } }
        AT_BAR();
    }
    LAS float* obuf = (LAS float*)lds;
    if (par == 1) {
#pragma unroll
        for (int dt = 0; dt < 4; ++dt)
#pragma unroll
            for (int r = 0; r < 16; ++r) obuf[(rg * 32 + crow(r, hi)) * 128 + 32 * dt + q] = ot[dt][r];
    }
    AT_BAR();
    if (par == 0) {
#pragma unroll
        for (int dt = 0; dt < 4; ++dt)
#pragma unroll
            for (int r = 0; r < 16; ++r) { LAS float* o = obuf + (rg * 32 + crow(r, hi)) * 128 + 32 * dt + q; *o = *o + ot[dt][r]; }
    }
    AT_BAR();
    for (int u = tid; u < 2048; u += NTHR) {
        const int rr = u >> 4, ch = u & 15, rgg = rr >> 5, qq = rr & 31;
        const f32x4 a = *(const LAS f32x4*)(obuf + rr * 128 + ch * 8), c = *(const LAS f32x4*)(obuf + rr * 128 + ch * 8 + 4);
        u32x4 w; w.x = cvtpk(a[0], a[1]); w.y = cvtpk(a[2], a[3]); w.z = cvtpk(c[0], c[1]); w.w = cvtpk(c[2], c[3]);
        *(u32x4*)(P.OB + ((size_t)b * TP + 32 * i + 8 * rgg + (qq >> 2)) * 1024 + (kv * 4 + (qq & 3)) * 128 + ch * 8) = w;
    }
    AT_BAR();
}

__device__ __forceinline__ void prep_kv_tile(float* __restrict__ T, const float* __restrict__ gain, bf16* __restrict__ Kf, bf16* __restrict__ Vf, float* __restrict__ wout, int b, int kv, int Tt, int tid, float* kl  ) {
    const int key = tid >> 4, part = tid & 15, lane = tid & 63, x = tid >> 6, l31 = lane & 31, h = lane >> 5;
    float* rowp = T + ((size_t)b * TP + 32 * Tt + key) * 512 + kv * 128 + part * 8;
    f32x4 k0 = *(const f32x4*)rowp, k1 = *(const f32x4*)(rowp + 4);
    float ss = (k0[0] * k0[0] + k0[1] * k0[1]) + (k0[2] * k0[2] + k0[3] * k0[3]) + (k1[0] * k1[0] + k1[1] * k1[1]) + (k1[2] * k1[2] + k1[3] * k1[3]);
    ss += __shfl_xor(ss, 1); ss += __shfl_xor(ss, 2); ss += __shfl_xor(ss, 4); ss += __shfl_xor(ss, 8);
    const float r = rsqrtf(ss * (1.0f / 128) + EPS); const f32x4 g0 = *(const f32x4*)(gain + part * 8), g1 = *(const f32x4*)(gain + part * 8 + 4);
    k0 = k0 * g0 * r; k1 = k1 * g1 * r;
    *(f32x4*)rowp = k0; *(f32x4*)(rowp + 4) = k1;
    *(f32x4*)(kl + key * 132 + part * 8) = k0; *(f32x4*)(kl + key * 132 + part * 8 + 4) = k1;
    if (wout != nullptr) { float* wo = wout + (size_t)key * 512 + kv * 128 + part * 8; *(f32x4*)wo = k0; *(f32x4*)(wo + 4) = k1;
        *(f32x4*)(wo + 256) = *(const f32x4*)(rowp + 256); *(f32x4*)(wo + 260) = *(const f32x4*)(rowp + 260); }
    __syncthreads();
    { const float* s = kl + l31 * 132 + 16 * x + 8 * h; const f32x4 a0 = *(const f32x4*)s, a1 = *(const f32x4*)(s + 4);
      u32x4 w; w.x = cvtpk(a0[0], a0[1]); w.y = cvtpk(a0[2], a0[3]); w.z = cvtpk(a1[0], a1[1]); w.w = cvtpk(a1[2], a1[3]); *(u32x4*)(Kf + (size_t)(x * 64 + lane) * 8) = w; }
    { const int ks = x >> 2, dt = x & 3; const float* vb = T + ((size_t)b * TP + 32 * Tt) * 512 + 256 + kv * 128 + 32 * dt + l31; float v[8];
#pragma unroll
      for (int j = 0; j < 8; ++j) v[j] = vb[(size_t)(16 * ks + 8 * (j >> 2) + 4 * h + (j & 3)) * 512];
      u32x4 w; w.x = cvtpk(v[0], v[1]); w.y = cvtpk(v[2], v[3]); w.z = cvtpk(v[4], v[5]); w.w = cvtpk(v[6], v[7]); *(u32x4*)(Vf + (size_t)((ks * 4 + dt) * 64 + lane) * 8) = w; }
    __syncthreads();
}
__device__ __forceinline__ void prep_kv_sample(float* __restrict__ out, float* __restrict__ WINKV, const float* __restrict__ ks_g, const float* __restrict__ kw_g, int grp, int part) {
    const int which = grp >> 9, r = (grp >> 1) & 255, kv = grp & 1;
    float* rowp = (which == 0 ? out + O_SELS + (size_t)r * 512 : WINKV + ((size_t)MP + r) * 512) + kv * 128 + part * 8;
    f32x4 k0 = *(const f32x4*)rowp, k1 = *(const f32x4*)(rowp + 4);
    float ss = (k0[0] * k0[0] + k0[1] * k0[1]) + (k0[2] * k0[2] + k0[3] * k0[3]) + (k1[0] * k1[0] + k1[1] * k1[1]) + (k1[2] * k1[2] + k1[3] * k1[3]);
    ss += __shfl_xor(ss, 1); ss += __shfl_xor(ss, 2); ss += __shfl_xor(ss, 4); ss += __shfl_xor(ss, 8);
    const float* gain = which == 0 ? ks_g : kw_g;
    const float rr = rsqrtf(ss * (1.0f / 128) + EPS); const f32x4 g0 = *(const f32x4*)(gain + part * 8), g1 = *(const f32x4*)(gain + part * 8 + 4);
    k0 = k0 * g0 * rr; k1 = k1 * g1 * rr;
    *(f32x4*)rowp = k0; *(f32x4*)(rowp + 4) = k1;
    if (which == 1) { float* wo = out + O_WINS + ((size_t)(r >> 3) * 512 + 504 + (r & 7)) * 512 + kv * 128 + part * 8; *(f32x4*)wo = k0; *(f32x4*)(wo + 4) = k1;
        *(f32x4*)(wo + 256) = *(const f32x4*)(rowp + 256); *(f32x4*)(wo + 260) = *(const f32x4*)(rowp + 260); }
}
template <class SrcK, class SrcV> __device__ __forceinline__ void pack_tile(bf16* Kf, bf16* Vf, const SrcK& sk, const SrcV& sv, int tid) {
    const int lane = tid & 63, x = tid >> 6, l31 = lane & 31, h = lane >> 5;
    { const int s = x; u32x4 w; float v[8];
#pragma unroll
        for (int j = 0; j < 8; ++j) v[j] = sk(l31, 16 * s + 8 * h + j);
        w.x = cvtpk(v[0], v[1]); w.y = cvtpk(v[2], v[3]); w.z = cvtpk(v[4], v[5]); w.w = cvtpk(v[6], v[7]); *(u32x4*)(Kf + (size_t)(s * 64 + lane) * 8) = w; }
    { const int ks = x >> 2, dt = x & 3; u32x4 w; float v[8];
#pragma unroll
        for (int j = 0; j < 8; ++j) v[j] = sv(16 * ks + 8 * (j >> 2) + 4 * h + (j & 3), 32 * dt + l31);
        w.x = cvtpk(v[0], v[1]); w.y = cvtpk(v[2], v[3]); w.z = cvtpk(v[4], v[5]); w.w = cvtpk(v[6], v[7]); *(u32x4*)(Vf + (size_t)((ks * 4 + dt) * 64 + lane) * 8) = w; }
}
struct SrcRowsLim { const float* base; size_t stride; int lim; __device__ __forceinline__ float operator()(int key, int d) const { return key < lim ? base[(size_t)key * stride + d] : 0.f; } };

constexpr int XHC_ROWS = 32768, XHP_ROWS = 1280;
__device__ __forceinline__ void b_xhc_panel(const float* __restrict__ cache, const int* __restrict__ pt, bf16* __restrict__ panel, int L, int tid) {
    const int w = L >> 7, p = L & 127, b = p >> 2, lane16 = tid & 15, x = tid >> 4;
    const int ptv = pt[b * NPAGE + (p & 3) * 16 + lane16];
#pragma unroll 1
    for (int pg2 = 0; pg2 < 16; pg2 += 2) {
        const size_t base0 = (size_t)__builtin_amdgcn_readlane(ptv, pg2) * PAGE, base1 = (size_t)__builtin_amdgcn_readlane(ptv, pg2 + 1) * PAGE;
        f32x4 xa[16], ya[16];
#pragma unroll
        for (int i = 0; i < 16; ++i) {
            const int seg = (pg2 * 8 + i) * 32 + x; const int r = seg >> 4, j = seg & 15, n7 = (r >> 1) & 7, kv = r & 1;
            const float* s = cache + ((i < 8 ? base0 : base1) + n7 * 16 + j) * 512 + w * 256 + kv * 128 + lane16 * 8;
            xa[i] = *(const f32x4*)s; ya[i] = *(const f32x4*)(s + 4);
        }
#pragma unroll
        for (int i = 0; i < 16; ++i) {
            const int seg = (pg2 * 8 + i) * 32 + x; const int r = seg >> 4, j = seg & 15;
            u32x4 o; o.x = cvtpk(xa[i][0], xa[i][1]); o.y = cvtpk(xa[i][2], xa[i][3]); o.z = cvtpk(ya[i][0], ya[i][1]); o.w = cvtpk(ya[i][2], ya[i][3]);
            *(u32x4*)(panel + (size_t)r * 2048 + j * 128 + lane16 * 8) = o;
        }
    }
}
struct OneOrder {
    int pn;
    __device__ __forceinline__ bool next(int i, pg8::Unit& u) const { if (i > 0) return false; u.pm = 0; u.pn = pn; u.k0 = 0; u.nt = 32; u.sel = 0; return true; }
    __device__ __forceinline__ void a_ready(const pg8::Unit&) const {}
    __device__ __forceinline__ void done(const pg8::Unit&) const {}
};
struct DiagOrder {
    int n, per, G, c;
    __device__ __forceinline__ bool next(int i, pg8::Unit& u) const { const int L = i * G + c; if (L >= n) return false; u.pm = L; u.pn = L / per; u.k0 = 0; u.nt = 32; u.sel = 0; return true; }
    __device__ __forceinline__ void a_ready(const pg8::Unit&) const {}
    __device__ __forceinline__ void done(const pg8::Unit&) const {}
};
struct FStorePre { float* C; int rowoff, pad; __device__ __forceinline__ void operator()(int r, int c, f32x4 v) const { *(f32x4*)(C + (size_t)(rowoff + r) * 256 + (c & 255)) = v; } };
struct CmpW { const float *kw1, *kb1, *kw2, *vw1, *vb1, *vw2, *kc_g; };
__device__ __forceinline__ void b_cfin(const float* __restrict__ PREC, const float* __restrict__ PREP, const CmpW& cw, float* __restrict__ KCP, float* __restrict__ VCP, float* __restrict__ KCS, float* __restrict__ VCS,
                                       int grp, int tid, float* hid, float* red) {
    const int NP = 2040;
    float* dst[4]; int w = 0;
#pragma unroll
    for (int r4 = 0; r4 < 4; ++r4) {
        int x = grp * 4 + r4; bool pr; int b, i, kv; const float *p0, *p1;
        if (x < NP) { pr = true; kv = x & 1; x >>= 1; i = x % 255; x /= 255; b = x & 1; w = x >> 1;
            p0 = PREP + ((size_t)w * XHP_ROWS + ((size_t)b * 256 + i) * 2 + kv) * 256; p1 = PREP + ((size_t)w * XHP_ROWS + ((size_t)b * 256 + i + 1) * 2 + kv) * 256 + 128; }
        else { x -= NP; pr = false; kv = x & 1; x >>= 1; i = x & 511; x >>= 9; b = x & 31; w = x >> 5;
            p0 = PREC + ((size_t)w * XHC_ROWS + ((size_t)b * 512 + i) * 2 + kv) * 256;
            p1 = (i < 511) ? PREC + ((size_t)w * XHC_ROWS + ((size_t)b * 512 + i + 1) * 2 + kv) * 256 + 128 : PREP + ((size_t)w * XHP_ROWS + 1024 + b * 2 + kv) * 256 + 128; }
        const float* b1 = w ? cw.vb1 : cw.kb1;
        hid[r4 * 128 + tid] = siluf_(p0[tid] + p1[tid] + b1[tid]);
        dst[r4] = pr ? (w ? VCP : KCP) + (((size_t)b * 256 + i) * 2 + kv) * 128 : (w ? VCS : KCS) + (((size_t)b * 512 + i) * 2 + kv) * 128;
    }
    __syncthreads();
    const float* w2 = w ? cw.vw2 : cw.kw2;
    float o[4] = {0.f, 0.f, 0.f, 0.f};
    for (int k = 0; k < 128; ++k) { const float wv = w2[k * 128 + tid];
#pragma unroll
        for (int r4 = 0; r4 < 4; ++r4) o[r4] += hid[r4 * 128 + k] * wv; }
#pragma unroll
    for (int r4 = 0; r4 < 4; ++r4) { const float ss = wave_sum(o[r4] * o[r4]); if ((tid & 63) == 0) red[r4 * 2 + (tid >> 6)] = ss; }
    __syncthreads();
#pragma unroll
    for (int r4 = 0; r4 < 4; ++r4) { float v = o[r4]; if (w == 0) v = v * rsqrtf((red[r4 * 2] + red[r4 * 2 + 1]) * (1.0f / 128) + EPS) * cw.kc_g[tid]; dst[r4][tid] = v; }
    __syncthreads();
}

__device__ __forceinline__ void b_cfin_mfma(const float* __restrict__ PREC, const float* __restrict__ PREP, const bf16* __restrict__ W2T, const CmpW& cw,
                                            bf16* __restrict__ KCf, bf16* __restrict__ VCf, float* __restrict__ KCS, float* __restrict__ VCS, int item, int lane) {
    const int l31 = lane & 31, hi = lane >> 5;
    int x, xmax;
    if (item < 64) { const int w0 = item >> 5; x = 1020 * w0 + 32 * (item & 31) + l31; xmax = 1020 * w0 + 1019; } else { x = 2040 + 32 * (item - 64) + l31; xmax = 2040 + 65535; }
    const bool valid = x <= xmax; x = valid ? x : xmax;
    bool pr; int b, i, kv, w; const float *p0, *p1; float* dst;
    if (x < 2040) { int y = x; pr = true; kv = y & 1; y >>= 1; i = y % 255; y /= 255; b = y & 1; w = y >> 1;
        p0 = PREP + ((size_t)w * XHP_ROWS + ((size_t)b * 256 + i) * 2 + kv) * 256; p1 = PREP + ((size_t)w * XHP_ROWS + ((size_t)b * 256 + i + 1) * 2 + kv) * 256 + 128;
        dst = nullptr; }
    else { int y = x - 2040; pr = false; kv = y & 1; y >>= 1; i = y & 511; y >>= 9; b = y & 31; w = y >> 5;
        p0 = PREC + ((size_t)w * XHC_ROWS + ((size_t)b * 512 + i) * 2 + kv) * 256;
        p1 = (i < 511) ? PREC + ((size_t)w * XHC_ROWS + ((size_t)b * 512 + i + 1) * 2 + kv) * 256 + 128 : PREP + ((size_t)w * XHP_ROWS + 1024 + b * 2 + kv) * 256 + 128;
        dst = (w ? VCS : KCS) + (((size_t)b * 512 + i) * 2 + kv) * 128; }
    (void)pr;
    const int wu = __builtin_amdgcn_readfirstlane(w);
    const float* b1 = wu ? cw.vb1 : cw.kb1; const bf16* wt = W2T + (size_t)wu * 16384;
    f32x16 d[4];
#pragma unroll
    for (int cb = 0; cb < 4; ++cb) d[cb] = (f32x16){0.f, 0.f, 0.f, 0.f, 0.f, 0.f, 0.f, 0.f, 0.f, 0.f, 0.f, 0.f, 0.f, 0.f, 0.f, 0.f};
#pragma unroll
    for (int s = 0; s < 8; ++s) {
        const int k0 = 16 * s + 8 * hi;
        const f32x4 a0 = *(const f32x4*)(p0 + k0), a1 = *(const f32x4*)(p0 + k0 + 4), c0 = *(const f32x4*)(p1 + k0), c1 = *(const f32x4*)(p1 + k0 + 4), e0 = *(const f32x4*)(b1 + k0), e1 = *(const f32x4*)(b1 + k0 + 4);
        u32x4 hw; hw.x = cvtpk(siluf_(a0[0] + c0[0] + e0[0]), siluf_(a0[1] + c0[1] + e0[1])); hw.y = cvtpk(siluf_(a0[2] + c0[2] + e0[2]), siluf_(a0[3] + c0[3] + e0[3]));
        hw.z = cvtpk(siluf_(a1[0] + c1[0] + e1[0]), siluf_(a1[1] + c1[1] + e1[1])); hw.w = cvtpk(siluf_(a1[2] + c1[2] + e1[2]), siluf_(a1[3] + c1[3] + e1[3]));
        const bf16x8 hf = __builtin_bit_cast(bf16x8, hw);
#pragma unroll
        for (int cb = 0; cb < 4; ++cb) { const bf16x8 wf = *(const bf16x8*)(wt + (size_t)(32 * cb + l31) * 128 + k0); d[cb] = __builtin_amdgcn_mfma_f32_32x32x16_bf16(wf, hf, d[cb], 0, 0, 0); }
    }
    float rs = 1.0f;
    if (wu == 0) { float ss = 0.f;
#pragma unroll
        for (int cb = 0; cb < 4; ++cb)
#pragma unroll
            for (int r = 0; r < 16; ++r) ss += d[cb][r] * d[cb][r];
        ss += __shfl_xor(ss, 32); rs = rsqrtf(ss * (1.0f / 128) + EPS); }
    const bool prm = (item < 64);
    if (valid) {
#pragma unroll
        for (int cb = 0; cb < 4; ++cb)
#pragma unroll
            for (int m = 0; m < 4; ++m) { const int col = 32 * cb + 8 * m + 4 * hi; f32x4 o;
#pragma unroll
                for (int e = 0; e < 4; ++e) o[e] = d[cb][4 * m + e] * rs;
                if (wu == 0) { const f32x4 gg = *(const f32x4*)(cw.kc_g + col); o = o * gg; }
                if (!prm) *(f32x4*)(dst + col) = o;
                else { const int T = i >> 5, kl = i & 31; bf16* tb = (wu ? VCf : KCf) + (((size_t)b * 2 + kv) * 8 + T) * 4096;
                    if (wu == 0) { typedef unsigned u32x2v __attribute__((ext_vector_type(2))); u32x2v pk; pk.x = cvtpk(o[0], o[1]); pk.y = cvtpk(o[2], o[3]);
                        *(u32x2v*)(tb + (size_t)((2 * cb + (m >> 1)) * 64 + kl + 32 * (m & 1)) * 8 + 4 * hi) = pk; }
                    else { const int ks = kl >> 4, kk = kl & 15, hh = (kk >> 2) & 1, jj = (kk >> 3) * 4 + (kk & 3);
#pragma unroll
                        for (int e = 0; e < 4; ++e) { const int dcol = col + e; tb[(size_t)(((ks * 4 + (dcol >> 5)) * 64) + (dcol & 31) + 32 * hh) * 8 + jj] = f2bf(o[e]); } } }
            }
    }
}

constexpr int HG_QPP = 0, HG_KPP = 17408, HG_KET = 34816, HG_VT = 53248, HG_QSUM = 71680, HG_BEND = 73728;
constexpr int HG_RS = 136, HG_TS = 72;
struct HgP { const bf16* QAb; const bf16* IAb; const bf16* GAs; const float* F; bf16* QS; float* OI; float* Lb; float* DEC; bf16* SPT; };

__device__ __forceinline__ bf16x8 hg_pack8(const float (&v)[16], int o) { u32x4 w; w.x = cvtpk(v[o], v[o + 1]); w.y = cvtpk(v[o + 2], v[o + 3]); w.z = cvtpk(v[o + 4], v[o + 5]); w.w = cvtpk(v[o + 6], v[o + 7]); return __builtin_bit_cast(bf16x8, w); }

__device__ __forceinline__ void hgrn_local(const HgP& P0, int item, LAS unsigned char* lds, int tid) {
    HgP P = P0; asm volatile("" : "+s"(P.QAb), "+s"(P.IAb), "+s"(P.F), "+s"(P.QS), "+s"(P.OI), "+s"(P.Lb), "+s"(P.DEC));
    const int b = item >> 9, h = (item >> 6) & 7, c = item & 63; const size_t row0 = (size_t)b * TP + 64 * c;
    const int k = tid & 127, qd = tid >> 7, lane = tid & 63, wave = __builtin_amdgcn_readfirstlane(tid >> 6), l31 = lane & 31, hi = lane >> 5;
    LAS bf16* QPP = (LAS bf16*)(lds + HG_QPP); LAS bf16* KPP = (LAS bf16*)(lds + HG_KPP); LAS bf16* KET = (LAS bf16*)(lds + HG_KET); LAS bf16* VT = (LAS bf16*)(lds + HG_VT);
    LAS float* qsum = (LAS float*)(lds + HG_QSUM); LAS float* bendl = (LAS float*)(lds + HG_BEND);
    float bl[16], fk[16];
    { float run = 0.f;
#pragma unroll
        for (int i = 0; i < 16; ++i) { fk[i] = P.F[(row0 + 16 * qd + i) * LQ + h * 128 + k]; run += __logf(fk[i]); bl[i] = run; }
        qsum[qd * 128 + k] = run; }
    asm volatile("s_waitcnt lgkmcnt(0)" ::: "memory"); __builtin_amdgcn_s_barrier(); asm volatile("" ::: "memory");
    float pre = 0.f, bend = 0.f;
#pragma unroll
    for (int j = 0; j < 4; ++j) { const float s = qsum[j * 128 + k]; bend += s; pre += (j < qd) ? s : 0.f; }
    {
        float ke[16], vt[16];
#pragma unroll
        for (int i = 0; i < 16; ++i) {
            const int t = 16 * qd + i; const float eb = pre + bl[i];
            const float q = bf2f(P.QAb[(row0 + t) * LQ + h * 128 + k]), kk = 1.0f - fk[i];
            P.QS[(row0 + t) * 1024 + h * 128 + k] = f2bf(q * __expf(eb));
            QPP[t * HG_RS + k] = f2bf(q * __expf(fminf(eb - 0.5f * bend, 80.f)));
            KPP[t * HG_RS + k] = f2bf(kk * __expf(fminf(0.5f * bend - eb, 80.f)));
            ke[i] = kk * __expf(bend - eb); vt[i] = bf2f(P.IAb[(row0 + t) * LQ + h * 128 + k]);
        }
        *(LAS bf16x8*)(KET + k * HG_TS + 16 * qd) = hg_pack8(ke, 0); *(LAS bf16x8*)(KET + k * HG_TS + 16 * qd + 8) = hg_pack8(ke, 8);
        *(LAS bf16x8*)(VT + k * HG_TS + 16 * qd) = hg_pack8(vt, 0); *(LAS bf16x8*)(VT + k * HG_TS + 16 * qd + 8) = hg_pack8(vt, 8);
        if (qd == 3) P.DEC[(size_t)item * 128 + k] = __expf(bend);
    }
    asm volatile("s_waitcnt lgkmcnt(0)" ::: "memory"); __builtin_amdgcn_s_barrier(); asm volatile("" ::: "memory");
    const int tb = (wave < 4) ? 1 : 0, vb = wave & 3;
    f32x16 z = {0.f, 0.f, 0.f, 0.f, 0.f, 0.f, 0.f, 0.f, 0.f, 0.f, 0.f, 0.f, 0.f, 0.f, 0.f, 0.f};
#pragma unroll 1
    for (int sb = 0; sb <= tb; ++sb) {
        f32x16 x = {0.f, 0.f, 0.f, 0.f, 0.f, 0.f, 0.f, 0.f, 0.f, 0.f, 0.f, 0.f, 0.f, 0.f, 0.f, 0.f};
#pragma unroll
        for (int st = 0; st < 8; ++st) { const bf16x8 af = *(const LAS bf16x8*)(KPP + (32 * sb + l31) * HG_RS + 16 * st + 8 * hi), bf = *(const LAS bf16x8*)(QPP + (32 * tb + l31) * HG_RS + 16 * st + 8 * hi);
            x = __builtin_amdgcn_mfma_f32_32x32x16_bf16(af, bf, x, 0, 0, 0); }
        if (sb == tb) {
#pragma unroll
            for (int r = 0; r < 16; ++r) x[r] = (crow(r, hi) <= l31) ? x[r] : 0.f;
        }
#pragma unroll
        for (int ks = 0; ks < 2; ++ks) {
            u32x4 w; w.x = cvtpk(x[8 * ks + 0], x[8 * ks + 1]); w.y = cvtpk(x[8 * ks + 2], x[8 * ks + 3]); w.z = cvtpk(x[8 * ks + 4], x[8 * ks + 5]); w.w = cvtpk(x[8 * ks + 6], x[8 * ks + 7]);
            typedef unsigned u32x2v __attribute__((ext_vector_type(2)));
            const LAS bf16* vp = VT + (32 * vb + l31) * HG_TS + 32 * sb + 16 * ks + 4 * hi;
            const u32x2v lo = *(const LAS u32x2v*)vp, hh = *(const LAS u32x2v*)(vp + 8);
            u32x4 vv; vv.x = lo.x; vv.y = lo.y; vv.z = hh.x; vv.w = hh.y;
            z = __builtin_amdgcn_mfma_f32_32x32x16_bf16(__builtin_bit_cast(bf16x8, w), __builtin_bit_cast(bf16x8, vv), z, 0, 0, 0);
        }
    }
    { float* o = P.OI + (row0 + 32 * tb) * 1024 + h * 128 + 32 * vb + l31;
#pragma unroll
        for (int r = 0; r < 16; ++r) o[(size_t)crow(r, hi) * 1024] = z[r]; }
    const int nt = (wave < 4) ? 1 : 3, t0 = (wave < 4) ? wave : 4 + 3 * (wave - 4);
#pragma unroll 1
    for (int ti = 0; ti < nt; ++ti) {
        const int kb = (t0 + ti) >> 2, vb2 = (t0 + ti) & 3;
        f32x16 d = {0.f, 0.f, 0.f, 0.f, 0.f, 0.f, 0.f, 0.f, 0.f, 0.f, 0.f, 0.f, 0.f, 0.f, 0.f, 0.f};
#pragma unroll
        for (int st = 0; st < 4; ++st) { const bf16x8 af = *(const LAS bf16x8*)(KET + (32 * kb + l31) * HG_TS + 16 * st + 8 * hi), bf = *(const LAS bf16x8*)(VT + (32 * vb2 + l31) * HG_TS + 16 * st + 8 * hi);
            d = __builtin_amdgcn_mfma_f32_32x32x16_bf16(af, bf, d, 0, 0, 0); }
        float* o = P.Lb + (size_t)item * 16384 + (size_t)(32 * kb) * 128 + 32 * vb2 + l31;
#pragma unroll
        for (int r = 0; r < 16; ++r) o[crow(r, hi) * 128] = d[r];
    }
    asm volatile("s_waitcnt lgkmcnt(0)" ::: "memory"); __builtin_amdgcn_s_barrier(); asm volatile("" ::: "memory");
}
__device__ __forceinline__ void hgrn_carry(const HgP& P, float* hg_out, int id) {
    const int v = id & 127, kq = (id >> 7) & 31, bh = id >> 12;
    float S[4] = {0.f, 0.f, 0.f, 0.f};
#pragma unroll 8
    for (int c = 0; c < 64; ++c) {
        const size_t item = (size_t)bh * 64 + c;
        typedef unsigned u32x2v __attribute__((ext_vector_type(2)));
        u32x2v w; w.x = cvtpk(S[0], S[1]); w.y = cvtpk(S[2], S[3]);
        *(u32x2v*)(P.SPT + item * 16384 + (size_t)v * 128 + 4 * kq) = w;
#pragma unroll
        for (int j = 0; j < 4; ++j) S[j] = P.DEC[item * 128 + 4 * kq + j] * S[j] + P.Lb[item * 16384 + (size_t)(4 * kq + j) * 128 + v];
    }
#pragma unroll
    for (int j = 0; j < 4; ++j) hg_out[(size_t)bh * 16384 + (size_t)(4 * kq + j) * 128 + v] = S[j];
}
__device__ __forceinline__ void hgrn_output(const HgP& P0, const float* onorm0, bf16* OA0, int item, LAS unsigned char* lds, int tid) {
    HgP P = P0; const float* onorm = onorm0; bf16* OA = OA0; asm volatile("" : "+s"(P.GAs), "+s"(P.QS), "+s"(P.OI), "+s"(P.SPT), "+s"(onorm), "+s"(OA));
    const int b = item >> 9, h = (item >> 6) & 7, c = item & 63; const size_t row0 = (size_t)b * TP + 64 * c;
    const int lane = tid & 63, wave = __builtin_amdgcn_readfirstlane(tid >> 6), l31 = lane & 31, hi = lane >> 5, tb = wave >> 2, vb = wave & 3;
    f32x16 acc;
    { const float* o = P.OI + (row0 + 32 * tb) * 1024 + h * 128 + 32 * vb + l31;
#pragma unroll
        for (int r = 0; r < 16; ++r) acc[r] = o[(size_t)crow(r, hi) * 1024]; }
#pragma unroll
    for (int st = 0; st < 8; ++st) {
        const bf16x8 af = *(const bf16x8*)(P.QS + (row0 + 32 * tb + l31) * 1024 + h * 128 + 16 * st + 8 * hi);
        const bf16x8 bf = *(const bf16x8*)(P.SPT + (size_t)item * 16384 + (size_t)(32 * vb + l31) * 128 + 16 * st + 8 * hi);
        acc = __builtin_amdgcn_mfma_f32_32x32x16_bf16(af, bf, acc, 0, 0, 0);
    }
    LAS float* ol = (LAS float*)lds;
#pragma unroll
    for (int r = 0; r < 16; ++r) ol[(32 * tb + crow(r, hi)) * 132 + 32 * vb + l31] = acc[r];
    asm volatile("s_waitcnt lgkmcnt(0)" ::: "memory"); __builtin_amdgcn_s_barrier(); asm volatile("" ::: "memory");
    {
        const int t = tid >> 3, sg = tid & 7; float o[16]; float ss = 0.f;
#pragma unroll
        for (int j = 0; j < 16; ++j) { o[j] = ol[t * 132 + 16 * sg + j]; ss += o[j] * o[j]; }
        ss += __shfl_xor(ss, 1); ss += __shfl_xor(ss, 2); ss += __shfl_xor(ss, 4);
        const float r = rsqrtf(ss * (1.0f / 128) + EPS); const bf16* g = P.GAs + (row0 + t) * LQ + h * 128 + 16 * sg; const float* on = onorm + h * 128 + 16 * sg;
#pragma unroll
        for (int j = 0; j < 16; ++j) o[j] = o[j] * r * on[j] * bf2f(g[j]);
        bf16* dst = OA + (row0 + t) * 1024 + h * 128 + 16 * sg;
        *(bf16x8*)dst = hg_pack8(o, 0); *(bf16x8*)(dst + 8) = hg_pack8(o, 8);
    }
    asm volatile("s_waitcnt lgkmcnt(0)" ::: "memory"); __builtin_amdgcn_s_barrier(); asm volatile("" ::: "memory");
}

constexpr int SA_IMP = AL_IMPA;
constexpr int SA_UL = AL_END;
constexpr int SA_SM = SA_UL + 136 * 4;
constexpr int SA_END = SA_SM + 8 * 5 * 4;
static_assert(SA_END <= LDS_BYTES, "sample attention LDS control region");
struct SAttnP { const float* QBr; const float* qn_g; const float* gates; const float* relb; const float* KCS; const float* VCS; const float* cache_sel; const float* cache_win; const int* pt; const float* selnew; const float* winkv; float* PART; };
struct STile { const float* kp; const float* vp; int stride; int kmax; int k0; };

__device__ __forceinline__ bf16x8 sa_kfrag(const float* rowp, int s, int hi) {
    const f32x4 a = *(const f32x4*)(rowp + 16 * s + 8 * hi), c = *(const f32x4*)(rowp + 16 * s + 8 * hi + 4);
    u32x4 w; w.x = cvtpk(a[0], a[1]); w.y = cvtpk(a[2], a[3]); w.z = cvtpk(c[0], c[1]); w.w = cvtpk(c[2], c[3]); return __builtin_bit_cast(bf16x8, w);
}
__device__ __forceinline__ f32x16 sa_qk(const STile& T, const bf16x8 (&qf)[8], int l31, int hi) {
    const int kl = l31 < T.kmax ? l31 : T.kmax; const float* rowp = T.kp + (size_t)kl * T.stride;
    f32x16 p = {0.f, 0.f, 0.f, 0.f, 0.f, 0.f, 0.f, 0.f, 0.f, 0.f, 0.f, 0.f, 0.f, 0.f, 0.f, 0.f};
#pragma unroll
    for (int s = 0; s < 8; ++s) p = __builtin_amdgcn_mfma_f32_32x32x16_bf16(sa_kfrag(rowp, s, hi), qf[s], p, 0, 0, 0);
    return p;
}
__device__ __forceinline__ void sa_pv(f32x16 (&o)[4], const f32x16& e, const STile& T, int l31, int hi) {
#pragma unroll
    for (int ks = 0; ks < 2; ++ks) {
        u32x4 w; w.x = cvtpk(e[8 * ks + 0], e[8 * ks + 1]); w.y = cvtpk(e[8 * ks + 2], e[8 * ks + 3]); w.z = cvtpk(e[8 * ks + 4], e[8 * ks + 5]); w.w = cvtpk(e[8 * ks + 6], e[8 * ks + 7]);
        const bf16x8 pf = __builtin_bit_cast(bf16x8, w);
        const float* rp[8];
#pragma unroll
        for (int j = 0; j < 8; ++j) { int key = 16 * ks + 8 * (j >> 2) + 4 * hi + (j & 3); key = key < T.kmax ? key : T.kmax; rp[j] = T.vp + (size_t)key * T.stride + l31; }
#pragma unroll
        for (int dt = 0; dt < 4; ++dt) {
            float v[8];
#pragma unroll
            for (int j = 0; j < 8; ++j) v[j] = rp[j][32 * dt];
            u32x4 x; x.x = cvtpk(v[0], v[1]); x.y = cvtpk(v[2], v[3]); x.z = cvtpk(v[4], v[5]); x.w = cvtpk(v[6], v[7]);
            o[dt] = __builtin_amdgcn_mfma_f32_32x32x16_bf16(pf, __builtin_bit_cast(bf16x8, x), o[dt], 0, 0, 0);
        }
    }
}
template <int BR> __device__ __forceinline__ float sa_exp(f32x16& p, int k0, int hi, int qoff, const LAS float* bias_g, bool keep) {
    float sum = 0.f;
#pragma unroll
    for (int r = 0; r < 16; ++r) {
        const int kidx = k0 + crow(r, hi); const int rel = (BR == 0) ? qoff - (16 * kidx + 31) : qoff - kidx;
        const bool ok = rel >= 0 && (BR != 2 || rel < 512) && keep; const int ix = rel < 0 ? 0 : (rel > 128 ? 128 : rel);
        const float e = ok ? __builtin_amdgcn_exp2f(p[r] + bias_g[ix]) : 0.f; p[r] = e; sum += e;
    }
    return sum;
}
__device__ __forceinline__ void sa_reduce_store(f32x16 (&o)[4], float lsum, float* part_br, LAS unsigned char* lds, int wave, int lane, bool zero_it) {
    const int l31 = lane & 31, hi = lane >> 5, tid = wave * 64 + lane;
    LAS float* ob = (LAS float*)lds;
    LAS float* lx = (LAS float*)(lds + AL_LX);
    lsum += __shfl_xor(lsum, 32);
    if (hi == 0) lx[wave * 32 + l31] = lsum;
#pragma unroll
    for (int dt = 0; dt < 4; ++dt)
#pragma unroll
        for (int r = 0; r < 16; ++r) ob[(wave * 32 + crow(r, hi)) * 128 + 32 * dt + l31] = o[dt][r];
    AT_BAR();
    for (int u = tid; u < 32 * 128; u += NTHR) { float s = 0.f;
#pragma unroll
        for (int w = 0; w < 8; ++w) s += ob[w * 4096 + u];
        part_br[(u >> 7) * 132 + (u & 127)] = zero_it ? 0.f : s; }
    if (tid < 32) { float s = 0.f;
#pragma unroll
        for (int w = 0; w < 8; ++w) s += lx[w * 32 + tid];
        part_br[tid * 132 + 128] = zero_it ? 0.f : s; }
    AT_BAR();
}

__device__ __forceinline__ void attn_sample_unit(const SAttnP& P0, int b, int kv, int part, LAS unsigned char* lds, int wave, int lane) {
    SAttnP P = P0;
    asm volatile("" : "+s"(P.QBr), "+s"(P.qn_g), "+s"(P.gates), "+s"(P.relb), "+s"(P.KCS), "+s"(P.VCS), "+s"(P.cache_sel));
    asm volatile("" : "+s"(P.cache_win), "+s"(P.pt), "+s"(P.selnew), "+s"(P.winkv), "+s"(P.PART));
    const int l31 = lane & 31, hi = lane >> 5, tid = wave * 64 + lane;
    const int t = l31 >> 2, g = l31 & 3, head = kv * 4 + g, qpos = PAST + t;
    const size_t row = (size_t)MP + b * TS + t;
    LAS float* biasT = (LAS float*)(lds + AL_BIAS); LAS float* lx = (LAS float*)(lds + AL_LX); LAS float* imp = (LAS float*)(lds + SA_IMP);
    LAS int* ulist = (LAS int*)(lds + SA_UL); LAS unsigned* smw = (LAS unsigned*)(lds + SA_SM);
    for (int u = tid; u < 4 * 129; u += NTHR) { const int gg = u / 129, r = u % 129; biasT[gg * 132 + r] = P.relb[rel_bucket(r) * 8 + kv * 4 + gg] * LOG2E; }
    bf16x8 qf[8];
    load_q_frags(qf, P.QBr + row * LQ + head * 128, P.qn_g, hi);
    const LAS float* bias_g = biasT + g * 132;
    float* pbuf = P.PART + (((size_t)b * 2 + kv) * 4 + part) * (3 * 32 * 132);
    f32x16 o[4];
#pragma unroll
    for (int dt = 0; dt < 4; ++dt) o[dt] = (f32x16){0.f, 0.f, 0.f, 0.f, 0.f, 0.f, 0.f, 0.f, 0.f, 0.f, 0.f, 0.f, 0.f, 0.f, 0.f, 0.f};
    AT_BAR();
    {
        float lsum = 0.f;
#pragma unroll 1
        for (int u = 2 * wave; u < 2 * wave + 2; ++u) {
            STile T; T.kp = P.KCS + (((size_t)b * 512 + 32 * u) * 2 + kv) * 128; T.vp = nullptr; T.stride = 256; T.kmax = 31; T.k0 = 32 * u;
            f32x16 sc = sa_qk(T, qf, l31, hi); lsum += sa_exp<0>(sc, T.k0, hi, qpos, bias_g, true);
        }
        lsum += __shfl_xor(lsum, 32);
        if (hi == 0) lx[wave * 32 + l31] = lsum;
        AT_BAR();
        float ltot = 0.f;
#pragma unroll
        for (int w = 0; w < 8; ++w) ltot += lx[w * 32 + l31];
        const float inv = 1.0f / fmaxf(ltot, 1e-30f);
        float lkeep = 0.f;
#pragma unroll 1
        for (int u = 2 * wave; u < 2 * wave + 2; ++u) {
            STile T; T.kp = P.KCS + (((size_t)b * 512 + 32 * u) * 2 + kv) * 128; T.vp = P.VCS + (((size_t)b * 512 + 32 * u) * 2 + kv) * 128; T.stride = 256; T.kmax = 31; T.k0 = 32 * u;
            f32x16 sc = sa_qk(T, qf, l31, hi); lkeep += sa_exp<0>(sc, T.k0, hi, qpos, bias_g, true);
#pragma unroll
            for (int r = 0; r < 16; ++r) { const float pn = sc[r] * inv; float v = pn + __shfl_xor(pn, 1); v += __shfl_xor(v, 2); if (g == 0) imp[t * 512 + T.k0 + crow(r, hi)] = v; }
            if (part == 0) sa_pv(o, sc, T, l31, hi);
        }
        AT_BAR();
        sa_reduce_store(o, lkeep, pbuf + 0 * (32 * 132), lds, wave, lane, part != 0);
#pragma unroll
        for (int dt = 0; dt < 4; ++dt) o[dt] = (f32x16){0.f, 0.f, 0.f, 0.f, 0.f, 0.f, 0.f, 0.f, 0.f, 0.f, 0.f, 0.f, 0.f, 0.f, 0.f, 0.f};
        {
            const int tk = wave; float sc3[3];
#pragma unroll
            for (int j = 0; j < 3; ++j) { const int s = lane + 64 * j; float v = -INFINITY;
                if (s <= 128) { float a = 0.f; const LAS float* ip = imp + tk * 512 + 4 * s; asm volatile("" : "+v"(ip));
#pragma unroll
                    for (int c = -1; c <= 3; ++c) if (4 * s + c >= 0 && 4 * s + c < 512) a += ip[c];
                    const bool forced = (s == 0) || (s == 128) || (s == 127); v = a + (forced ? 1.0e6f : 0.f); }
                sc3[j] = v; }
            int rk[3] = {0, 0, 0};
#pragma unroll 1
            for (int tt = 0; tt < 129; ++tt) { const float u = __shfl(tt < 64 ? sc3[0] : (tt < 128 ? sc3[1] : sc3[2]), tt & 63);
#pragma unroll
                for (int j = 0; j < 3; ++j) { const int s = lane + 64 * j; rk[j] += (u > sc3[j] || (u == sc3[j] && tt < s)) ? 1 : 0; } }
            const unsigned long long m0 = __ballot(rk[0] < 16), m1 = __ballot(rk[1] < 16), m2 = __ballot(rk[2] < 16 && lane == 0);
            if (lane == 0) { smw[tk * 5] = (unsigned)m0; smw[tk * 5 + 1] = (unsigned)(m0 >> 32); smw[tk * 5 + 2] = (unsigned)m1; smw[tk * 5 + 3] = (unsigned)(m1 >> 32); smw[tk * 5 + 4] = (unsigned)(m2 & 1ull); }
        }
        AT_BAR();
    }
    const unsigned long long s0 = ((unsigned long long)smw[t * 5 + 1] << 32) | smw[t * 5], s1 = ((unsigned long long)smw[t * 5 + 3] << 32) | smw[t * 5 + 2]; const unsigned s2 = smw[t * 5 + 4];
    int nblk;
    {
        unsigned long long u0 = 0ull, u1 = 0ull; unsigned u2 = 0u;
#pragma unroll
        for (int k = 0; k < 8; ++k) { u0 |= ((unsigned long long)smw[k * 5 + 1] << 32) | smw[k * 5]; u1 |= ((unsigned long long)smw[k * 5 + 3] << 32) | smw[k * 5 + 2]; u2 |= smw[k * 5 + 4]; }
        const int n0 = __popcll(u0), n1 = __popcll(u1); nblk = n0 + n1 + (int)(u2 & 1u);
        if (wave == 0) {
            const unsigned long long below = (lane == 0) ? 0ull : (~0ull >> (64 - lane));
            if ((u0 >> lane) & 1ull) ulist[__popcll(u0 & below)] = lane;
            if ((u1 >> lane) & 1ull) ulist[n0 + __popcll(u1 & below)] = 64 + lane;
            if (lane == 0 && (u2 & 1u)) ulist[n0 + n1] = 128;
        }
    }
    AT_BAR();
    {
        float lsum = 0.f; const int nmine = (nblk - part + 3) >> 2;
#pragma unroll 1
        for (int it = wave; it < 2 * nmine; it += 8) {
            const int s = ulist[part + 4 * (it >> 1)], sub = it & 1;
            if (s == 128 && sub == 1) continue;
            STile T;
            if (s < 128) { const size_t pg = (size_t)P.pt[b * NPAGE + (s >> 1)] * PAGE + (s & 1) * 64 + sub * 32; T.kp = P.cache_sel + pg * 512 + kv * 128; T.vp = T.kp + 256; T.stride = 512; T.kmax = 31; }
            else { T.kp = P.selnew + (size_t)b * TS * 512 + kv * 128; T.vp = T.kp + 256; T.stride = 512; T.kmax = 7; }
            T.k0 = 64 * s + 32 * sub;
            const bool keep = (s < 64) ? (((s0 >> s) & 1ull) != 0ull) : (s < 128 ? (((s1 >> (s - 64)) & 1ull) != 0ull) : ((s2 & 1u) != 0u));
            f32x16 sc = sa_qk(T, qf, l31, hi); lsum += sa_exp<1>(sc, T.k0, hi, qpos, bias_g, keep);
            sa_pv(o, sc, T, l31, hi);
        }
        sa_reduce_store(o, lsum, pbuf + 1 * (32 * 132), lds, wave, lane, false);
#pragma unroll
        for (int dt = 0; dt < 4; ++dt) o[dt] = (f32x16){0.f, 0.f, 0.f, 0.f, 0.f, 0.f, 0.f, 0.f, 0.f, 0.f, 0.f, 0.f, 0.f, 0.f, 0.f, 0.f};
    }
    {
        float lsum = 0.f;
#pragma unroll 1
        for (int u = part + 4 * wave; u < 17; u += 32) {
            STile T;
            if (u < 16) { T.kp = P.cache_win + ((size_t)b * 512 + 32 * u) * 512 + kv * 128; T.vp = T.kp + 256; T.stride = 512; T.kmax = 31; }
            else { T.kp = P.winkv + ((size_t)MP + b * TS) * 512 + kv * 128; T.vp = T.kp + 256; T.stride = 512; T.kmax = 7; }
            T.k0 = 32 * u;
            f32x16 sc = sa_qk(T, qf, l31, hi); lsum += sa_exp<2>(sc, T.k0, hi, 512 + t, bias_g, true);
            sa_pv(o, sc, T, l31, hi);
        }
        sa_reduce_store(o, lsum, pbuf + 2 * (32 * 132), lds, wave, lane, false);
    }
}
__device__ __forceinline__ void attn_sample_combine(const float* PART, const float* gates, bf16* OB, int idx  , int lane) {
    const int rl = idx >> 3, head = idx & 7, b = rl >> 3, t = rl & 7, kv = head >> 2, g = head & 3, r = t * 4 + g;
    const float* base = PART + ((size_t)b * 2 + kv) * 4 * (3 * 32 * 132);
    float acc0 = 0.f, acc1 = 0.f;
#pragma unroll
    for (int br = 0; br < 3; ++br) {
        float l = 0.f, a0 = 0.f, a1 = 0.f;
#pragma unroll
        for (int p = 0; p < 4; ++p) { const float* q = base + ((size_t)p * 3 + br) * (32 * 132) + r * 132; l += q[128]; a0 += q[lane]; a1 += q[lane + 64]; }
        const float f = gates[((size_t)MP + rl) * 24 + head * 3 + br] / fmaxf(l, 1e-30f); acc0 += f * a0; acc1 += f * a1;
    }
    OB[((size_t)MP + rl) * 1024 + head * 128 + lane] = f2bf(acc0); OB[((size_t)MP + rl) * 1024 + head * 128 + lane + 64] = f2bf(acc1);
}

constexpr size_t al256(size_t x) { return (x + 255) & ~(size_t)255; }
constexpr size_t WS_BAR = 0;
constexpr size_t WS_WT_IN = al256(WS_BAR + XCD_BAR_WORDS * 4);
constexpr size_t WS_WT_BA = al256(WS_WT_IN + (size_t)NPROJ * D * 2);
constexpr size_t WS_WT_BB = al256(WS_WT_BA + (size_t)D * 1024 * 2);
constexpr size_t WS_WT_OUT = al256(WS_WT_BB + (size_t)D * 1024 * 2);
constexpr size_t WS_WT_1 = al256(WS_WT_OUT + (size_t)D * D * 2);
constexpr size_t WS_WT_2 = al256(WS_WT_1 + (size_t)DFF * D * 2);
constexpr size_t WS_MODS = al256(WS_WT_2 + (size_t)D * DFF * 2);
constexpr size_t WS_H = al256(WS_MODS + (size_t)34 * NMOD * 4);
constexpr size_t WS_PROJ = al256(WS_H + (size_t)MT * D * 2);
constexpr size_t WS_WINKV = al256(WS_PROJ + (size_t)0);
constexpr size_t WS_QN = al256(WS_WINKV + (size_t)MT * 512 * 4);
constexpr size_t WS_F = al256(WS_QN + (size_t)0);
constexpr size_t WS_ORAW = al256(WS_F + (size_t)MT * LQ * 4);
constexpr size_t WS_OA = al256(WS_ORAW + (size_t)MT * 1024 * 4);
constexpr size_t WS_OB = al256(WS_OA + (size_t)MT * 1024 * 2);
constexpr size_t WS_KCP = al256(WS_OB + (size_t)MT * 1024 * 2);
constexpr size_t WS_VCP = al256(WS_KCP + (size_t)0);
constexpr size_t WS_KCS = al256(WS_VCP + (size_t)0);
constexpr size_t WS_VCS = al256(WS_KCS + (size_t)32 * 512 * 256 * 4);
constexpr size_t WS_PCMP = al256(WS_VCS + (size_t)32 * 512 * 256 * 4);
constexpr size_t WS_IDX = al256(WS_PCMP + (size_t)0);
constexpr size_t WS_OCMP = al256(WS_IDX + (size_t)0);
constexpr size_t WS_OSEL = al256(WS_OCMP + (size_t)0);
constexpr size_t WS_OWIN = al256(WS_OSEL + (size_t)0);
constexpr size_t WS_T = al256(WS_OWIN + (size_t)0);
constexpr size_t WS_MERGED = al256(WS_T + (size_t)MT * D * 4);
constexpr size_t WS_X1 = al256(WS_MERGED + (size_t)MT * D * 2);
constexpr size_t WS_U = al256(WS_X1 + (size_t)MT * D * 4);
constexpr size_t WS_QNB = al256(WS_U + (size_t)MT * DFF * 2);
constexpr size_t WS_GATES = al256(WS_QNB + (size_t)0);
constexpr size_t WS_KSF = al256(WS_GATES + (size_t)MT * 24 * 4);
constexpr size_t WS_VSF = al256(WS_KSF + (size_t)4 * 128 * 4096 * 2);
constexpr size_t WS_KWF = al256(WS_VSF + (size_t)4 * 128 * 4096 * 2);
constexpr size_t WS_VWF = al256(WS_KWF + (size_t)4 * 128 * 4096 * 2);
constexpr size_t WS_KCF = al256(WS_VWF + (size_t)4 * 128 * 4096 * 2);
constexpr size_t WS_VCF = al256(WS_KCF + (size_t)4 * 8 * 4096 * 2);
constexpr size_t WS_OT = al256(WS_VCF + (size_t)4 * 8 * 4096 * 2);
constexpr size_t WS_IMP = al256(WS_OT + (size_t)0);
constexpr size_t WS_XHC = al256(WS_IMP + (size_t)0);
constexpr size_t WS_XHP = al256(WS_XHC + (size_t)256 * 256 * 2048 * 2);
constexpr size_t WS_WC1T = al256(WS_XHP + (size_t)2 * XHP_ROWS * 2048 * 2);
constexpr size_t WS_PREC = al256(WS_WC1T + (size_t)512 * 2048 * 2);
constexpr size_t WS_PREP = al256(WS_PREC + (size_t)2 * XHC_ROWS * 256 * 4);
constexpr size_t WS_HQS = al256(WS_PREP + (size_t)2 * XHP_ROWS * 256 * 4);
constexpr size_t WS_HOI = al256(WS_HQS + (size_t)MP * 1024 * 2);
constexpr size_t WS_HLB = al256(WS_HOI + (size_t)MP * 1024 * 4);
constexpr size_t WS_HDEC = al256(WS_HLB + (size_t)1024 * 16384 * 4);
constexpr size_t WS_HSPT = al256(WS_HDEC + (size_t)1024 * 128 * 4);
constexpr size_t WS_PART = al256(WS_HSPT + (size_t)1024 * 16384 * 2);
constexpr size_t WS_SLAB = al256(WS_PART + (size_t)64 * 4 * 3 * 32 * 132 * 4);
constexpr size_t WS_MODP = al256(WS_SLAB + (size_t)16 * 256 * 2048 * 4);
constexpr size_t WS_QAB = al256(WS_MODP + (size_t)8 * 34 * NMOD * 4);
constexpr size_t WS_IAB = al256(WS_QAB + (size_t)MT * LQ * 2);
constexpr size_t WS_GAS = al256(WS_IAB + (size_t)MT * LQ * 2);
constexpr size_t WS_QBR = al256(WS_GAS + (size_t)MT * LQ * 2);
constexpr size_t WS_MGAB = al256(WS_QBR + (size_t)MT * LQ * 4);
constexpr size_t WS_MGBB = al256(WS_MGAB + (size_t)MT * LMG * 2);
constexpr size_t WS_W2T = al256(WS_MGBB + (size_t)MT * LMG * 2);
constexpr size_t WS_END = al256(WS_W2T + (size_t)2 * 16384 * 2);

struct Args { const void* in[32]; float* out; unsigned char* ws; int ph_lo, ph_hi; };

#define G_x_p ((const float*)a.in[0])
#define G_x_s ((const float*)a.in[1])
#define G_c_p ((const float*)a.in[2])
#define G_c_s ((const float*)a.in[3])
#define G_cache_cmp ((const float*)a.in[4])
#define G_cache_sel ((const float*)a.in[5])
#define G_cache_win ((const float*)a.in[6])
#define G_state ((const float*)a.in[7])
#define G_pt ((const int*)a.in[8])
#define G_lbl ((const float*)a.in[9])
#define G_relb ((const float*)a.in[10])
#define G_ada_w ((const float*)a.in[11])
#define G_ada_b ((const float*)a.in[12])
#define G_norm1 ((const float*)a.in[13])
#define G_norm2 ((const float*)a.in[14])
#define G_w_in ((const float*)a.in[15])
#define G_onorm ((const float*)a.in[16])
#define G_qn_g ((const float*)a.in[17])
#define G_ks_g ((const float*)a.in[19])
#define G_kw_g ((const float*)a.in[20])
#define G_w_ba ((const float*)a.in[27])
#define G_w_bb ((const float*)a.in[28])
#define G_w_out ((const float*)a.in[29])
#define G_w1 ((const float*)a.in[30])
#define G_w2 ((const float*)a.in[31])
#define G_Wt_in ((bf16*)(a.ws + WS_WT_IN))
#define G_Wt_ba ((bf16*)(a.ws + WS_WT_BA))
#define G_Wt_bb ((bf16*)(a.ws + WS_WT_BB))
#define G_Wt_out ((bf16*)(a.ws + WS_WT_OUT))
#define G_Wt_1 ((bf16*)(a.ws + WS_WT_1))
#define G_Wt_2 ((bf16*)(a.ws + WS_WT_2))
#define G_mods ((float*)(a.ws + WS_MODS))
#define G_H ((bf16*)(a.ws + WS_H))
#define G_proj ((float*)(a.ws + WS_PROJ))
#define G_winkv ((float*)(a.ws + WS_WINKV))
#define G_QN ((float*)(a.ws + WS_QN))
#define G_F ((float*)(a.ws + WS_F))
#define G_oraw ((float*)(a.ws + WS_ORAW))
#define G_OA ((bf16*)(a.ws + WS_OA))
#define G_OB ((bf16*)(a.ws + WS_OB))
#define G_KCP ((float*)(a.ws + WS_KCP))
#define G_VCP ((float*)(a.ws + WS_VCP))
#define G_KCS ((float*)(a.ws + WS_KCS))
#define G_VCS ((float*)(a.ws + WS_VCS))
#define G_PCMP ((float*)(a.ws + WS_PCMP))
#define G_IDX ((int*)(a.ws + WS_IDX))
#define G_OCMP ((float*)(a.ws + WS_OCMP))
#define G_OSEL ((float*)(a.ws + WS_OSEL))
#define G_OWIN ((float*)(a.ws + WS_OWIN))
#define G_QNb ((bf16*)(a.ws + WS_QNB))
#define G_GATES ((float*)(a.ws + WS_GATES))
#define G_KSf ((bf16*)(a.ws + WS_KSF))
#define G_VSf ((bf16*)(a.ws + WS_VSF))
#define G_KWf ((bf16*)(a.ws + WS_KWF))
#define G_VWf ((bf16*)(a.ws + WS_VWF))
#define G_KCf ((bf16*)(a.ws + WS_KCF))
#define G_VCf ((bf16*)(a.ws + WS_VCF))
#define G_T ((float*)(a.ws + WS_T))
#define G_MERGED ((bf16*)(a.ws + WS_MERGED))
#define G_X1 ((float*)(a.ws + WS_X1))
#define G_U ((bf16*)(a.ws + WS_U))
#define G_XHC ((bf16*)(a.ws + WS_XHC))
#define G_XHP ((bf16*)(a.ws + WS_XHP))
#define G_Wc1t ((bf16*)(a.ws + WS_WC1T))
#define G_PREC ((float*)(a.ws + WS_PREC))
#define G_PREP ((float*)(a.ws + WS_PREP))
#define G_out (a.out)
#define G_ws (a.ws)
#define lane ((int)__builtin_amdgcn_mbcnt_hi(~0u, __builtin_amdgcn_mbcnt_lo(~0u, 0u)))
#define wave (wave_s)
#define tid (wave_s * 64 + lane)
#define sub2 (wave_s >> 2)
#define lt2 ((wave_s & 3) * 64 + lane)
#define sub4 (wave_s >> 1)
#define lt4 ((wave_s & 1) * 64 + lane)
__global__ void __launch_bounds__(NTHR, 2) mk_fwd(Args a) {
    extern __shared__ __attribute__((aligned(16))) unsigned char lds[];
    const int G = gridDim.x, bid = blockIdx.x;
    const int wave_s = __builtin_amdgcn_readfirstlane((int)threadIdx.x >> 6);
    if (threadIdx.x < 4) ((unsigned*)(lds + LDS_CTL))[threadIdx.x] = 0u;
    __syncthreads();
    const int lo = a.ph_lo, hi = a.ph_hi;
    XcdBarrier bar; bar.bar = (unsigned*)(G_ws + WS_BAR); bar.x = 0; bar.st = nullptr;
    if (hi - lo > 1) bar = xcd_barrier_post((unsigned*)(G_ws + WS_BAR), (volatile LAS unsigned*)(lds + LDS_CTL), wave_s);
#define IN(k) (lo <= (k) && (k) < hi)
#define MK_HGP() HgP hp; hp.QAb = (const bf16*)(G_ws + WS_QAB); hp.IAb = (const bf16*)(G_ws + WS_IAB); hp.GAs = (const bf16*)(G_ws + WS_GAS); hp.F = G_F; hp.QS = (bf16*)(G_ws + WS_HQS); hp.OI = (float*)(G_ws + WS_HOI); hp.Lb = (float*)(G_ws + WS_HLB); hp.DEC = (float*)(G_ws + WS_HDEC); hp.SPT = (bf16*)(G_ws + WS_HSPT)
#define SEAM(k) do { if (IN(k) && IN((k) + 1)) xcd_barrier(bar, wave_s); } while (0)
    float* ldsf = (float*)lds;

    if (IN(PH_PRO)) {
        constexpr int T_IN = (NPROJ / 128) * (D / 128), T_BA = (D / 128) * (1024 / 128), T_OUT = (D / 128) * (D / 128), T_1 = (DFF / 128) * (D / 128), T_2 = (D / 128) * (DFF / 128), T_C = 4 * 16;
        constexpr int NT = T_IN + 2 * T_BA + T_OUT + T_1 + T_2 + T_C + 2;
        for (int it = bid; it < NT; it += G) {
            int r = it;
            if (r < T_IN) { const int nb = r % (NPROJ / 128), kb = r / (NPROJ / 128), n0 = nb * 128; const int c0 = win_col(n0); const int lim = n0 < C_GATE ? 128 : (n0 == C_GATE ? 24 : 0);
                b_transpose128(G_w_in, IN_COLS, c0 < 0 ? 0 : c0, lim, G_Wt_in, D, n0, kb * 128, tid, ldsf); continue; } r -= T_IN;
            if (r < T_BA) { b_transpose128(G_w_ba, D, (r % 16) * 128, 128, G_Wt_ba, 1024, (r % 16) * 128, (r / 16) * 128, tid, ldsf); continue; } r -= T_BA;
            if (r < T_BA) { b_transpose128(G_w_bb, D, (r % 16) * 128, 128, G_Wt_bb, 1024, (r % 16) * 128, (r / 16) * 128, tid, ldsf); continue; } r -= T_BA;
            if (r < T_OUT) { b_transpose128(G_w_out, D, (r % 16) * 128, 128, G_Wt_out, D, (r % 16) * 128, (r / 16) * 128, tid, ldsf); continue; } r -= T_OUT;
            if (r < T_1) { b_transpose128(G_w1, DFF, (r % 64) * 128, 128, G_Wt_1, D, (r % 64) * 128, (r / 64) * 128, tid, ldsf); continue; } r -= T_1;
            if (r < T_2) { b_transpose128(G_w2, D, (r % 16) * 128, 128, G_Wt_2, DFF, (r % 16) * 128, (r / 16) * 128, tid, ldsf); continue; } r -= T_2;
            if (r >= T_C) { const int w = r - T_C; b_transpose128(w ? (const float*)a.in[26] : (const float*)a.in[23], 128, 0, 128, (bf16*)(G_ws + WS_W2T) + (size_t)w * 16384, 128, 0, 0, tid, ldsf); continue; }
            { const int wh = r >> 4, kb = r & 15;
              b_transpose128((wh >> 1 ? (const float*)a.in[24] : (const float*)a.in[21]) + (size_t)(wh & 1) * 2048 * 128, 128, 0, 128, G_Wc1t + (size_t)wh * 128 * 2048, 2048, 0, kb * 128, tid, ldsf); }
        }
        for (size_t u = (size_t)bid * NTHR + tid; u < (size_t)2 * 4 * 8 * 4096 / 8; u += (size_t)G * NTHR) { bf16* z = u < (size_t)4 * 8 * 4096 / 8 ? G_KCf + u * 8 : G_VCf + (u - (size_t)4 * 8 * 4096 / 8) * 8; *(u32x4*)z = (u32x4){0u, 0u, 0u, 0u}; }
        for (size_t u = (size_t)bid * NTHR + tid; u < (size_t)2 * 256 * 2048 / 8; u += (size_t)G * NTHR) { const size_t w = u / (256 * 256), r = u % (256 * 256); *(u32x4*)(G_XHP + ((size_t)w * XHP_ROWS + 1024) * 2048 + r * 8) = (u32x4){0u, 0u, 0u, 0u}; }
        for (int it = G - 1 - bid; it < 192; it += G) b_mods_part(G_c_p, G_c_s, G_ada_w, (float*)(G_ws + WS_MODP), it % 24, it / 24, tid, ldsf);
    }
    SEAM(PH_PRO);
    if (IN(PH_MRED)) { const float* mp = (const float*)(G_ws + WS_MODP);
        for (int u = bid * NTHR + tid; u < 34 * NMOD; u += G * NTHR) { float s = G_ada_b[u % NMOD];
#pragma unroll
            for (int kc = 0; kc < 8; ++kc) s += mp[(size_t)kc * 34 * NMOD + u];
            G_mods[u] = s; } }
    SEAM(PH_MRED);
    if (IN(PH_NORM1)) { for (int row = bid * 8 + wave; row < MT; row += G * 8) b_hnorm_wave(G_x_p, G_x_s, G_norm1, G_mods, 0, 1, G_H, row, lane); }
    SEAM(PH_NORM1);
    if (IN(PH_INPROJ)) {
        pg8::Gemm g{G_H, G_Wt_in, MT, NPROJ, D, D, nullptr, nullptr};
        EpiInProj E; E.o.QAb = (bf16*)(G_ws + WS_QAB); E.o.F = G_F; E.o.IAb = (bf16*)(G_ws + WS_IAB); E.o.GAs = (bf16*)(G_ws + WS_GAS); E.o.QBr = (float*)(G_ws + WS_QBR); E.o.out = G_out; E.o.XHP = G_XHP; E.o.WINKV = G_winkv;
        E.o.MGAb = (bf16*)(G_ws + WS_MGAB); E.o.MGBb = (bf16*)(G_ws + WS_MGBB); E.o.GATES = G_GATES; E.o.lbl = G_lbl;
        const int ksplit = (bid >> 3) % 6;
        { RangeOrder<pg8::StaticOrder> S; S.B.init(MT, NPROJ, G, bid, D); S.i0 = 0; S.i1 = ksplit;
          pg8::gemm_phase<EpiInProj, RangeOrder<pg8::StaticOrder>, false>((PG8_LAS unsigned char*)lds, g, S, E, nullptr, wave_s); }
        { bf16* panel = G_XHC + (size_t)bid * 256 * 2048; const int L = bid;
          __syncthreads();
          b_xhc_panel(G_cache_cmp, G_pt, panel, L, tid);
          __syncthreads();
          pg8::Gemm gc{panel, G_Wc1t, 256, 512, 2048, 2048, nullptr, nullptr}; OneOrder S; S.pn = L >> 7; EpiGen<FStorePre> Ec; Ec.f.C = G_PREC; Ec.f.rowoff = L * 256; Ec.f.pad = 0; Ec.slab = nullptr; Ec.slab_n = 0; Ec.kslice = 1;
          pg8::gemm_phase<EpiGen<FStorePre>, OneOrder, false>((PG8_LAS unsigned char*)lds, gc, S, Ec, nullptr, wave_s); }
        { RangeOrder<pg8::StaticOrder> S; S.B.init(MT, NPROJ, G, bid, D); S.i0 = ksplit; S.i1 = 1 << 20;
          pg8::gemm_phase<EpiInProj, RangeOrder<pg8::StaticOrder>, false>((PG8_LAS unsigned char*)lds, g, S, E, nullptr, wave_s); }
    }
    SEAM(PH_INPROJ);
    if (IN(PH_MIX1)) {
        for (int x = 16 + bid * 4 + sub4; x < 16 + 256; x += G * 4) b_hgrn_seq((const bf16*)(G_ws + WS_QAB), (const bf16*)(G_ws + WS_IAB), G_F, G_state, G_oraw, G_out, x, lt4);
        const int NW = G - 10;
        if (bid < NW) for (int it = NW - 1 - bid; it < 1024; it += NW) { const int which = it >> 9, r = it & 511, b = r >> 8, kv = (r >> 7) & 1, Tt = r & 127; const size_t to = (((size_t)b * 2 + kv) * 128 + Tt) * 4096;
            float* wout = (which == 1 && Tt >= 112) ? G_out + O_WINP + ((size_t)b * 512 + 32 * (Tt - 112)) * 512 : nullptr;
            prep_kv_tile(which == 0 ? G_out + O_SELP : G_winkv, which == 0 ? G_ks_g : G_kw_g, (which == 0 ? G_KSf : G_KWf) + to, (which == 0 ? G_VSf : G_VWf) + to, wout, b, kv, Tt, tid, ldsf + 20480); }
        for (int it = bid; it < 32; it += G) prep_kv_sample(G_out, G_winkv, G_ks_g, G_kw_g, it * 32 + (tid >> 4), tid & 15);
        { const size_t n = (size_t)BS * 504 * 512 / 4;
          for (size_t i = (size_t)bid * NTHR + tid; i < n; i += (size_t)G * NTHR) { const size_t b = i / (504 * 128), r = i % (504 * 128); *(f32x4*)(G_out + O_WINS + b * 512 * 512 + r * 4) = *(const f32x4*)(G_cache_win + b * 512 * 512 + 8 * 512 + r * 4); } }
        { MK_HGP();
          if (bid < NW)
#pragma unroll 1
          for (int item = bid; item < 1024; item += NW) hgrn_local(hp, item, (LAS unsigned char*)lds, tid); }
        { pg8::Gemm g{G_XHP, G_Wc1t, 2 * XHP_ROWS, 512, 2048, 2048, nullptr, nullptr}; DiagOrder S; S.n = 10; S.per = 5; S.G = G; S.c = G - 1 - bid; EpiGen<FStorePre> E; E.f.C = G_PREP; E.f.rowoff = 0; E.f.pad = 0; E.slab = nullptr; E.slab_n = 0; E.kslice = 1;
          __syncthreads();
          pg8::gemm_phase<EpiGen<FStorePre>, DiagOrder, false>((PG8_LAS unsigned char*)lds, g, S, E, nullptr, wave_s); }
    }
    SEAM(PH_MIX1);
    if (IN(PH_CFIN)) {
        CmpW cw; cw.kw1 = (const float*)a.in[21]; cw.kb1 = (const float*)a.in[22]; cw.kw2 = (const float*)a.in[23]; cw.vw1 = (const float*)a.in[24]; cw.vb1 = (const float*)a.in[25]; cw.vw2 = (const float*)a.in[26]; cw.kc_g = (const float*)a.in[18];
        { MK_HGP(); for (int id = bid * NTHR + tid; id < 65536; id += G * NTHR) hgrn_carry(hp, G_out + O_HGP, id); }
        if (bid >= 128) for (int item = (bid - 128) * 8 + wave; item < 64 + 2048; item += 128 * 8) b_cfin_mfma(
            G_PREC, G_PREP, (const bf16*)(G_ws + WS_W2T), cw, G_KCf, G_VCf, G_KCS, G_VCS, item, lane);
    }
    SEAM(PH_CFIN);
    if (IN(PH_ATTN)) {
        for (int row = MP + bid * 2 + sub2; row < MT; row += G * 2) b_hgrn_out(G_oraw, (const bf16*)(G_ws + WS_GAS), G_onorm, G_OA, row, lt2);
        { MK_HGP();
#pragma unroll 1
          for (int item = bid; item < 1024; item += G) hgrn_output(hp, G_onorm, G_OA, item, (LAS unsigned char*)lds, tid); }
        AttnP P; P.QBr = (const float*)(G_ws + WS_QBR); P.qn_g = G_qn_g; P.KSf = G_KSf; P.VSf = G_VSf; P.KWf = G_KWf; P.VWf = G_VWf; P.KCf = G_KCf; P.VCf = G_VCf; P.gates = G_GATES; P.relb = G_relb; P.OB = G_OB; P.OT = (float*)(G_ws + WS_OT); P.IMP = (float*)(G_ws + WS_IMP);
#pragma unroll 1
        for (int k = 0; k < 2; ++k) { const int u = bid, bk = u & 3, m = u >> 2; attn_prompt_unit(P, bk >> 1, bk & 1, k ? m : 127 - m, (LAS unsigned char*)lds, wave, lane); }
    }
    SEAM(PH_ATTN);
    if (IN(PH_SATTN)) {
        SAttnP P; P.QBr = (const float*)(G_ws + WS_QBR); P.qn_g = G_qn_g; P.gates = G_GATES; P.relb = G_relb; P.KCS = G_KCS; P.VCS = G_VCS; P.cache_sel = G_cache_sel; P.cache_win = G_cache_win; P.pt = G_pt; P.selnew = G_out + O_SELS; P.winkv = G_winkv; P.PART = (float*)(G_ws + WS_PART);
        { const int u = bid; attn_sample_unit(P, u >> 3, (u >> 2) & 1, u & 3, (LAS unsigned char*)lds, wave, lane); }
    }
    SEAM(PH_SATTN);
    if (IN(PH_SCOMB)) { for (int idx = bid * 8 + wave; idx < 2048; idx += G * 8) attn_sample_combine((const float*)(G_ws + WS_PART), G_GATES, G_OB, idx, lane); }
    SEAM(PH_SCOMB);
#define SLABP(off) ((float*)(G_ws + WS_SLAB) + (size_t)(off))
    if (IN(PH_BR)) { pg8::Gemm g{G_OA, G_Wt_ba, MT, D, 1024, 1024, G_OB, G_Wt_bb}; PairOrder S; S.init(D, 1024, 4, G, bid);
        EpiBranch E; E.mga = (const bf16*)(G_ws + WS_MGAB); E.mgb = (const bf16*)(G_ws + WS_MGBB); E.T = G_T; E.merged = G_MERGED; E.slab = SLABP(0); E.kslice = 256; E.pad = 0;
        pg8::gemm_phase<EpiBranch, PairOrder, false>((PG8_LAS unsigned char*)lds, g, S, E, nullptr, wave_s); }
    SEAM(PH_BR);
    if (IN(PH_RMERGE)) {
        const float* sa = SLABP(0); const float* sb = SLABP(4 * 256 * 2048);
        for (int u = bid * NTHR + tid; u < 256 * 512; u += G * NTHR) { const int r = u >> 9, c = (u & 511) * 4; f32x4 x = {0.f, 0.f, 0.f, 0.f}, y = x;
#pragma unroll
            for (int ks = 0; ks < 4; ++ks) { x += *(const f32x4*)(sa + ((size_t)ks * 256 + r) * 2048 + c); y += *(const f32x4*)(sb + ((size_t)ks * 256 + r) * 2048 + c); }
            const ushort4 ga = *(const ushort4*)((const bf16*)(G_ws + WS_MGAB) + ((size_t)MP + r) * LMG + c), gb = *(const ushort4*)((const bf16*)(G_ws + WS_MGBB) + ((size_t)MP + r) * LMG + c); ushort4 o;
            o.x = f2bf(bf2f(ga.x) * x[0] + bf2f(gb.x) * y[0]); o.y = f2bf(bf2f(ga.y) * x[1] + bf2f(gb.y) * y[1]); o.z = f2bf(bf2f(ga.z) * x[2] + bf2f(gb.z) * y[2]); o.w = f2bf(bf2f(ga.w) * x[3] + bf2f(gb.w) * y[3]);
            *(ushort4*)(G_MERGED + ((size_t)MP + r) * D + c) = o; }
    }
    SEAM(PH_RMERGE);
    if (IN(PH_OUT)) { pg8::Gemm g{G_MERGED, G_Wt_out, MT, D, D, D, nullptr, nullptr}; MixOrder S; S.init(D, D, 8, G, bid); EpiGen<FRes1> E; E.f.xp = G_x_p; E.f.xs = G_x_s; E.f.mods = G_mods; E.f.X1 = G_X1; E.slab = SLABP(0); E.slab_n = D; E.kslice = 256;
        pg8::gemm_phase<EpiGen<FRes1>, MixOrder, false>((PG8_LAS unsigned char*)lds, g, S, E, nullptr, wave_s); }
    SEAM(PH_OUT);
    if (IN(PH_NORM2)) {
        for (int row = MP + bid * 2 + sub2; row < MT; row += G * 2) b_norm2_sample(G_x_s, SLABP(0), G_norm2, G_mods, G_X1, G_H, row, lt2, ldsf + sub2 * 4);
        for (int row = bid * 8 + wave; row < MP; row += G * 8) b_hnorm_wave(G_X1, G_X1 + (size_t)MP * D, G_norm2, G_mods, 3, 4, G_H, row, lane);
    }
    SEAM(PH_NORM2);
    if (IN(PH_MLP1)) { pg8::Gemm g{G_H, G_Wt_1, MT, DFF, D, D, nullptr, nullptr}; MixOrder S; S.init(DFF, D, 4, G, bid); EpiGen<FRelu2> E; E.f.U = G_U; E.slab = SLABP(0); E.slab_n = DFF; E.kslice = 512;
        pg8::gemm_phase<EpiGen<FRelu2>, MixOrder, false>((PG8_LAS unsigned char*)lds, g, S, E, nullptr, wave_s); }
    SEAM(PH_MLP1);
    if (IN(PH_RU)) {
        const float* su = SLABP(0);
        for (int u = bid * NTHR + tid; u < 256 * 2048; u += G * NTHR) { const int r = u >> 11, c = (u & 2047) * 4; f32x4 x = {0.f, 0.f, 0.f, 0.f};
#pragma unroll
            for (int ks = 0; ks < 4; ++ks) x += *(const f32x4*)(su + ((size_t)ks * 256 + r) * DFF + c);
            ushort4 o; float t; t = fmaxf(x[0], 0.f); o.x = f2bf(t * t); t = fmaxf(x[1], 0.f); o.y = f2bf(t * t); t = fmaxf(x[2], 0.f); o.z = f2bf(t * t); t = fmaxf(x[3], 0.f); o.w = f2bf(t * t);
            *(ushort4*)(G_U + ((size_t)MP + r) * DFF + c) = o; }
    }
    SEAM(PH_RU);
    if (IN(PH_MLP2)) { pg8::Gemm g{G_U, G_Wt_2, MT, D, DFF, DFF, nullptr, nullptr}; MixOrder S; S.init(D, DFF, 16, G, bid); EpiGen<FRes2> E; E.f.X1 = G_X1; E.f.mods = G_mods; E.f.out = G_out; E.slab = SLABP(0); E.slab_n = D; E.kslice = 512;
        pg8::gemm_phase<EpiGen<FRes2>, MixOrder, false>((PG8_LAS unsigned char*)lds, g, S, E, nullptr, wave_s); }
    SEAM(PH_MLP2);
    if (IN(PH_RY)) {
        const float* sy = SLABP(0);
        for (int u = bid * NTHR + tid; u < 256 * 512; u += G * NTHR) { const int r = u >> 9, c = (u & 511) * 4; f32x4 x = {0.f, 0.f, 0.f, 0.f};
#pragma unroll
            for (int ks = 0; ks < 16; ++ks) x += *(const f32x4*)(sy + ((size_t)ks * 256 + r) * 2048 + c);
            const f32x4 xv = *(const f32x4*)(G_X1 + ((size_t)MP + r) * D + c), g2 = *(const f32x4*)(G_mods + (size_t)modrow(MP + r) * NMOD + 5 * D + c);
            *(f32x4*)(G_out + ((size_t)MP + r) * D + c) = xv + g2 * x; }
    }
#undef SLABP
#undef IN
#undef SEAM
}
#undef G_x_p
#undef G_x_s
#undef G_c_p
#undef G_c_s
#undef G_cache_cmp
#undef G_cache_sel
#undef G_cache_win
#undef G_state
#undef G_pt
#undef G_lbl
#undef G_relb
#undef G_ada_w
#undef G_ada_b
#undef G_norm1
#undef G_norm2
#undef G_w_in
#undef G_onorm
#undef G_qn_g
#undef G_ks_g
#undef G_kw_g
#undef G_w_ba
#undef G_w_bb
#undef G_w_out
#undef G_w1
#undef G_w2
#undef G_Wt_in
#undef G_Wt_ba
#undef G_Wt_bb
#undef G_Wt_out
#undef G_Wt_1
#undef G_Wt_2
#undef G_mods
#undef G_H
#undef G_proj
#undef G_winkv
#undef G_QN
#undef G_F
#undef G_oraw
#undef G_OA
#undef G_OB
#undef G_KCP
#undef G_VCP
#undef G_KCS
#undef G_VCS
#undef G_PCMP
#undef G_IDX
#undef G_OCMP
#undef G_OSEL
#undef G_OWIN
#undef G_QNb
#undef G_GATES
#undef G_KSf
#undef G_VSf
#undef G_KWf
#undef G_VWf
#undef G_KCf
#undef G_VCf
#undef G_T
#undef G_MERGED
#undef G_X1
#undef G_U
#undef G_XHC
#undef G_XHP
#undef G_Wc1t
#undef G_PREC
#undef G_PREP
#undef G_out
#undef G_ws
#undef tid
#undef lane
#undef wave
#undef sub2
#undef lt2
#undef sub4
#undef lt4


#ifndef MK_N_LAUNCHES
#define MK_N_LAUNCHES 1
#endif
extern "C" void kernel_launch(void* const* d_in, const int* in_sizes, int n_in, void* d_out, int out_size, void* d_ws, size_t ws_size, hipStream_t stream) {
    (void)in_sizes; (void)out_size;
    static int grid = 0;
    if (grid == 0) {
        if (n_in != 32 || ws_size < WS_END) { fprintf(stderr, "kernel_launch: unexpected inputs (%d) or workspace (%zu < %zu)\n", n_in, ws_size, (size_t)WS_END); grid = -1; return; }
        int dev = 0, cus = 0, per_cu = 0;
        (void)hipGetDevice(&dev); (void)hipDeviceGetAttribute(&cus, hipDeviceAttributeMultiprocessorCount, dev);
        if (hipFuncSetAttribute((const void*)mk_fwd, hipFuncAttributeMaxDynamicSharedMemorySize, LDS_BYTES) != hipSuccess) { fprintf(stderr, "kernel_launch: hipFuncSetAttribute failed\n"); grid = -1; return; }
        if (hipOccupancyMaxActiveBlocksPerMultiprocessor(&per_cu, (const void*)mk_fwd, NTHR, LDS_BYTES) != hipSuccess || per_cu < 1) { fprintf(stderr, "kernel_launch: occupancy query says %d\n", per_cu); }
        (void)hipGetLastError();
        if (cus != 256) { fprintf(stderr, "kernel_launch: built for a 256-CU device, found %d CUs\n", cus); grid = -1; return; }
        grid = 256;
    }
    if (grid < 0) return;
    (void)hipMemsetAsync((char*)d_ws + WS_BAR, 0, XCD_BAR_WORDS * 4, stream);
    Args a{};
    for (int i = 0; i < 32; ++i) a.in[i] = d_in[i];
    a.out = (float*)d_out; a.ws = (unsigned char*)d_ws;
    if (MK_N_LAUNCHES == 1) { a.ph_lo = 0; a.ph_hi = N_PHASES; hipLaunchKernelGGL(mk_fwd, dim3(grid), dim3(NTHR), LDS_BYTES, stream, a); }
    else { for (int k = 0; k < N_PHASES; ++k) { a.ph_lo = k; a.ph_hi = k + 1; hipLaunchKernelGGL(mk_fwd, dim3(grid), dim3(NTHR), LDS_BYTES, stream, a); } }
}
```

```cpp
#include <hip/hip_runtime.h>
#include <stdint.h>
#include <math.h>
#include <cstdio>

namespace pg8 {
#define PG8_LAS __attribute__((address_space(3)))
typedef unsigned short bf16_t;
typedef short bf16x8 __attribute__((ext_vector_type(8)));
typedef float f32x4 __attribute__((ext_vector_type(4)));
typedef unsigned u32x4 __attribute__((ext_vector_type(4)));
constexpr int BM = 256, BK = 64, HALF = 128, HTB = HALF * BK * 2  , STAGE_BYTES = 8 * HTB, NXCD = 8, WGM = 8;

__host__ __device__ __forceinline__ int lds_byte(int r, int c) { const int st = (r >> 4) * 2 + (c >> 5), rr = r & 15, cc = c & 31, ob = rr * 64 + cc * 2; return st * 1024 + (ob ^ (((ob >> 9) & 1) << 5)); }
__host__ __device__ __forceinline__ void stage_rc(int b, int& R, int& C) { const int st = b / 1024, sb = b % 1024, swz = sb ^ (((sb >> 9) & 1) << 5); R = (st >> 1) * 16 + swz / 64; C = (st & 1) * 32 + (swz % 64) / 2; }
__host__ __device__ __forceinline__ int perm32(int rho) { const int n = rho >> 4, i = rho & 15; return 8 * (i >> 2) + 4 * n + (i & 3); }

struct Unit { int pm, pn, k0, nt, sel; };
struct Gemm { const bf16_t* A; const bf16_t* Bt; int M, N, K, ld; const bf16_t* A2; const bf16_t* Bt2; };

struct StaticOrder {
    int nM, nN, nwg, G, c, nt0;
    __host__ __device__ void init(int M, int N, int G_, int c_, int K_ = 0) { nM = M / BM; nN = N / BM; nwg = nM * nN; G = G_; c = c_; nt0 = K_ / BK; }
    __host__ __device__ bool next(int i, Unit& u) const {
        const long L = (long)i * G + c; if (L >= nwg) return false;
        int wgid = (int)L; { const int q = nwg / NXCD, r = nwg % NXCD, xcd = wgid % NXCD, off = wgid / NXCD; wgid = (xcd < r ? xcd * (q + 1) : r * (q + 1) + (xcd - r) * q) + off; }
        const int nig = WGM * nN, gid = wgid / nig, fm = gid * WGM, gsz = (nM - fm) < WGM ? (nM - fm) : WGM;
        u.pm = fm + ((wgid % nig) % gsz); u.pn = (wgid % nig) / gsz; u.k0 = 0; u.nt = nt0; u.sel = 0; return true;
    }
    __device__ __forceinline__ void a_ready(const Unit&) const {}
    __device__ __forceinline__ void done(const Unit&) const {}
};
template <class Epi, class Sched, bool STAMP = false>
__device__ __forceinline__ void gemm_phase(PG8_LAS unsigned char* lds, const Gemm g, const Sched& S, const Epi& E, unsigned long long* stamps, int pg8_wave_id) {
    const int wid = __builtin_amdgcn_readfirstlane(pg8_wave_id), lane = (int)__builtin_amdgcn_mbcnt_hi(~0u, __builtin_amdgcn_mbcnt_lo(~0u, 0u)), tid = wid * 64 + lane, wr = wid >> 2, wc = wid & 3, fr = lane & 15, fq = lane >> 4;
    const int K = g.ld;
    int ts_lo = 0, ts_hi = 0, nts = 0; const unsigned long long rt_entry = STAMP ? (unsigned long long)wall_clock64() : 0ull;
#define PG8_STAMP() do { if (STAMP && wid == 0 && nts < 64) { const unsigned long long _c = (unsigned long long)clock64(); \
        ts_lo = (lane == nts) ? (int)(unsigned)_c : ts_lo; ts_hi = (lane == nts) ? (int)(unsigned)(_c >> 32) : ts_hi; ++nts; } } while (0)
    PG8_STAMP();
    unsigned voffA[2], voffB[2];
#pragma unroll
    for (int i = 0; i < 2; ++i) { int R, C; stage_rc(tid * 16 + i * 8192, R, C); const int Rb = Epi::PERM ? ((R & ~31) + perm32(R & 31)) : R;
        voffA[i] = (unsigned)(R * K + C) * 2u; voffB[i] = (unsigned)(Rb * K + C) * 2u; }
    const size_t kstep = (size_t)(BK * 2);
    const size_t hstep = (size_t)HALF * K * 2;
    const size_t tstep = 2 * hstep;
    const unsigned ldsw = (unsigned)wid * 1024u;
    const int aoff = lds_byte(wr * 64 + fr, fq * 8), boff = lds_byte(wc * 32 + fr, fq * 8);
#define PG8_SA(b, h) (((b) * 2 + (h)) * HTB)
#define PG8_SB(b, h) ((4 + (b) * 2 + (h)) * HTB)
#define PG8_STAGE(bufoff, gbase, voff) do { _Pragma("unroll") for (int _i = 0; _i < 2; ++_i) \
        __builtin_amdgcn_global_load_lds((const unsigned*)((const char*)(gbase) + (voff)[_i]), (PG8_LAS unsigned*)(lds + (bufoff) + ldsw + _i * 8192), 16, 0, 0); } while (0)
#define PG8_LDA(dst, b, h) do { _Pragma("unroll") for (int m = 0; m < 4; ++m) _Pragma("unroll") for (int k = 0; k < 2; ++k) dst[m][k] = *(const PG8_LAS bf16x8*)(lds + PG8_SA(b, h) + aoff + m * 2048 + k * 1024); } while (0)
#define PG8_LDB(dst, b, h) do { _Pragma("unroll") for (int n = 0; n < 2; ++n) _Pragma("unroll") for (int k = 0; k < 2; ++k) dst[n][k] = *(const PG8_LAS bf16x8*)(lds + PG8_SB(b, h) + boff + n * 2048 + k * 1024); } while (0)
#define PG8_MMA(ai, bj, At, Bt) do { __builtin_amdgcn_s_setprio(1); _Pragma("unroll") for (int m = 0; m < 4; ++m) _Pragma("unroll") for (int n = 0; n < 2; ++n) _Pragma("unroll") for (int k = 0; k < 2; ++k) \
        acc[ai][bj][m][n] = __builtin_amdgcn_mfma_f32_16x16x32_bf16(Bt[n][k], At[m][k], acc[ai][bj][m][n], 0, 0, 0); __builtin_amdgcn_s_setprio(0); } while (0)
#define PG8_WAIT_V(n) asm volatile("s_waitcnt vmcnt(" #n ")" ::: "memory")
#define PG8_WAIT_L(n) asm volatile("s_waitcnt lgkmcnt(" #n ")" ::: "memory")
#define PG8_BAR __builtin_amdgcn_s_barrier()
#define PG8_SCHED __builtin_amdgcn_sched_barrier(0)
    Unit cur, nxt; int ui = 0;
    if (!S.next(0, cur)) return;
    f32x4 acc[2][2][4][2];
#pragma unroll
    for (int a = 0; a < 2; ++a)
#pragma unroll
        for (int b = 0; b < 2; ++b)
#pragma unroll
            for (int m = 0; m < 4; ++m)
#pragma unroll
                for (int n = 0; n < 2; ++n) acc[a][b][m][n] = (f32x4){0.f, 0.f, 0.f, 0.f};
    bf16x8 At[4][2], B0[2][2], B1[2][2];
    const char* cA = (const char*)(cur.sel ? g.A2 : g.A) + (size_t)cur.pm * tstep + (size_t)cur.k0 * 2; const char* cB = (const char*)(cur.sel ? g.Bt2 : g.Bt) + (size_t)cur.pn * tstep + (size_t)cur.k0 * 2;
    S.a_ready(cur);
    PG8_STAGE(PG8_SB(0, 0), cB, voffB); PG8_STAGE(PG8_SA(0, 0), cA, voffA); PG8_STAGE(PG8_SB(0, 1), cB + hstep, voffB); PG8_STAGE(PG8_SA(0, 1), cA + hstep, voffA);
    if (wr == 1) PG8_BAR;
    PG8_WAIT_V(4); PG8_BAR;
    PG8_STAGE(PG8_SB(1, 0), cB + kstep, voffB); PG8_STAGE(PG8_SA(1, 0), cA + kstep, voffA); PG8_STAGE(PG8_SB(1, 1), cB + hstep + kstep, voffB);
    PG8_WAIT_V(6); PG8_BAR;
    PG8_STAMP();
    for (;;) {
        const bool has_next = S.next(ui + 1, nxt);
        const char* nA = has_next ? (const char*)(nxt.sel ? g.A2 : g.A) + (size_t)nxt.pm * tstep + (size_t)nxt.k0 * 2 : cA; const char* nB = has_next ? (const char*)(nxt.sel ? g.Bt2 : g.Bt) + (size_t)nxt.pn * tstep + (size_t)nxt.k0 * 2 : cB;
        const int nt = cur.nt;
        for (int t = 0; t < nt; t += 2) {
            const bool last = (t == nt - 2);
            const char* a1 = cA + (size_t)(t + 1) * kstep;
            const char* a2 = last ? nA : cA + (size_t)(t + 2) * kstep; const char* b2 = last ? nB : cB + (size_t)(t + 2) * kstep;
            const char* a3 = a2 + kstep; const char* b3 = b2 + kstep;
            if (last && has_next) S.a_ready(nxt);
            PG8_LDB(B0, 0, 0); PG8_SCHED; PG8_LDA(At, 0, 0); PG8_STAGE(PG8_SA(1, 1), a1 + hstep, voffA);
            PG8_WAIT_L(8); PG8_BAR; PG8_WAIT_L(0); PG8_MMA(0, 0, At, B0); PG8_BAR; PG8_SCHED;
            PG8_LDB(B1, 0, 1); PG8_STAGE(PG8_SB(0, 0), b2, voffB);
            PG8_BAR; PG8_WAIT_L(0); PG8_MMA(0, 1, At, B1); PG8_BAR;
            PG8_LDA(At, 0, 1); PG8_STAGE(PG8_SA(0, 0), a2, voffA);
            PG8_BAR; PG8_WAIT_L(0); PG8_MMA(1, 0, At, B0); PG8_BAR; PG8_SCHED;
            PG8_STAGE(PG8_SB(0, 1), b2 + hstep, voffB);
            PG8_WAIT_V(6); PG8_BAR; PG8_MMA(1, 1, At, B1); PG8_BAR;
            PG8_LDB(B0, 1, 0); PG8_SCHED; PG8_LDA(At, 1, 0); PG8_STAGE(PG8_SA(0, 1), a2 + hstep, voffA);
            PG8_WAIT_L(8); PG8_BAR; PG8_WAIT_L(0); PG8_MMA(0, 0, At, B0); PG8_BAR; PG8_SCHED;
            PG8_LDB(B1, 1, 1); PG8_STAGE(PG8_SB(1, 0), b3, voffB);
            PG8_BAR; PG8_WAIT_L(0); PG8_MMA(0, 1, At, B1); PG8_BAR;
            PG8_LDA(At, 1, 1); PG8_STAGE(PG8_SA(1, 0), a3, voffA);
            PG8_BAR; PG8_WAIT_L(0); PG8_MMA(1, 0, At, B0); PG8_BAR; PG8_SCHED;
            PG8_STAGE(PG8_SB(1, 1), b3 + hstep, voffB);
            PG8_WAIT_V(6); PG8_BAR; PG8_MMA(1, 1, At, B1); PG8_BAR;
        }
        PG8_STAMP();
        if constexpr (!Epi::AFTER_DRAIN) { E(acc, cur, wr, wc, fr, fq); S.done(cur); }
        PG8_STAMP();
        if (!has_next) break;
#pragma unroll
        for (int a = 0; a < 2; ++a)
#pragma unroll
            for (int b = 0; b < 2; ++b)
#pragma unroll
                for (int m = 0; m < 4; ++m)
#pragma unroll
                    for (int n = 0; n < 2; ++n) acc[a][b][m][n] = (f32x4){0.f, 0.f, 0.f, 0.f};
        cur = nxt; cA = nA; cB = nB; ++ui;
    }
    PG8_WAIT_V(0);
    if (wr == 0) PG8_BAR;
    PG8_BAR;
    if constexpr (Epi::AFTER_DRAIN) { E.fused(acc, cur, wr, wc, fr, fq, lds, wid, lane); S.done(cur); }
    PG8_STAMP();
    if (STAMP && wid == 0) { stamps[lane] = lane < nts ? (((unsigned long long)(unsigned)ts_hi << 32) | (unsigned)ts_lo) : 0ull;
        if (lane == 62) stamps[62] = rt_entry; if (lane == 63) stamps[63] = (unsigned long long)wall_clock64(); }
#undef PG8_STAMP
#undef PG8_SA
#undef PG8_SB
#undef PG8_STAGE
#undef PG8_LDA
#undef PG8_LDB
#undef PG8_MMA
#undef PG8_WAIT_V
#undef PG8_WAIT_L
#undef PG8_BAR
#undef PG8_SCHED
}
}

#define XB_TMO      128
#define XB_XCNT(j)  (256  + 64 * (j))
#define XB_XSUB(j)  (1280 + 64 * (j))
#define XB_XGEN(j)  (2304 + 64 * (j))
#define XB_TOP      3328
#define XB_TOPGEN   3392
#define XCD_BAR_WORDS 3456
#define XB_SPIN_CAP (1u << 22)
#define LAS __attribute__((address_space(3)))

__device__ __forceinline__ unsigned xb_ld(unsigned* p)              { return __hip_atomic_load(p, __ATOMIC_RELAXED, __HIP_MEMORY_SCOPE_AGENT); }
__device__ __forceinline__ unsigned xb_add(unsigned* p, unsigned v) { return __hip_atomic_fetch_add(p, v, __ATOMIC_RELAXED, __HIP_MEMORY_SCOPE_AGENT); }
__device__ __forceinline__ unsigned xb_xcc_id() { return (unsigned)__builtin_amdgcn_s_getreg((3 << 11) | 20) & 0xFu; }
#define XB_SPIN(cond, bar) do { unsigned _sp = 0; while (cond) { __builtin_amdgcn_s_sleep(1); \
    if ((++_sp & 255u) == 0u) { if (xb_ld(&(bar)[XB_TMO])) break; if (_sp > XB_SPIN_CAP) { atomicAdd(&(bar)[XB_TMO], 1u); break; } } } } while (0)

#define xb_thread0() (xb_wave_s == 0 && __builtin_amdgcn_mbcnt_hi(~0u, __builtin_amdgcn_mbcnt_lo(~0u, 0u)) == 0u)
struct XcdBarrier {
    unsigned* bar; unsigned x;
    volatile LAS unsigned* st;
};

__device__ __forceinline__ XcdBarrier xcd_barrier_post(unsigned* bar, volatile LAS unsigned* st, int xb_wave_s) {
    XcdBarrier b; b.bar = bar; b.x = xb_xcc_id(); b.st = st;
    if (xb_thread0()) (void)xb_add(&bar[XB_XCNT(b.x)], 1u);
    return b;
}
__device__ __forceinline__ void xcd_barrier_complete(unsigned* bar, unsigned x, unsigned& nloc, unsigned& nx) {
    const unsigned G = gridDim.x * gridDim.y * gridDim.z;
    unsigned sum, cnt, mine, sp = 0u;
    for (;;) {
        sum = 0u; cnt = 0u; mine = 0u;
#pragma unroll
        for (unsigned j = 0; j < 16; ++j) { const unsigned c = xb_ld(&bar[XB_XCNT(j)]); sum += c; cnt += (c > 0u) ? 1u : 0u; mine = (j == x) ? c : mine; }
        if (sum == G) break;
        __builtin_amdgcn_s_sleep(1);
        if ((++sp & 255u) == 0u) { if (xb_ld(&bar[XB_TMO])) break; if (sp > XB_SPIN_CAP) { atomicAdd(&bar[XB_TMO], 1u); break; } }
    }
    nloc = mine > 0u ? mine : 1u; nx = cnt > 0u ? cnt : 1u;
}

__device__ __forceinline__ void xcd_barrier(const XcdBarrier& b, int xb_wave_s) {
    asm volatile("s_waitcnt vmcnt(0)" ::: "memory");
    __syncthreads();
    if (xb_thread0()) {
        unsigned* bar = b.bar;
        __builtin_amdgcn_s_waitcnt(0);
        unsigned nloc = b.st[0], nx = b.st[1];
        if (nloc == 0u) { xcd_barrier_complete(bar, b.x, nloc, nx); b.st[0] = nloc; b.st[1] = nx; }
        const unsigned old = xb_add(&bar[XB_XSUB(b.x)], 1u);
        const unsigned gen = old / nloc;
        if (old + 1u == (gen + 1u) * nloc) {
            __builtin_amdgcn_fence(__ATOMIC_RELEASE, "agent");
            asm volatile("s_waitcnt vmcnt(0)" ::: "memory");
            const unsigned og = xb_add(&bar[XB_TOP], 1u);
            const unsigned tg = og / nx;
            if (og + 1u == (tg + 1u) * nx) xb_add(&bar[XB_TOPGEN], 1u);
            else XB_SPIN(xb_ld(&bar[XB_TOPGEN]) == tg, bar);
            __builtin_amdgcn_fence(__ATOMIC_ACQUIRE, "agent");
            xb_add(&bar[XB_XGEN(b.x)], 1u);
            asm volatile("s_waitcnt vmcnt(0)" ::: "memory");
        } else {
            XB_SPIN(xb_ld(&bar[XB_XGEN(b.x)]) == gen, bar);
            __builtin_amdgcn_fence(__ATOMIC_ACQUIRE, "agent");
            asm volatile("s_waitcnt vmcnt(0)" ::: "memory");
        }
    }
    __syncthreads();
}

typedef unsigned short bf16;
typedef float f32x4 __attribute__((ext_vector_type(4)));
typedef float f32x2 __attribute__((ext_vector_type(2)));
constexpr int D = 2048, TP = 4096, MP = 8192, BS = 32, TS = 8, MS = 256, MT = 8448;
constexpr int PAST = 8192, NPAGE = 64, PAGE = 128, NMOD = 12288, DFF = 8192;
constexpr int NPROJ = 11008;
constexpr int C_QA = 0, C_ZA = 1024, C_IA = 2048, C_GA = 3072, C_QB = 4096, C_KC = 5120, C_VC = 5376, C_KS = 5632, C_VS = 5888, C_KW = 6144, C_VW = 6400, C_MGA = 6656, C_MGB = 8704, C_GATE = 10752;
constexpr int IN_COLS = 10776;
constexpr int LQ = 1024 + 64, LMG = 2048 + 64;
constexpr size_t O_YP = 0, O_YS = 16777216, O_CMPP = 17301504, O_CMPS = 21495808, O_SELP = 21626880, O_SELS = 25821184, O_WINP = 25952256, O_WINS = 26476544, O_HGP = 34865152, O_HGS = 35127296, O_END = 39321600;
constexpr float EPS = 1e-6f;
typedef short bf16x8 __attribute__((ext_vector_type(8)));
typedef float f32x16 __attribute__((ext_vector_type(16)));
typedef float f32x2_t __attribute__((ext_vector_type(2))); typedef __bf16 bf16x2_t __attribute__((ext_vector_type(2)));
typedef unsigned u32x4 __attribute__((ext_vector_type(4)));
constexpr float LOG2E = 1.4426950408889634f;
__device__ __forceinline__ unsigned cvtpk(float lo, float hi) { f32x2_t v = {lo, hi}; bf16x2_t b = __builtin_convertvector(v, bf16x2_t); return __builtin_bit_cast(unsigned, b); }

__device__ __forceinline__ bf16 f2bf(float f) { unsigned u = __float_as_uint(f); u += 0x7FFFu + ((u >> 16) & 1u); return (bf16)(u >> 16); }
__device__ __forceinline__ float bf2f(bf16 b) { return __uint_as_float(((unsigned)b) << 16); }
__device__ __forceinline__ float sigmoidf_(float x) { return __builtin_amdgcn_rcpf(1.0f + __builtin_amdgcn_exp2f(-1.4426950408889634f * x)); }
__device__ __forceinline__ float siluf_(float x) { return x * sigmoidf_(x); }
__device__ __forceinline__ int modrow(int r) { return r < MP ? (r >> 12) : 2 + ((r - MP) >> 3); }
__device__ __forceinline__ int win_col(int n) {
    if (n < C_MGA) return n;
    if (n < C_MGB) return 6680 + (n - C_MGA);
    if (n < C_GATE) return 8728 + (n - C_MGB);
    if (n < C_GATE + 24) return 6656 + (n - C_GATE);
    return -1;
}
__device__ __forceinline__ int rel_bucket(int rel) {
    const int n = rel > 0 ? rel : 0;
    if (n < 16) return n;
    const float nf = (float)n;
    const int large = 16 + (int)(logf(nf / 16.0f) / 2.0794415416798357f * 16.0f);
    return large < 31 ? large : 31;
}
__device__ __forceinline__ float wave_sum(float v) {
#pragma unroll
    for (int o = 32; o >= 1; o >>= 1) v += __shfl_xor(v, o);
    return v;
}
__device__ __forceinline__ float wave_max(float v) {
#pragma unroll
    for (int o = 32; o >= 1; o >>= 1) v = fmaxf(v, __shfl_xor(v, o));
    return v;
}

__device__ __forceinline__ void b_transpose128(const float* __restrict__ W, int ldw, int c0, int lim, bf16* __restrict__ Wt, int K, int n0, int k0, int tid, float* tile) {
#pragma unroll
    for (int p = 0; p < 8; ++p) { const int k = p * 16 + (tid >> 5), n4 = (tid & 31) * 4; f32x4 v = {0.f, 0.f, 0.f, 0.f};
        if (n4 < lim) v = *(const f32x4*)(W + (size_t)(k0 + k) * ldw + c0 + n4);
        float* t = tile + k * 129 + n4; t[0] = v[0]; t[1] = v[1]; t[2] = v[2]; t[3] = v[3]; }
    __syncthreads();
#pragma unroll
    for (int p = 0; p < 4; ++p) { const int n = p * 32 + (tid >> 4), kg = tid & 15; const float* t = tile + (8 * kg) * 129 + n;
        u32x4 w; w.x = cvtpk(t[0], t[129]); w.y = cvtpk(t[2 * 129], t[3 * 129]); w.z = cvtpk(t[4 * 129], t[5 * 129]); w.w = cvtpk(t[6 * 129], t[7 * 129]);
        *(u32x4*)(Wt + (size_t)(n0 + n) * K + k0 + 8 * kg) = w; }
    __syncthreads();
}
__device__ __forceinline__ void b_mods_part(const float* __restrict__ cp, const float* __restrict__ cs, const float* __restrict__ ada_w, float* __restrict__ MODP, int cg, int kc, int tid, float* tbl) {
    float* accl = tbl + 34 * 256;
    for (int u = tid; u < 34 * 256; u += 512) { const int r = u >> 8, k = 256 * kc + (u & 255); const float* c = r < 2 ? cp + r * D : cs + (r - 2) * D; tbl[u] = siluf_(c[k]); }
    __syncthreads();
    const int col = cg * 512 + tid;
#pragma unroll 1
    for (int k0 = 0; k0 < 256; k0 += 64) {
        float w[64];
        const float* wp = ada_w + (size_t)(256 * kc + k0) * NMOD + col;
#pragma unroll
        for (int j = 0; j < 64; ++j) w[j] = wp[(size_t)j * NMOD];
#pragma unroll 1
        for (int r = 0; r < 34; ++r) {
            float a0 = (k0 == 0) ? 0.f : accl[r * 512 + tid], a1 = 0.f;
#pragma unroll
            for (int j = 0; j < 64; j += 8) { const f32x4 s4 = *(const f32x4*)(tbl + r * 256 + k0 + j), t4 = *(const f32x4*)(tbl + r * 256 + k0 + j + 4);
                a0 += (s4[0] * w[j] + s4[1] * w[j + 1]) + (s4[2] * w[j + 2] + s4[3] * w[j + 3]); a1 += (t4[0] * w[j + 4] + t4[1] * w[j + 5]) + (t4[2] * w[j + 6] + t4[3] * w[j + 7]); }
            accl[r * 512 + tid] = a0 + a1;
        }
    }
    for (int r = 0; r < 34; ++r) MODP[((size_t)kc * 34 + r) * NMOD + col] = accl[r * 512 + tid];
    __syncthreads();
}
__device__ __forceinline__ void b_hnorm(const float* __restrict__ xa, const float* __restrict__ xb, const float* __restrict__ gain, const float* __restrict__ mods, int sh_idx, int sc_idx, bf16* __restrict__ out, int row, int lt, float* red) {
    const float* x = row < MP ? xa + (size_t)row * D : xb + (size_t)(row - MP) * D;
    float v[8]; float ss = 0.f;
#pragma unroll
    for (int j = 0; j < 8; ++j) { v[j] = x[lt * 8 + j]; ss += v[j] * v[j]; }
    ss = wave_sum(ss); if ((lt & 63) == 0) red[lt >> 6] = ss; __syncthreads();
    ss = red[0] + red[1] + red[2] + red[3];
    const float r = rsqrtf(ss * (1.0f / D) + EPS);
    const float* m = mods + (size_t)modrow(row) * NMOD;
#pragma unroll
    for (int j = 0; j < 8; ++j) { const int c = lt * 8 + j; out[(size_t)row * D + c] = f2bf(v[j] * r * gain[c] * (1.0f + m[sc_idx * D + c]) + m[sh_idx * D + c]); }
    __syncthreads();
}
__device__ __forceinline__ void b_norm2_sample(const float* __restrict__ xs, const float* __restrict__ slab, const float* __restrict__ gain, const float* __restrict__ mods, float* __restrict__ X1, bf16* __restrict__ out, int row, int lt, float* red) {
    const int r = row - MP; const float* m = mods + (size_t)modrow(row) * NMOD;
    float v[8]; float ss = 0.f;
#pragma unroll
    for (int j = 0; j < 8; ++j) { const int c = lt * 8 + j; float s = 0.f;
#pragma unroll
        for (int ks = 0; ks < 8; ++ks) s += slab[((size_t)ks * 256 + r) * 2048 + c];
        v[j] = xs[(size_t)r * D + c] + m[2 * D + c] * s; X1[(size_t)row * D + c] = v[j]; ss += v[j] * v[j]; }
    ss = wave_sum(ss); if ((lt & 63) == 0) red[lt >> 6] = ss; __syncthreads();
    ss = red[0] + red[1] + red[2] + red[3];
    const float rn = rsqrtf(ss * (1.0f / D) + EPS);
#pragma unroll
    for (int j = 0; j < 8; ++j) { const int c = lt * 8 + j; out[(size_t)row * D + c] = f2bf(v[j] * rn * gain[c] * (1.0f + m[4 * D + c]) + m[3 * D + c]); }
    __syncthreads();
}
__device__ __forceinline__ void b_hgrn_seq(const bf16* __restrict__ QAb, const bf16* __restrict__ IAb, const float* __restrict__ F, const float* __restrict__ state, float* __restrict__ oraw, float* __restrict__ out, int x, int v) {
    const bool pr = x < 16;
    const int b = pr ? (x >> 3) : ((x - 16) >> 3), h = x & 7;
    const int T = pr ? TP : TS; const size_t row0 = pr ? (size_t)b * TP : (size_t)MP + b * TS;
    float S[128];
#pragma unroll
    for (int k = 0; k < 128; ++k) S[k] = pr ? 0.f : state[(((size_t)b * 8 + h) * 128 + k) * 128 + v];
    for (int t = 0; t < T; ++t) {
        const bf16* qp = QAb + (row0 + t) * LQ + h * 128; const float* f = F + (row0 + t) * LQ + h * 128;
        const float vi = bf2f(IAb[(row0 + t) * LQ + h * 128 + v]); float o = 0.f;
#pragma unroll
        for (int k = 0; k < 128; ++k) { const float fk = f[k]; S[k] = fk * S[k] + (1.0f - fk) * vi; o += S[k] * bf2f(qp[k]); }
        oraw[(row0 + t) * 1024 + h * 128 + v] = o;
    }
    float* so = out + (pr ? O_HGP : O_HGS) + ((size_t)b * 8 + h) * 16384;
#pragma unroll
    for (int k = 0; k < 128; ++k) so[k * 128 + v] = S[k];
}
__device__ __forceinline__ void b_hgrn_out(const float* __restrict__ oraw, const bf16* __restrict__ GAs, const float* __restrict__ onorm, bf16* __restrict__ OA, int row, int tid) {
    float o[4]; float ss = 0.f;
#pragma unroll
    for (int j = 0; j < 4; ++j) { o[j] = oraw[(size_t)row * 1024 + tid * 4 + j]; ss += o[j] * o[j]; }
#pragma unroll
    for (int s = 16; s >= 1; s >>= 1) ss += __shfl_xor(ss, s);
    const float r = rsqrtf(ss * (1.0f / 128) + EPS);
#pragma unroll
    for (int j = 0; j < 4; ++j) { const int c = tid * 4 + j; OA[(size_t)row * 1024 + c] = f2bf(o[j] * r * onorm[c] * bf2f(GAs[(size_t)row * LQ + c])); }
}

template <class F> struct EpiGen {
    static constexpr bool PERM = false, AFTER_DRAIN = false;
    F f; float* slab; int slab_n, kslice;
    __device__ __forceinline__ void operator()(const pg8::f32x4 (&acc)[2][2][4][2], const pg8::Unit& u, int wr, int wc, int fr0, int fq0) const {
        int fr = fr0, fq = fq0; asm volatile("" : "+v"(fr), "+v"(fq));
        const int row0 = u.pm * 256 + wr * 64 + fr, col0 = u.pn * 256 + wc * 32 + 4 * fq;
        if (slab != nullptr && u.pm == 32) {
            float* sp = slab + ((size_t)(u.k0 / kslice) * 256 + (row0 - MP)) * slab_n + col0;
#pragma unroll
            for (int ai = 0; ai < 2; ++ai)
#pragma unroll
                for (int m = 0; m < 4; ++m)
#pragma unroll
                    for (int bj = 0; bj < 2; ++bj)
#pragma unroll
                        for (int n = 0; n < 2; ++n) *(f32x4*)(sp + (size_t)(ai * 128 + m * 16) * slab_n + bj * 128 + n * 16) = acc[ai][bj][m][n];
            return;
        }
#pragma unroll
        for (int ai = 0; ai < 2; ++ai)
#pragma unroll
            for (int m = 0; m < 4; ++m)
#pragma unroll
                for (int bj = 0; bj < 2; ++bj)
#pragma unroll
                    for (int n = 0; n < 2; ++n) f(row0 + ai * 128 + m * 16, col0 + bj * 128 + n * 16, acc[ai][bj][m][n]);
    }
};
struct MixOrder {
    pg8::StaticOrder P; int nN, nsl, ntS, kslice;
    __device__ __forceinline__ void init(int N, int K, int nsl_, int G, int c) { P.init(MP, N, G, c, K); nN = N / 256; nsl = nsl_; kslice = K / nsl_; ntS = kslice / 64; }
    __device__ __forceinline__ bool next(int i, pg8::Unit& u) const {
        const int L = i * P.G + P.c; if (L < P.nwg) return P.next(i, u);
        const int idx = L - P.nwg; if (idx >= nN * nsl) return false;
        u.pm = 32; u.pn = idx % nN; u.k0 = (idx / nN) * kslice; u.nt = ntS; u.sel = 0; return true; }
    __device__ __forceinline__ void a_ready(const pg8::Unit&) const {}
    __device__ __forceinline__ void done(const pg8::Unit&) const {}
};
template <class Base> struct RangeOrder {
    Base B; int i0, i1;
    __device__ __forceinline__ bool next(int i, pg8::Unit& u) const { return (i0 + i < i1) ? B.next(i0 + i, u) : false; }
    __device__ __forceinline__ void a_ready(const pg8::Unit&) const {}
    __device__ __forceinline__ void done(const pg8::Unit&) const {}
};
struct PairOrder {
    pg8::StaticOrder P; int nN, nsl, ntS, kslice;
    __device__ __forceinline__ void init(int N, int K, int nsl_, int G, int c) { P.init(MP, N, G, c, K); nN = N / 256; nsl = nsl_; kslice = K / nsl_; ntS = kslice / 64; }
    __device__ __forceinline__ bool next(int i, pg8::Unit& u) const {
        if (i < 2) { const bool ok = P.next(0, u); u.sel = i; return ok; }
        const int idx = (i - 2) * P.G + P.c; if (idx >= 2 * nN * nsl) return false;
        const int half = nN * nsl, w = idx >= half ? 1 : 0, id2 = idx - w * half;
        u.pm = 32; u.pn = id2 % nN; u.k0 = (id2 / nN) * kslice; u.nt = ntS; u.sel = w; return true; }
    __device__ __forceinline__ void a_ready(const pg8::Unit&) const {}
    __device__ __forceinline__ void done(const pg8::Unit&) const {}
};
struct EpiBranch {
    static constexpr bool PERM = false, AFTER_DRAIN = false;
    const bf16* mga; const bf16* mgb; float* T; bf16* merged; float* slab; int kslice, pad;
    __device__ __forceinline__ void operator()(const pg8::f32x4 (&acc)[2][2][4][2], const pg8::Unit& u, int wr, int wc, int fr0, int fq0) const {
        int fr = fr0, fq = fq0; asm volatile("" : "+v"(fr), "+v"(fq));
        const int row0 = u.pm * 256 + wr * 64 + fr, col0 = u.pn * 256 + wc * 32 + 4 * fq;
#define EB_LOOP(...) _Pragma("unroll") for (int ai = 0; ai < 2; ++ai) _Pragma("unroll") for (int m = 0; m < 4; ++m) _Pragma("unroll") for (int bj = 0; bj < 2; ++bj) _Pragma("unroll") for (int n = 0; n < 2; ++n) { \
            const int r = row0 + ai * 128 + m * 16, c = col0 + bj * 128 + n * 16; const f32x4 v = acc[ai][bj][m][n]; __VA_ARGS__ }
        if (u.pm == 32) { float* sp = slab + ((size_t)u.sel * 4 * 256 + (size_t)(u.k0 / kslice) * 256) * D; EB_LOOP( *(f32x4*)(sp + (size_t)(r - MP) * D + c) = v; ) }
        else if (u.sel == 0) { EB_LOOP( const ushort4 g = *(const ushort4*)(mga + (size_t)r * LMG + c); f32x4 o; o[0] = bf2f(g.x) * v[0]; o[1] = bf2f(g.y) * v[1]; o[2] = bf2f(g.z) * v[2]; o[3] = bf2f(g.w) * v[3]; *(f32x4*)(T + (size_t)r * D + c) = o; ) }
        else { EB_LOOP( const ushort4 g = *(const ushort4*)(mgb + (size_t)r * LMG + c); const f32x4 t = *(const f32x4*)(T + (size_t)r * D + c); ushort4 o;
                        o.x = f2bf(t[0] + bf2f(g.x) * v[0]); o.y = f2bf(t[1] + bf2f(g.y) * v[1]); o.z = f2bf(t[2] + bf2f(g.z) * v[2]); o.w = f2bf(t[3] + bf2f(g.w) * v[3]); *(ushort4*)(merged + (size_t)r * D + c) = o; ) }
#undef EB_LOOP
    }
};
struct FStoreF32 { float* C; int ldc; int pad;
    __device__ __forceinline__ void operator()(int r, int c, f32x4 v) const { *(f32x4*)(C + (size_t)r * ldc + c) = v; } };
struct FGateA { const bf16* mga; float* T;
    __device__ __forceinline__ void operator()(int r, int c, f32x4 v) const { const ushort4 g = *(const ushort4*)(mga + (size_t)r * LMG + c); f32x4 o;
        o[0] = bf2f(g.x) * v[0]; o[1] = bf2f(g.y) * v[1]; o[2] = bf2f(g.z) * v[2]; o[3] = bf2f(g.w) * v[3];
        *(f32x4*)(T + (size_t)r * D + c) = o; } };
struct FGateB { const bf16* mgb; const float* T; bf16* merged;
    __device__ __forceinline__ void operator()(int r, int c, f32x4 v) const { const ushort4 g = *(const ushort4*)(mgb + (size_t)r * LMG + c); const f32x4 t = *(const f32x4*)(T + (size_t)r * D + c); ushort4 o;
        o.x = f2bf(t[0] + bf2f(g.x) * v[0]); o.y = f2bf(t[1] + bf2f(g.y) * v[1]); o.z = f2bf(t[2] + bf2f(g.z) * v[2]); o.w = f2bf(t[3] + bf2f(g.w) * v[3]);
        *(ushort4*)(merged + (size_t)r * D + c) = o; } };
struct FRes1 { const float* xp; const float* xs; const float* mods; float* X1;
    __device__ __forceinline__ void operator()(int r, int c, f32x4 v) const { const float* x = r < MP ? xp + (size_t)r * D : xs + (size_t)(r - MP) * D; const f32x4 xv = *(const f32x4*)(x + c);
        const f32x4 g = *(const f32x4*)(mods + (size_t)modrow(r) * NMOD + 2 * D + c); *(f32x4*)(X1 + (size_t)r * D + c) = xv + g * v; } };
struct FRelu2 { bf16* U;
    __device__ __forceinline__ void operator()(int r, int c, f32x4 v) const { ushort4 o; float a;
        a = fmaxf(v[0], 0.f); o.x = f2bf(a * a); a = fmaxf(v[1], 0.f); o.y = f2bf(a * a); a = fmaxf(v[2], 0.f); o.z = f2bf(a * a); a = fmaxf(v[3], 0.f); o.w = f2bf(a * a);
        *(ushort4*)(U + (size_t)r * DFF + c) = o; } };
struct FRes2 { const float* X1; const float* mods; float* out;
    __device__ __forceinline__ void operator()(int r, int c, f32x4 v) const { const f32x4 xv = *(const f32x4*)(X1 + (size_t)r * D + c);
        const f32x4 g = *(const f32x4*)(mods + (size_t)modrow(r) * NMOD + 5 * D + c); *(f32x4*)(out + (size_t)r * D + c) = xv + g * v; } };

struct InProjOut { bf16* QAb; float* F; bf16* IAb; bf16* GAs; float* QBr; float* out; bf16* XHP; float* WINKV; bf16* MGAb; bf16* MGBb; float* GATES; const float* lbl; };
__device__ __forceinline__ void st_bf16x4(bf16* p, f32x4 v) { typedef unsigned u32x2v __attribute__((ext_vector_type(2))); u32x2v w; w.x = cvtpk(v[0], v[1]); w.y = cvtpk(v[2], v[3]); *(u32x2v*)p = w; }
struct EpiInProj {
    static constexpr bool PERM = false, AFTER_DRAIN = false;
    InProjOut o;
#define EPI_LOOP(...) _Pragma("unroll") for (int bj = 0; bj < 2; ++bj) _Pragma("unroll") for (int n = 0; n < 2; ++n) { const int c = ct0 + bj * 128 + n * 16; \
        _Pragma("unroll") for (int ai = 0; ai < 2; ++ai) _Pragma("unroll") for (int m = 0; m < 4; ++m) { const int row = row0 + ai * 128 + m * 16; const f32x4 v = acc[ai][bj][m][n]; __VA_ARGS__ } }
    __device__ __forceinline__ void operator()(const pg8::f32x4 (&acc)[2][2][4][2], const pg8::Unit& u, int wr, int wc, int fr0, int fq0) const {
        int fr = fr0, fq = fq0; asm volatile("" : "+v"(fr), "+v"(fq));
        const int row0 = u.pm * 256 + wr * 64 + fr, ct0 = wc * 32 + 4 * fq, pn = u.pn;
        if (pn < 4) { bf16* p = o.QAb + pn * 256; EPI_LOOP( st_bf16x4(p + (size_t)row * LQ + c, v); ) }
        else if (pn < 8) {
            float* p = o.F + (pn - 4) * 256;
#pragma unroll
            for (int bj = 0; bj < 2; ++bj)
#pragma unroll
                for (int n = 0; n < 2; ++n) { const int c = ct0 + bj * 128 + n * 16; const int cc = (pn - 4) * 256 + c; const f32x4 l0 = *(const f32x4*)(o.lbl + cc), l1 = *(const f32x4*)(o.lbl + 1024 + cc); f32x4 lb;
#pragma unroll
                    for (int j = 0; j < 4; ++j) lb[j] = sigmoidf_(l0[j] - l1[j]);
#pragma unroll
                    for (int ai = 0; ai < 2; ++ai)
#pragma unroll
                        for (int m = 0; m < 4; ++m) { const int row = row0 + ai * 128 + m * 16; const f32x4 v = acc[ai][bj][m][n]; f32x4 f;
#pragma unroll
                            for (int j = 0; j < 4; ++j) f[j] = lb[j] + (1.0f - lb[j]) * sigmoidf_(v[j]);
                            *(f32x4*)(p + (size_t)row * LQ + c) = f; } }
        }
        else if (pn < 12) { bf16* p = o.IAb + (pn - 8) * 256; EPI_LOOP( st_bf16x4(p + (size_t)row * LQ + c, v); ) }
        else if (pn < 16) { bf16* p = o.GAs + (pn - 12) * 256; EPI_LOOP( f32x4 s; s[0] = siluf_(v[0]); s[1] = siluf_(v[1]); s[2] = siluf_(v[2]); s[3] = siluf_(v[3]); st_bf16x4(p + (size_t)row * LQ + c, s); ) }
        else if (pn < 20) { float* p = o.QBr + (pn - 16) * 256; EPI_LOOP( *(f32x4*)(p + (size_t)row * LQ + c) = v; ) }
        else if (pn < 22) { const int w = pn & 1; const bool pr = u.pm < 32; float* p = o.out + (pr ? O_CMPP : O_CMPS) + w * 256 - (pr ? (size_t)0 : (size_t)MP * 512); bf16* xp = o.XHP + (size_t)w * 1280 * 2048;
            EPI_LOOP( *(f32x4*)(p + (size_t)row * 512 + c) = v;
                      { const int kv = c >> 7, d = c & 127; size_t r; int j; if (pr) { const int b = row >> 12, t = row & 4095; r = ((size_t)b * 256 + (t >> 4)) * 2 + kv; j = t & 15; } else { const int lrow = row - MP; r = 1024 + (size_t)(lrow >> 3) * 2 + kv; j = lrow & 7; }
                        st_bf16x4(xp + r * 2048 + j * 128 + d, v); } ) }
        else if (pn < 24) { const int w = pn & 1; const bool pr = u.pm < 32; float* p = o.out + (pr ? O_SELP : O_SELS) + w * 256 - (pr ? (size_t)0 : (size_t)MP * 512); EPI_LOOP( *(f32x4*)(p + (size_t)row * 512 + c) = v; ) }
        else if (pn < 26) { float* p = o.WINKV + (pn & 1) * 256; EPI_LOOP( *(f32x4*)(p + (size_t)row * 512 + c) = v; ) }
        else if (pn < 42) { bf16* p = (pn < 34) ? o.MGAb + (pn - 26) * 256 : o.MGBb + (pn - 34) * 256;
            EPI_LOOP( f32x4 s; s[0] = sigmoidf_(v[0]); s[1] = sigmoidf_(v[1]); s[2] = sigmoidf_(v[2]); s[3] = sigmoidf_(v[3]); st_bf16x4(p + (size_t)row * LMG + c, s); ) }
        else { EPI_LOOP( if (c < 24) { f32x4 s; s[0] = sigmoidf_(v[0]); s[1] = sigmoidf_(v[1]); s[2] = sigmoidf_(v[2]); s[3] = sigmoidf_(v[3]); *(f32x4*)(o.GATES + (size_t)row * 24 + c) = s; } ) }
    }
#undef EPI_LOOP
};

constexpr int NTHR = 512;
constexpr int LDS_STAGE = 131072;
constexpr int LDS_CTL = LDS_STAGE;
constexpr int LDS_BYTES = 163840;
enum { PH_PRO = 0, PH_MRED, PH_NORM1, PH_INPROJ, PH_MIX1, PH_CFIN, PH_ATTN, PH_SATTN, PH_SCOMB, PH_BR, PH_RMERGE, PH_OUT, PH_NORM2, PH_MLP1, PH_RU, PH_MLP2, PH_RY, N_PHASES };


__device__ __forceinline__ int crow(int r, int hi) { return (r & 3) + 8 * (r >> 2) + 4 * hi; }
constexpr int AL_BIAS = LDS_CTL + 64;
constexpr int AL_LX = AL_BIAS + 4 * 132 * 4;
constexpr int AL_FX = AL_LX + 8 * 32 * 4;
constexpr int AL_SEL = AL_FX + 8 * 32 * 4;
constexpr int AL_IMPA = AL_SEL + 32 * 2 * 4;
constexpr int AL_IMPB = AL_IMPA + 32 * 64 * 4;
constexpr int AL_SCT = AL_IMPB + 32 * 64 * 4;
constexpr int AL_END = AL_SCT + 32 * 64 * 4;
static_assert(AL_END <= LDS_BYTES, "attention LDS control region");

struct AttnP { const float* QBr; const float* qn_g; const bf16* KSf; const bf16* VSf; const bf16* KWf; const bf16* VWf; const bf16* KCf; const bf16* VCf; const float* gates; const float* relb; bf16* OB; float* OT; float* IMP; };

__device__ __forceinline__ void dma_copy(LAS unsigned char* dst, const bf16* src, int nchunks  , int wave, int lane) {
    for (int c = wave; c < nchunks; c += 8) __builtin_amdgcn_global_load_lds((const unsigned*)((const char*)src + c * 1024 + lane * 16), (LAS unsigned*)(dst + c * 1024), 16, 0, 0);
}
#define AT_WAITV0() asm volatile("s_waitcnt vmcnt(0)" ::: "memory")
#define AT_BAR() do { asm volatile("s_waitcnt vmcnt(0) lgkmcnt(0)" ::: "memory"); __builtin_amdgcn_s_barrier(); asm volatile("" ::: "memory"); } while (0)

__device__ __forceinline__ f32x16 at_qk(const LAS unsigned char* kb, const bf16x8 (&qf)[8], int lane) {
    f32x16 p = {0.f, 0.f, 0.f, 0.f, 0.f, 0.f, 0.f, 0.f, 0.f, 0.f, 0.f, 0.f, 0.f, 0.f, 0.f, 0.f};
#pragma unroll
    for (int s = 0; s < 8; ++s) { const bf16x8 kf = *(const LAS bf16x8*)(kb + s * 1024 + lane * 16); p = __builtin_amdgcn_mfma_f32_32x32x16_bf16(kf, qf[s], p, 0, 0, 0); if (s == 3) __builtin_amdgcn_sched_barrier(0); }
    return p;
}
__device__ __forceinline__ void at_pv(f32x16 (&o)[4], const f32x16& e, const LAS unsigned char* vb, int lane) {
#pragma unroll
    for (int ks = 0; ks < 2; ++ks) {
        u32x4 w; w.x = cvtpk(e[8 * ks + 0], e[8 * ks + 1]); w.y = cvtpk(e[8 * ks + 2], e[8 * ks + 3]); w.z = cvtpk(e[8 * ks + 4], e[8 * ks + 5]); w.w = cvtpk(e[8 * ks + 6], e[8 * ks + 7]);
        const bf16x8 pf = __builtin_bit_cast(bf16x8, w);
#pragma unroll
        for (int dt = 0; dt < 4; ++dt) { const bf16x8 vf = *(const LAS bf16x8*)(vb + (ks * 4 + dt) * 1024 + lane * 16); o[dt] = __builtin_amdgcn_mfma_f32_32x32x16_bf16(pf, vf, o[dt], 0, 0, 0); }
    }
}
template <int MODE> __device__ __forceinline__ float at_exp(f32x16& p, int tok, int key0  , int hi, const LAS float* bias_g, float b31, int maxrel, bool keep) {
    float sum = 0.f;
#pragma unroll
    for (int r = 0; r < 16; ++r) {
        float e;
        if (MODE == 0) e = __builtin_amdgcn_exp2f(p[r] + b31);
        else { const int rel = tok - (key0 + crow(r, hi)); const bool ok = rel >= 0 && rel < maxrel; const int ix = rel < 0 ? 0 : (rel > 128 ? 128 : rel); e = ok ? __builtin_amdgcn_exp2f(p[r] + bias_g[ix]) : 0.f; }
        e = keep ? e : 0.f; p[r] = e; sum += e;
    }
    return sum;
}

__device__ __forceinline__ void load_q_frags(bf16x8 (&qf)[8], const float* qrow, const float* qn_g, int hi) {
    f32x4 x[8], y[8]; float ss = 0.f;
#pragma unroll
    for (int s = 0; s < 8; ++s) { x[s] = *(const f32x4*)(qrow + 16 * s + 8 * hi); y[s] = *(const f32x4*)(qrow + 16 * s + 8 * hi + 4);
        ss += (x[s][0] * x[s][0] + x[s][1] * x[s][1]) + (x[s][2] * x[s][2] + x[s][3] * x[s][3]) + (y[s][0] * y[s][0] + y[s][1] * y[s][1]) + (y[s][2] * y[s][2] + y[s][3] * y[s][3]); }
    ss += __shfl_xor(ss, 32);
    const float r = rsqrtf(ss * (1.0f / 128) + EPS) * (0.08838834764831845f * LOG2E);
#pragma unroll
    for (int s = 0; s < 8; ++s) { const f32x4 g0 = *(const f32x4*)(qn_g + 16 * s + 8 * hi), g1 = *(const f32x4*)(qn_g + 16 * s + 8 * hi + 4);
        u32x4 w; w.x = cvtpk(x[s][0] * g0[0] * r, x[s][1] * g0[1] * r); w.y = cvtpk(x[s][2] * g0[2] * r, x[s][3] * g0[3] * r); w.z = cvtpk(y[s][0] * g1[0] * r, y[s][1] * g1[1] * r); w.w = cvtpk(y[s][2] * g1[2] * r, y[s][3] * g1[3] * r);
        qf[s] = __builtin_bit_cast(bf16x8, w); }
}
__device__ __forceinline__ void at_stage_tile(LAS unsigned char* slot, const bf16* Kf, const bf16* Vf, int j, int wave, int lane) {
#pragma unroll
    for (int c = 0; c < 2; ++c) { const int ch = wave + 8 * c;
        __builtin_amdgcn_global_load_lds((const unsigned*)((const char*)(Kf + (size_t)j * 8192) + ch * 1024 + lane * 16), (LAS unsigned*)(slot + ch * 1024), 16, 0, 0);
        __builtin_amdgcn_global_load_lds((const unsigned*)((const char*)(Vf + (size_t)j * 8192) + ch * 1024 + lane * 16), (LAS unsigned*)(slot + 16384 + ch * 1024), 16, 0, 0); }
}
__device__ __forceinline__ void attn_prompt_unit(const AttnP& P0, int b, int kv, int i, LAS unsigned char* lds, int wave, int lane0) {
    int lane = lane0; asm volatile("" : "+v"(lane));
    AttnP P = P0;
    asm volatile("" : "+s"(P.QBr), "+s"(P.qn_g), "+s"(P.KSf), "+s"(P.VSf), "+s"(P.KWf), "+s"(P.VWf), "+s"(P.KCf), "+s"(P.VCf));
    asm volatile("" : "+s"(P.gates), "+s"(P.relb), "+s"(P.OB), "+s"(P.OT));
    const int rg = wave & 3, par = wave >> 2, q = lane & 31, hi = lane >> 5, tid = wave * 64 + lane;
    const int tok = 32 * i + 8 * rg + (q >> 2), g = q & 3, head = kv * 4 + g, cur = i >> 1;
    const size_t row = (size_t)b * TP + tok;
    LAS float* biasT = (LAS float*)(lds + AL_BIAS); LAS float* lx = (LAS float*)(lds + AL_LX); LAS float* fx = (LAS float*)(lds + AL_FX); LAS unsigned* selw = (LAS unsigned*)(lds + AL_SEL);
    LAS float* impA = (LAS float*)(lds + AL_IMPA); LAS float* impB = (LAS float*)(lds + AL_IMPB); LAS float* scT = (LAS float*)(lds + AL_SCT);
    for (int u = tid; u < 4 * 129; u += NTHR) { const int gg = u / 129, r = u % 129; biasT[gg * 132 + r] = P.relb[rel_bucket(r) * 8 + kv * 4 + gg] * LOG2E; }
    bf16x8 qf[8];
    load_q_frags(qf, P.QBr + row * LQ + head * 128, P.qn_g, hi);
    const float g0 = P.gates[row * 24 + head * 3 + 0], g1 = P.gates[row * 24 + head * 3 + 1], g2 = P.gates[row * 24 + head * 3 + 2];
    const LAS float* bias_g = biasT + g * 132;
    f32x16 ob[4], ot[4];
#pragma unroll
    for (int dt = 0; dt < 4; ++dt) { ob[dt] = (f32x16){0.f, 0.f, 0.f, 0.f, 0.f, 0.f, 0.f, 0.f, 0.f, 0.f, 0.f, 0.f, 0.f, 0.f, 0.f, 0.f}; ot[dt] = ob[dt]; }
    const size_t seqkv = (size_t)b * 2 + kv;

    {
        int nct = ((2 * i + 3) >> 6) + 1; nct = nct > 4 ? 4 : nct;
        dma_copy(lds, P.KCf + seqkv * 8 * 4096, nct * 16, wave, lane);
        dma_copy(lds + 65536, P.VCf + seqkv * 8 * 4096, nct * 16, wave, lane);
        AT_BAR();
        float lsum = 0.f;
#pragma unroll 1
        for (int t = 0; t < 2; ++t) {
            const int ct = par + 2 * t;
            if (ct < nct) {
#pragma unroll 1
                for (int sub = 0; sub < 2; ++sub) {
                    f32x16 sc = at_qk(lds + ct * 16384 + sub * 8192, qf, lane);
#pragma unroll
                    for (int r = 0; r < 16; ++r) { const int c = 64 * ct + 32 * sub + crow(r, hi); const int rel = tok - (16 * c + 31); const int ix = rel < 0 ? 0 : (rel > 128 ? 128 : rel);
                        const float e = rel >= 0 ? __builtin_amdgcn_exp2f(sc[r] + bias_g[ix]) : 0.f; lsum += e; }
                }
            }
        }
        lsum += __shfl_xor(lsum, 32);
        if (hi == 0) lx[wave * 32 + q] = lsum;
        AT_BAR();
        const float ltot = lx[rg * 32 + q] + lx[(rg + 4) * 32 + q];
        const float inv = 1.0f / fmaxf(ltot, 1e-30f);
#pragma unroll 1
        for (int t = 0; t < 2; ++t) {
            const int ct = par + 2 * t;
            if (ct < nct) {
#pragma unroll 1
                for (int sub = 0; sub < 2; ++sub) {
                    f32x16 sc = at_qk(lds + ct * 16384 + sub * 8192, qf, lane);
#pragma unroll
                    for (int r = 0; r < 16; ++r) { const int c = 64 * ct + 32 * sub + crow(r, hi); const int rel = tok - (16 * c + 31); const int ix = rel < 0 ? 0 : (rel > 128 ? 128 : rel);
                        sc[r] = (rel >= 0 ? __builtin_amdgcn_exp2f(sc[r] + bias_g[ix]) : 0.f) * inv; }
#pragma unroll
                    for (int m = 0; m < 4; ++m) { float sa = (sc[4 * m] + sc[4 * m + 1]) + (sc[4 * m + 2] + sc[4 * m + 3]), sb = sc[4 * m + 3];
                        sa += __shfl_xor(sa, 1); sa += __shfl_xor(sa, 2); sb += __shfl_xor(sb, 1); sb += __shfl_xor(sb, 2);
                        if (g == 0) { const int s = 16 * ct + 8 * sub + 2 * m + hi; impA[(8 * rg + (q >> 2)) * 64 + s] = sa; impB[(8 * rg + (q >> 2)) * 64 + s] = sb; } }
#pragma unroll
                    for (int r = 0; r < 16; ++r) sc[r] *= g0;
                    at_pv(ot, sc, lds + 65536 + ct * 16384 + sub * 8192, lane);
                }
            }
        }
        AT_BAR();
#pragma unroll 1
        for (int tt = 0; tt < 4; ++tt) {
            const int tl = 4 * wave + tt, s = lane; float score = -INFINITY;
            if (s <= cur) { const float a = impA[tl * 64 + s] + (s > 0 ? impB[tl * 64 + s - 1] : 0.f); const bool forced = (s == 0) || (s == cur) || (s == cur - 1); score = a + (forced ? 1.0e6f : 0.f); }
            scT[tl * 64 + s] = score;
        }
        asm volatile("s_waitcnt lgkmcnt(0)" ::: "memory"); __builtin_amdgcn_wave_barrier();
#pragma unroll 1
        for (int tt = 0; tt < 4; ++tt) {
            const int tl = 4 * wave + tt, s = lane; const float score = scT[tl * 64 + s]; int rank = 0;
#pragma unroll 2
            for (int t4 = 0; t4 < 16; ++t4) { const f32x4 u4 = *(const LAS f32x4*)(scT + tl * 64 + 4 * t4);
#pragma unroll
                for (int e = 0; e < 4; ++e) { const int t = 4 * t4 + e; rank += (u4[e] > score || (u4[e] == score && t < s)) ? 1 : 0; } }
            const unsigned long long m = __ballot(rank < 16);
            if (lane == 0) { selw[tl * 2] = (unsigned)m; selw[tl * 2 + 1] = (unsigned)(m >> 32); }
        }
        AT_BAR();
    }
    const unsigned long long smask = ((unsigned long long)selw[(8 * rg + (q >> 2)) * 2 + 1] << 32) | selw[(8 * rg + (q >> 2)) * 2];
    const float b31 = bias_g[128];
    const int t0 = 32 * i + 8 * rg;

#pragma unroll 1
    for (int br = 1; br <= 2; ++br) {
        const bf16* Kf = (br == 1 ? P.KSf : P.KWf) + seqkv * 128 * 4096; const bf16* Vf = (br == 1 ? P.VSf : P.VWf) + seqkv * 128 * 4096;
        const int j0 = (br == 1) ? 0 : ((32 * i >= 511) ? ((32 * i - 511) >> 6) : 0);
        const int ntile = cur - j0 + 1; const int maxrel = (br == 1) ? 0x40000000 : 512;
        float lsum = 0.f;
        at_stage_tile(lds, Kf, Vf, j0, wave, lane);
        if (ntile > 1) at_stage_tile(lds + 32768, Kf, Vf, j0 + 1, wave, lane);
        if (ntile > 2) at_stage_tile(lds + 65536, Kf, Vf, j0 + 2, wave, lane);
#pragma unroll 1
        for (int t = 0; t < ntile; ++t) {
            const int ahead = ntile - 1 - t;
            if (ahead >= 2) asm volatile("s_waitcnt vmcnt(8)" ::: "memory"); else if (ahead == 1) asm volatile("s_waitcnt vmcnt(4)" ::: "memory"); else asm volatile("s_waitcnt vmcnt(0)" ::: "memory");
            asm volatile("s_waitcnt lgkmcnt(0)" ::: "memory"); __builtin_amdgcn_s_barrier(); asm volatile("" ::: "memory");
            if (t + 3 < ntile) at_stage_tile(lds + ((t + 3) & 3) * 32768, Kf, Vf, j0 + t + 3, wave, lane);
            const int j = j0 + t;
            const bool keep = (br == 1) ? (((smask >> j) & 1ull) != 0ull) : true;
            const int relmin = t0 - (64 * j + 63), relmax = t0 + 7 - 64 * j;
            const bool skip = (br == 2) && (relmin > 511);
            if (__ballot(keep) != 0ull && !skip) {
                const LAS unsigned char* kb = lds + (t & 3) * 32768 + par * 8192; const LAS unsigned char* vb = kb + 16384;
                f32x16 p0 = at_qk(kb, qf, lane);
                if (relmin >= 128 && relmax < maxrel) lsum += at_exp<0>(p0, tok, 64 * j + 32 * par, hi, bias_g, b31, maxrel, keep);
                else lsum += at_exp<1>(p0, tok, 64 * j + 32 * par, hi, bias_g, b31, maxrel, keep);
                at_pv(ob, p0, vb, lane);
            }
        }
        lsum += __shfl_xor(lsum, 32);
        if (hi == 0) lx[wave * 32 + q] = lsum;
        AT_BAR();
        { const float ltot = lx[rg * 32 + q] + lx[(rg + 4) * 32 + q]; const float f = (br == 1 ? g1 : g2) / fmaxf(ltot, 1e-30f); if (hi == 0) fx[wave * 32 + q] = f; }
        asm volatile("s_waitcnt lgkmcnt(0)" ::: "memory"); __builtin_amdgcn_wave_barrier();
#pragma unroll
        for (int m = 0; m < 4; ++m) { const f32x4 fv = *(const LAS f32x4*)(fx + wave * 32 + 8 * m + 4 * hi);
#pragma unroll
            for (int dt = 0; dt < 4; ++dt)
#pragma unroll
                for (int e = 0; e < 4; ++e) { ot[dt][4 * m + e] += fv[e] * ob[dt][4 * m + e]; ob[dt][4 * m + e] = 0.f; } }
        AT_BAR();
    }
    LAS float* obuf = (LAS float*)lds;
    if (par == 1) {
#pragma unroll
        for (int dt = 0; dt < 4; ++dt)
#pragma unroll
            for (int r = 0; r < 16; ++r) obuf[(rg * 32 + crow(r, hi)) * 128 + 32 * dt + q] = ot[dt][r];
    }
    AT_BAR();
    if (par == 0) {
#pragma unroll
        for (int dt = 0; dt < 4; ++dt)
#pragma unroll
            for (int r = 0; r < 16; ++r) { LAS float* o = obuf + (rg * 32 + crow(r, hi)) * 128 + 32 * dt + q; *o = *o + ot[dt][r]; }
    }
    AT_BAR();
    for (int u = tid; u < 2048; u += NTHR) {
        const int rr = u >> 4, ch = u & 15, rgg = rr >> 5, qq = rr & 31;
        const f32x4 a = *(const LAS f32x4*)(obuf + rr * 128 + ch * 8), c = *(const LAS f32x4*)(obuf + rr * 128 + ch * 8 + 4);
        u32x4 w; w.x = cvtpk(a[0], a[1]); w.y = cvtpk(a[2], a[3]); w.z = cvtpk(c[0], c[1]); w.w = cvtpk(c[2], c[3]);
        *(u32x4*)(P.OB + ((size_t)b * TP + 32 * i + 8 * rgg + (qq >> 2)) * 1024 + (kv * 4 + (qq & 3)) * 128 + ch * 8) = w;
    }
    AT_BAR();
}

__device__ __forceinline__ void prep_kv_tile(float* __restrict__ T, const float* __restrict__ gain, bf16* __restrict__ Kf, bf16* __restrict__ Vf, float* __restrict__ wout, int b, int kv, int Tt, int tid, float* kl  ) {
    const int key = tid >> 4, part = tid & 15, lane = tid & 63, x = tid >> 6, l31 = lane & 31, h = lane >> 5;
    float* rowp = T + ((size_t)b * TP + 32 * Tt + key) * 512 + kv * 128 + part * 8;
    f32x4 k0 = *(const f32x4*)rowp, k1 = *(const f32x4*)(rowp + 4);
    float ss = (k0[0] * k0[0] + k0[1] * k0[1]) + (k0[2] * k0[2] + k0[3] * k0[3]) + (k1[0] * k1[0] + k1[1] * k1[1]) + (k1[2] * k1[2] + k1[3] * k1[3]);
    ss += __shfl_xor(ss, 1); ss += __shfl_xor(ss, 2); ss += __shfl_xor(ss, 4); ss += __shfl_xor(ss, 8);
    const float r = rsqrtf(ss * (1.0f / 128) + EPS); const f32x4 g0 = *(const f32x4*)(gain + part * 8), g1 = *(const f32x4*)(gain + part * 8 + 4);
    k0 = k0 * g0 * r; k1 = k1 * g1 * r;
    *(f32x4*)rowp = k0; *(f32x4*)(rowp + 4) = k1;
    *(f32x4*)(kl + key * 132 + part * 8) = k0; *(f32x4*)(kl + key * 132 + part * 8 + 4) = k1;
    if (wout != nullptr) { float* wo = wout + (size_t)key * 512 + kv * 128 + part * 8; *(f32x4*)wo = k0; *(f32x4*)(wo + 4) = k1;
        *(f32x4*)(wo + 256) = *(const f32x4*)(rowp + 256); *(f32x4*)(wo + 260) = *(const f32x4*)(rowp + 260); }
    __syncthreads();
    { const float* s = kl + l31 * 132 + 16 * x + 8 * h; const f32x4 a0 = *(const f32x4*)s, a1 = *(const f32x4*)(s + 4);
      u32x4 w; w.x = cvtpk(a0[0], a0[1]); w.y = cvtpk(a0[2], a0[3]); w.z = cvtpk(a1[0], a1[1]); w.w = cvtpk(a1[2], a1[3]); *(u32x4*)(Kf + (size_t)(x * 64 + lane) * 8) = w; }
    { const int ks = x >> 2, dt = x & 3; const float* vb = T + ((size_t)b * TP + 32 * Tt) * 512 + 256 + kv * 128 + 32 * dt + l31; float v[8];
#pragma unroll
      for (int j = 0; j < 8; ++j) v[j] = vb[(size_t)(16 * ks + 8 * (j >> 2) + 4 * h + (j & 3)) * 512];
      u32x4 w; w.x = cvtpk(v[0], v[1]); w.y = cvtpk(v[2], v[3]); w.z = cvtpk(v[4], v[5]); w.w = cvtpk(v[6], v[7]); *(u32x4*)(Vf + (size_t)((ks * 4 + dt) * 64 + lane) * 8) = w; }
    __syncthreads();
}
__device__ __forceinline__ void prep_kv_sample(float* __restrict__ out, float* __restrict__ WINKV, const float* __restrict__ ks_g, const float* __restrict__ kw_g, int grp, int part) {
    const int which = grp >> 9, r = (grp >> 1) & 255, kv = grp & 1;
    float* rowp = (which == 0 ? out + O_SELS + (size_t)r * 512 : WINKV + ((size_t)MP + r) * 512) + kv * 128 + part * 8;
    f32x4 k0 = *(const f32x4*)rowp, k1 = *(const f32x4*)(rowp + 4);
    float ss = (k0[0] * k0[0] + k0[1] * k0[1]) + (k0[2] * k0[2] + k0[3] * k0[3]) + (k1[0] * k1[0] + k1[1] * k1[1]) + (k1[2] * k1[2] + k1[3] * k1[3]);
    ss += __shfl_xor(ss, 1); ss += __shfl_xor(ss, 2); ss += __shfl_xor(ss, 4); ss += __shfl_xor(ss, 8);
    const float* gain = which == 0 ? ks_g : kw_g;
    const float rr = rsqrtf(ss * (1.0f / 128) + EPS); const f32x4 g0 = *(const f32x4*)(gain + part * 8), g1 = *(const f32x4*)(gain + part * 8 + 4);
    k0 = k0 * g0 * rr; k1 = k1 * g1 * rr;
    *(f32x4*)rowp = k0; *(f32x4*)(rowp + 4) = k1;
    if (which == 1) { float* wo = out + O_WINS + ((size_t)(r >> 3) * 512 + 504 + (r & 7)) * 512 + kv * 128 + part * 8; *(f32x4*)wo = k0; *(f32x4*)(wo + 4) = k1;
        *(f32x4*)(wo + 256) = *(const f32x4*)(rowp + 256); *(f32x4*)(wo + 260) = *(const f32x4*)(rowp + 260); }
}
template <class SrcK, class SrcV> __device__ __forceinline__ void pack_tile(bf16* Kf, bf16* Vf, const SrcK& sk, const SrcV& sv, int tid) {
    const int lane = tid & 63, x = tid >> 6, l31 = lane & 31, h = lane >> 5;
    { const int s = x; u32x4 w; float v[8];
#pragma unroll
        for (int j = 0; j < 8; ++j) v[j] = sk(l31, 16 * s + 8 * h + j);
        w.x = cvtpk(v[0], v[1]); w.y = cvtpk(v[2], v[3]); w.z = cvtpk(v[4], v[5]); w.w = cvtpk(v[6], v[7]); *(u32x4*)(Kf + (size_t)(s * 64 + lane) * 8) = w; }
    { const int ks = x >> 2, dt = x & 3; u32x4 w; float v[8];
#pragma unroll
        for (int j = 0; j < 8; ++j) v[j] = sv(16 * ks + 8 * (j >> 2) + 4 * h + (j & 3), 32 * dt + l31);
        w.x = cvtpk(v[0], v[1]); w.y = cvtpk(v[2], v[3]); w.z = cvtpk(v[4], v[5]); w.w = cvtpk(v[6], v[7]); *(u32x4*)(Vf + (size_t)((ks * 4 + dt) * 64 + lane) * 8) = w; }
}
struct SrcRowsLim { const float* base; size_t stride; int lim; __device__ __forceinline__ float operator()(int key, int d) const { return key < lim ? base[(size_t)key * stride + d] : 0.f; } };

constexpr int XHC_ROWS = 32768, XHP_ROWS = 1280;
__device__ __forceinline__ void b_xhc_panel(const float* __restrict__ cache, const int* __restrict__ pt, bf16* __restrict__ panel, int L, int tid) {
    const int w = L >> 7, p = L & 127, b = p >> 2, lane16 = tid & 15, x = tid >> 4;
    const int ptv = pt[b * NPAGE + (p & 3) * 16 + lane16];
#pragma unroll 1
    for (int pg2 = 0; pg2 < 16; pg2 += 2) {
        const size_t base0 = (size_t)__builtin_amdgcn_readlane(ptv, pg2) * PAGE, base1 = (size_t)__builtin_amdgcn_readlane(ptv, pg2 + 1) * PAGE;
        f32x4 xa[16], ya[16];
#pragma unroll
        for (int i = 0; i < 16; ++i) {
            const int seg = (pg2 * 8 + i) * 32 + x; const int r = seg >> 4, j = seg & 15, n7 = (r >> 1) & 7, kv = r & 1;
            const float* s = cache + ((i < 8 ? base0 : base1) + n7 * 16 + j) * 512 + w * 256 + kv * 128 + lane16 * 8;
            xa[i] = *(const f32x4*)s; ya[i] = *(const f32x4*)(s + 4);
        }
#pragma unroll
        for (int i = 0; i < 16; ++i) {
            const int seg = (pg2 * 8 + i) * 32 + x; const int r = seg >> 4, j = seg & 15;
            u32x4 o; o.x = cvtpk(xa[i][0], xa[i][1]); o.y = cvtpk(xa[i][2], xa[i][3]); o.z = cvtpk(ya[i][0], ya[i][1]); o.w = cvtpk(ya[i][2], ya[i][3]);
            *(u32x4*)(panel + (size_t)r * 2048 + j * 128 + lane16 * 8) = o;
        }
    }
}
struct OneOrder {
    int pn;
    __device__ __forceinline__ bool next(int i, pg8::Unit& u) const { if (i > 0) return false; u.pm = 0; u.pn = pn; u.k0 = 0; u.nt = 32; u.sel = 0; return true; }
    __device__ __forceinline__ void a_ready(const pg8::Unit&) const {}
    __device__ __forceinline__ void done(const pg8::Unit&) const {}
};
struct DiagOrder {
    int n, per, G, c;
    __device__ __forceinline__ bool next(int i, pg8::Unit& u) const { const int L = i * G + c; if (L >= n) return false; u.pm = L; u.pn = L / per; u.k0 = 0; u.nt = 32; u.sel = 0; return true; }
    __device__ __forceinline__ void a_ready(const pg8::Unit&) const {}
    __device__ __forceinline__ void done(const pg8::Unit&) const {}
};
struct FStorePre { float* C; int rowoff, pad; __device__ __forceinline__ void operator()(int r, int c, f32x4 v) const { *(f32x4*)(C + (size_t)(rowoff + r) * 256 + (c & 255)) = v; } };
struct CmpW { const float *kw1, *kb1, *kw2, *vw1, *vb1, *vw2, *kc_g; };
__device__ __forceinline__ void b_cfin(const float* __restrict__ PREC, const float* __restrict__ PREP, const CmpW& cw, float* __restrict__ KCP, float* __restrict__ VCP, float* __restrict__ KCS, float* __restrict__ VCS,
                                       int grp, int tid, float* hid, float* red) {
    const int NP = 2040;
    float* dst[4]; int w = 0;
#pragma unroll
    for (int r4 = 0; r4 < 4; ++r4) {
        int x = grp * 4 + r4; bool pr; int b, i, kv; const float *p0, *p1;
        if (x < NP) { pr = true; kv = x & 1; x >>= 1; i = x % 255; x /= 255; b = x & 1; w = x >> 1;
            p0 = PREP + ((size_t)w * XHP_ROWS + ((size_t)b * 256 + i) * 2 + kv) * 256; p1 = PREP + ((size_t)w * XHP_ROWS + ((size_t)b * 256 + i + 1) * 2 + kv) * 256 + 128; }
        else { x -= NP; pr = false; kv = x & 1; x >>= 1; i = x & 511; x >>= 9; b = x & 31; w = x >> 5;
            p0 = PREC + ((size_t)w * XHC_ROWS + ((size_t)b * 512 + i) * 2 + kv) * 256;
            p1 = (i < 511) ? PREC + ((size_t)w * XHC_ROWS + ((size_t)b * 512 + i + 1) * 2 + kv) * 256 + 128 : PREP + ((size_t)w * XHP_ROWS + 1024 + b * 2 + kv) * 256 + 128; }
        const float* b1 = w ? cw.vb1 : cw.kb1;
        hid[r4 * 128 + tid] = siluf_(p0[tid] + p1[tid] + b1[tid]);
        dst[r4] = pr ? (w ? VCP : KCP) + (((size_t)b * 256 + i) * 2 + kv) * 128 : (w ? VCS : KCS) + (((size_t)b * 512 + i) * 2 + kv) * 128;
    }
    __syncthreads();
    const float* w2 = w ? cw.vw2 : cw.kw2;
    float o[4] = {0.f, 0.f, 0.f, 0.f};
    for (int k = 0; k < 128; ++k) { const float wv = w2[k * 128 + tid];
#pragma unroll
        for (int r4 = 0; r4 < 4; ++r4) o[r4] += hid[r4 * 128 + k] * wv; }
#pragma unroll
    for (int r4 = 0; r4 < 4; ++r4) { const float ss = wave_sum(o[r4] * o[r4]); if ((tid & 63) == 0) red[r4 * 2 + (tid >> 6)] = ss; }
    __syncthreads();
#pragma unroll
    for (int r4 = 0; r4 < 4; ++r4) { float v = o[r4]; if (w == 0) v = v * rsqrtf((red[r4 * 2] + red[r4 * 2 + 1]) * (1.0f / 128) + EPS) * cw.kc_g[tid]; dst[r4][tid] = v; }
    __syncthreads();
}

__device__ __forceinline__ void b_cfin_mfma(const float* __restrict__ PREC, const float* __restrict__ PREP, const bf16* __restrict__ W2T, const CmpW& cw,
                                            bf16* __restrict__ KCf, bf16* __restrict__ VCf, float* __restrict__ KCS, float* __restrict__ VCS, int item, int lane) {
    const int l31 = lane & 31, hi = lane >> 5;
    int x, xmax;
    if (item < 64) { const int w0 = item >> 5; x = 1020 * w0 + 32 * (item & 31) + l31; xmax = 1020 * w0 + 1019; } else { x = 2040 + 32 * (item - 64) + l31; xmax = 2040 + 65535; }
    const bool valid = x <= xmax; x = valid ? x : xmax;
    bool pr; int b, i, kv, w; const float *p0, *p1; float* dst;
    if (x < 2040) { int y = x; pr = true; kv = y & 1; y >>= 1; i = y % 255; y /= 255; b = y & 1; w = y >> 1;
        p0 = PREP + ((size_t)w * XHP_ROWS + ((size_t)b * 256 + i) * 2 + kv) * 256; p1 = PREP + ((size_t)w * XHP_ROWS + ((size_t)b * 256 + i + 1) * 2 + kv) * 256 + 128;
        dst = nullptr; }
    else { int y = x - 2040; pr = false; kv = y & 1; y >>= 1; i = y & 511; y >>= 9; b = y & 31; w = y >> 5;
        p0 = PREC + ((size_t)w * XHC_ROWS + ((size_t)b * 512 + i) * 2 + kv) * 256;
        p1 = (i < 511) ? PREC + ((size_t)w * XHC_ROWS + ((size_t)b * 512 + i + 1) * 2 + kv) * 256 + 128 : PREP + ((size_t)w * XHP_ROWS + 1024 + b * 2 + kv) * 256 + 128;
        dst = (w ? VCS : KCS) + (((size_t)b * 512 + i) * 2 + kv) * 128; }
    (void)pr;
    const int wu = __builtin_amdgcn_readfirstlane(w);
    const float* b1 = wu ? cw.vb1 : cw.kb1; const bf16* wt = W2T + (size_t)wu * 16384;
    f32x16 d[4];
#pragma unroll
    for (int cb = 0; cb < 4; ++cb) d[cb] = (f32x16){0.f, 0.f, 0.f, 0.f, 0.f, 0.f, 0.f, 0.f, 0.f, 0.f, 0.f, 0.f, 0.f, 0.f, 0.f, 0.f};
    f32x4 pa[16], pc[16];
#pragma unroll
    for (int s = 0; s < 8; ++s) { const int k0 = 16 * s + 8 * hi; pa[2 * s] = *(const f32x4*)(p0 + k0); pa[2 * s + 1] = *(const f32x4*)(p0 + k0 + 4); pc[2 * s] = *(const f32x4*)(p1 + k0); pc[2 * s + 1] = *(const f32x4*)(p1 + k0 + 4); }
#pragma unroll
    for (int s = 0; s < 8; ++s) {
        const int k0 = 16 * s + 8 * hi;
        const f32x4 a0 = pa[2 * s], a1 = pa[2 * s + 1], c0 = pc[2 * s], c1 = pc[2 * s + 1], e0 = *(const f32x4*)(b1 + k0), e1 = *(const f32x4*)(b1 + k0 + 4);
        u32x4 hw; hw.x = cvtpk(siluf_(a0[0] + c0[0] + e0[0]), siluf_(a0[1] + c0[1] + e0[1])); hw.y = cvtpk(siluf_(a0[2] + c0[2] + e0[2]), siluf_(a0[3] + c0[3] + e0[3]));
        hw.z = cvtpk(siluf_(a1[0] + c1[0] + e1[0]), siluf_(a1[1] + c1[1] + e1[1])); hw.w = cvtpk(siluf_(a1[2] + c1[2] + e1[2]), siluf_(a1[3] + c1[3] + e1[3]));
        const bf16x8 hf = __builtin_bit_cast(bf16x8, hw);
#pragma unroll
        for (int cb = 0; cb < 4; ++cb) { const bf16x8 wf = *(const bf16x8*)(wt + (size_t)(32 * cb + l31) * 128 + k0); d[cb] = __builtin_amdgcn_mfma_f32_32x32x16_bf16(wf, hf, d[cb], 0, 0, 0); }
    }
    float rs = 1.0f;
    if (wu == 0) { float ss = 0.f;
#pragma unroll
        for (int cb = 0; cb < 4; ++cb)
#pragma unroll
            for (int r = 0; r < 16; ++r) ss += d[cb][r] * d[cb][r];
        ss += __shfl_xor(ss, 32); rs = rsqrtf(ss * (1.0f / 128) + EPS); }
    const bool prm = (item < 64);
    if (valid) {
#pragma unroll
        for (int cb = 0; cb < 4; ++cb)
#pragma unroll
            for (int m = 0; m < 4; ++m) { const int col = 32 * cb + 8 * m + 4 * hi; f32x4 o;
#pragma unroll
                for (int e = 0; e < 4; ++e) o[e] = d[cb][4 * m + e] * rs;
                if (wu == 0) { const f32x4 gg = *(const f32x4*)(cw.kc_g + col); o = o * gg; }
                if (!prm) *(f32x4*)(dst + col) = o;
                else { const int T = i >> 5, kl = i & 31; bf16* tb = (wu ? VCf : KCf) + (((size_t)b * 2 + kv) * 8 + T) * 4096;
                    if (wu == 0) { typedef unsigned u32x2v __attribute__((ext_vector_type(2))); u32x2v pk; pk.x = cvtpk(o[0], o[1]); pk.y = cvtpk(o[2], o[3]);
                        *(u32x2v*)(tb + (size_t)((2 * cb + (m >> 1)) * 64 + kl + 32 * (m & 1)) * 8 + 4 * hi) = pk; }
                    else { const int ks = kl >> 4, kk = kl & 15, hh = (kk >> 2) & 1, jj = (kk >> 3) * 4 + (kk & 3);
#pragma unroll
                        for (int e = 0; e < 4; ++e) { const int dcol = col + e; tb[(size_t)(((ks * 4 + (dcol >> 5)) * 64) + (dcol & 31) + 32 * hh) * 8 + jj] = f2bf(o[e]); } } }
            }
    }
}

constexpr int HG_QPP = 0, HG_KPP = 17408, HG_KET = 34816, HG_VT = 53248, HG_QSUM = 71680, HG_BEND = 73728;
constexpr int HG_RS = 136, HG_TS = 72;
struct HgP { const bf16* QAb; const bf16* IAb; const bf16* GAs; const float* F; bf16* QS; float* OI; float* Lb; float* DEC; bf16* SPT; };

__device__ __forceinline__ bf16x8 hg_pack8(const float (&v)[16], int o) { u32x4 w; w.x = cvtpk(v[o], v[o + 1]); w.y = cvtpk(v[o + 2], v[o + 3]); w.z = cvtpk(v[o + 4], v[o + 5]); w.w = cvtpk(v[o + 6], v[o + 7]); return __builtin_bit_cast(bf16x8, w); }

__device__ __forceinline__ void hgrn_local(const HgP& P0, int item, LAS unsigned char* lds, int tid) {
    HgP P = P0; asm volatile("" : "+s"(P.QAb), "+s"(P.IAb), "+s"(P.F), "+s"(P.QS), "+s"(P.OI), "+s"(P.Lb), "+s"(P.DEC));
    const int b = item >> 9, h = (item >> 6) & 7, c = item & 63; const size_t row0 = (size_t)b * TP + 64 * c;
    const int k = tid & 127, qd = tid >> 7, lane = tid & 63, wave = __builtin_amdgcn_readfirstlane(tid >> 6), l31 = lane & 31, hi = lane >> 5;
    LAS bf16* QPP = (LAS bf16*)(lds + HG_QPP); LAS bf16* KPP = (LAS bf16*)(lds + HG_KPP); LAS bf16* KET = (LAS bf16*)(lds + HG_KET); LAS bf16* VT = (LAS bf16*)(lds + HG_VT);
    LAS float* qsum = (LAS float*)(lds + HG_QSUM); LAS float* bendl = (LAS float*)(lds + HG_BEND);
    float bl[16], fk[16];
    { float run = 0.f;
#pragma unroll
        for (int i = 0; i < 16; ++i) { fk[i] = P.F[(row0 + 16 * qd + i) * LQ + h * 128 + k]; run += __logf(fk[i]); bl[i] = run; }
        qsum[qd * 128 + k] = run; }
    asm volatile("s_waitcnt lgkmcnt(0)" ::: "memory"); __builtin_amdgcn_s_barrier(); asm volatile("" ::: "memory");
    float pre = 0.f, bend = 0.f;
#pragma unroll
    for (int j = 0; j < 4; ++j) { const float s = qsum[j * 128 + k]; bend += s; pre += (j < qd) ? s : 0.f; }
    {
        float ke[16], vt[16];
#pragma unroll
        for (int i = 0; i < 16; ++i) {
            const int t = 16 * qd + i; const float eb = pre + bl[i];
            const float q = bf2f(P.QAb[(row0 + t) * LQ + h * 128 + k]), kk = 1.0f - fk[i];
            P.QS[(row0 + t) * 1024 + h * 128 + k] = f2bf(q * __expf(eb));
            QPP[t * HG_RS + k] = f2bf(q * __expf(fminf(eb - 0.5f * bend, 80.f)));
            KPP[t * HG_RS + k] = f2bf(kk * __expf(fminf(0.5f * bend - eb, 80.f)));
            ke[i] = kk * __expf(bend - eb); vt[i] = bf2f(P.IAb[(row0 + t) * LQ + h * 128 + k]);
        }
        *(LAS bf16x8*)(KET + k * HG_TS + 16 * qd) = hg_pack8(ke, 0); *(LAS bf16x8*)(KET + k * HG_TS + 16 * qd + 8) = hg_pack8(ke, 8);
        *(LAS bf16x8*)(VT + k * HG_TS + 16 * qd) = hg_pack8(vt, 0); *(LAS bf16x8*)(VT + k * HG_TS + 16 * qd + 8) = hg_pack8(vt, 8);
        if (qd == 3) P.DEC[(size_t)item * 128 + k] = __expf(bend);
    }
    asm volatile("s_waitcnt lgkmcnt(0)" ::: "memory"); __builtin_amdgcn_s_barrier(); asm volatile("" ::: "memory");
    const int tb = (wave < 4) ? 1 : 0, vb = wave & 3;
    f32x16 z = {0.f, 0.f, 0.f, 0.f, 0.f, 0.f, 0.f, 0.f, 0.f, 0.f, 0.f, 0.f, 0.f, 0.f, 0.f, 0.f};
#pragma unroll 1
    for (int sb = 0; sb <= tb; ++sb) {
        f32x16 x = {0.f, 0.f, 0.f, 0.f, 0.f, 0.f, 0.f, 0.f, 0.f, 0.f, 0.f, 0.f, 0.f, 0.f, 0.f, 0.f};
#pragma unroll
        for (int st = 0; st < 8; ++st) { const bf16x8 af = *(const LAS bf16x8*)(KPP + (32 * sb + l31) * HG_RS + 16 * st + 8 * hi), bf = *(const LAS bf16x8*)(QPP + (32 * tb + l31) * HG_RS + 16 * st + 8 * hi);
            x = __builtin_amdgcn_mfma_f32_32x32x16_bf16(af, bf, x, 0, 0, 0); }
        if (sb == tb) {
#pragma unroll
            for (int r = 0; r < 16; ++r) x[r] = (crow(r, hi) <= l31) ? x[r] : 0.f;
        }
#pragma unroll
        for (int ks = 0; ks < 2; ++ks) {
            u32x4 w; w.x = cvtpk(x[8 * ks + 0], x[8 * ks + 1]); w.y = cvtpk(x[8 * ks + 2], x[8 * ks + 3]); w.z = cvtpk(x[8 * ks + 4], x[8 * ks + 5]); w.w = cvtpk(x[8 * ks + 6], x[8 * ks + 7]);
            typedef unsigned u32x2v __attribute__((ext_vector_type(2)));
            const LAS bf16* vp = VT + (32 * vb + l31) * HG_TS + 32 * sb + 16 * ks + 4 * hi;
            const u32x2v lo = *(const LAS u32x2v*)vp, hh = *(const LAS u32x2v*)(vp + 8);
            u32x4 vv; vv.x = lo.x; vv.y = lo.y; vv.z = hh.x; vv.w = hh.y;
            z = __builtin_amdgcn_mfma_f32_32x32x16_bf16(__builtin_bit_cast(bf16x8, w), __builtin_bit_cast(bf16x8, vv), z, 0, 0, 0);
        }
    }
    { float* o = P.OI + (row0 + 32 * tb) * 1024 + h * 128 + 32 * vb + l31;
#pragma unroll
        for (int r = 0; r < 16; ++r) o[(size_t)crow(r, hi) * 1024] = z[r]; }
    const int nt = (wave < 4) ? 1 : 3, t0 = (wave < 4) ? wave : 4 + 3 * (wave - 4);
#pragma unroll 1
    for (int ti = 0; ti < nt; ++ti) {
        const int kb = (t0 + ti) >> 2, vb2 = (t0 + ti) & 3;
        f32x16 d = {0.f, 0.f, 0.f, 0.f, 0.f, 0.f, 0.f, 0.f, 0.f, 0.f, 0.f, 0.f, 0.f, 0.f, 0.f, 0.f};
#pragma unroll
        for (int st = 0; st < 4; ++st) { const bf16x8 af = *(const LAS bf16x8*)(KET + (32 * kb + l31) * HG_TS + 16 * st + 8 * hi), bf = *(const LAS bf16x8*)(VT + (32 * vb2 + l31) * HG_TS + 16 * st + 8 * hi);
            d = __builtin_amdgcn_mfma_f32_32x32x16_bf16(af, bf, d, 0, 0, 0); }
        float* o = P.Lb + (size_t)item * 16384 + (size_t)(32 * kb) * 128 + 32 * vb2 + l31;
#pragma unroll
        for (int r = 0; r < 16; ++r) o[crow(r, hi) * 128] = d[r];
    }
    asm volatile("s_waitcnt lgkmcnt(0)" ::: "memory"); __builtin_amdgcn_s_barrier(); asm volatile("" ::: "memory");
}
__device__ __forceinline__ void hgrn_carry(const HgP& P, float* hg_out, int bh, int k, int v) {
    const float* lb = P.Lb + (size_t)bh * 64 * 16384 + (size_t)k * 128;
    const float* dc = P.DEC + (size_t)bh * 64 * 128 + k;
    bf16* sp = P.SPT + (size_t)bh * 64 * 16384 + (size_t)k * 128;
    float L[64], dd[64];
#pragma unroll
    for (int c = 0; c < 64; ++c) { L[c] = (lb + (size_t)c * 16384)[v]; dd[c] = dc[c * 128]; }
    float S = 0.f;
#pragma unroll
    for (int c = 0; c < 64; ++c) { (sp + (size_t)c * 16384)[v] = f2bf(S); S = dd[c] * S + L[c]; }
    hg_out[(size_t)bh * 16384 + (size_t)k * 128 + v] = S;
}
__device__ __forceinline__ void hgrn_output(const HgP& P0, const float* onorm0, bf16* OA0, int item, LAS unsigned char* lds, int tid) {
    HgP P = P0; const float* onorm = onorm0; bf16* OA = OA0; asm volatile("" : "+s"(P.GAs), "+s"(P.QS), "+s"(P.OI), "+s"(P.SPT), "+s"(onorm), "+s"(OA));
    const int b = item >> 9, h = (item >> 6) & 7, c = item & 63; const size_t row0 = (size_t)b * TP + 64 * c;
    const int lane = tid & 63, wave = __builtin_amdgcn_readfirstlane(tid >> 6), l31 = lane & 31, hi = lane >> 5, tb = wave >> 2, vb = wave & 3;
    f32x16 acc;
    { const float* o = P.OI + (row0 + 32 * tb) * 1024 + h * 128 + 32 * vb + l31;
#pragma unroll
        for (int r = 0; r < 16; ++r) acc[r] = o[(size_t)crow(r, hi) * 1024]; }
    LAS bf16* sl = (LAS bf16*)(lds + 40960);
#pragma unroll
    for (int c4 = 0; c4 < 4; ++c4) { const int e = (c4 * 512 + tid) * 8; *(LAS u32x4*)(sl + (e >> 7) * 136 + (e & 127)) = *(const u32x4*)(P.SPT + (size_t)item * 16384 + e); }
    asm volatile("s_waitcnt vmcnt(0) lgkmcnt(0)" ::: "memory"); __builtin_amdgcn_s_barrier(); asm volatile("" ::: "memory");
#pragma unroll
    for (int st = 0; st < 8; ++st) {
        const bf16x8 af = *(const bf16x8*)(P.QS + (row0 + 32 * tb + l31) * 1024 + h * 128 + 16 * st + 8 * hi);
        const LAS bf16* sp = sl + (16 * st + 8 * hi) * 136 + 32 * vb + l31;
        u32x4 w; w.x = (unsigned)sp[0] | ((unsigned)sp[136] << 16); w.y = (unsigned)sp[2 * 136] | ((unsigned)sp[3 * 136] << 16); w.z = (unsigned)sp[4 * 136] | ((unsigned)sp[5 * 136] << 16); w.w = (unsigned)sp[6 * 136] | ((unsigned)sp[7 * 136] << 16);
        acc = __builtin_amdgcn_mfma_f32_32x32x16_bf16(af, __builtin_bit_cast(bf16x8, w), acc, 0, 0, 0);
    }
    LAS float* ol = (LAS float*)lds;
#pragma unroll
    for (int r = 0; r < 16; ++r) ol[(32 * tb + crow(r, hi)) * 132 + 32 * vb + l31] = acc[r];
    asm volatile("s_waitcnt lgkmcnt(0)" ::: "memory"); __builtin_amdgcn_s_barrier(); asm volatile("" ::: "memory");
    {
        const int t = tid >> 3, sg = tid & 7; float o[16]; float ss = 0.f;
#pragma unroll
        for (int j = 0; j < 16; ++j) { o[j] = ol[t * 132 + 16 * sg + j]; ss += o[j] * o[j]; }
        ss += __shfl_xor(ss, 1); ss += __shfl_xor(ss, 2); ss += __shfl_xor(ss, 4);
        const float r = rsqrtf(ss * (1.0f / 128) + EPS); const bf16* g = P.GAs + (row0 + t) * LQ + h * 128 + 16 * sg; const float* on = onorm + h * 128 + 16 * sg;
#pragma unroll
        for (int j = 0; j < 16; ++j) o[j] = o[j] * r * on[j] * bf2f(g[j]);
        bf16* dst = OA + (row0 + t) * 1024 + h * 128 + 16 * sg;
        *(bf16x8*)dst = hg_pack8(o, 0); *(bf16x8*)(dst + 8) = hg_pack8(o, 8);
    }
    asm volatile("s_waitcnt lgkmcnt(0)" ::: "memory"); __builtin_amdgcn_s_barrier(); asm volatile("" ::: "memory");
}

constexpr int SA_IMP = AL_IMPA;
constexpr int SA_UL = AL_END;
constexpr int SA_SM = SA_UL + 136 * 4;
constexpr int SA_END = SA_SM + 8 * 5 * 4;
static_assert(SA_END <= LDS_BYTES, "sample attention LDS control region");
struct SAttnP { const float* QBr; const float* qn_g; const float* gates; const float* relb; const float* KCS; const float* VCS; const float* cache_sel; const float* cache_win; const int* pt; const float* selnew; const float* winkv; float* PART; };
struct STile { const float* kp; const float* vp; int stride; int kmax; int k0; };

__device__ __forceinline__ bf16x8 sa_kfrag(const float* rowp, int s, int hi) {
    const f32x4 a = *(const f32x4*)(rowp + 16 * s + 8 * hi), c = *(const f32x4*)(rowp + 16 * s + 8 * hi + 4);
    u32x4 w; w.x = cvtpk(a[0], a[1]); w.y = cvtpk(a[2], a[3]); w.z = cvtpk(c[0], c[1]); w.w = cvtpk(c[2], c[3]); return __builtin_bit_cast(bf16x8, w);
}
__device__ __forceinline__ f32x16 sa_qk(const STile& T, const bf16x8 (&qf)[8], int l31, int hi) {
    const int kl = l31 < T.kmax ? l31 : T.kmax; const float* rowp = T.kp + (size_t)kl * T.stride;
    f32x16 p = {0.f, 0.f, 0.f, 0.f, 0.f, 0.f, 0.f, 0.f, 0.f, 0.f, 0.f, 0.f, 0.f, 0.f, 0.f, 0.f};
#pragma unroll
    for (int s = 0; s < 8; ++s) p = __builtin_amdgcn_mfma_f32_32x32x16_bf16(sa_kfrag(rowp, s, hi), qf[s], p, 0, 0, 0);
    return p;
}
__device__ __forceinline__ void sa_pv(f32x16 (&o)[4], const f32x16& e, const STile& T, int l31, int hi) {
#pragma unroll
    for (int ks = 0; ks < 2; ++ks) {
        u32x4 w; w.x = cvtpk(e[8 * ks + 0], e[8 * ks + 1]); w.y = cvtpk(e[8 * ks + 2], e[8 * ks + 3]); w.z = cvtpk(e[8 * ks + 4], e[8 * ks + 5]); w.w = cvtpk(e[8 * ks + 6], e[8 * ks + 7]);
        const bf16x8 pf = __builtin_bit_cast(bf16x8, w);
        const float* rp[8];
#pragma unroll
        for (int j = 0; j < 8; ++j) { int key = 16 * ks + 8 * (j >> 2) + 4 * hi + (j & 3); key = key < T.kmax ? key : T.kmax; rp[j] = T.vp + (size_t)key * T.stride + l31; }
#pragma unroll
        for (int dt = 0; dt < 4; ++dt) {
            float v[8];
#pragma unroll
            for (int j = 0; j < 8; ++j) v[j] = rp[j][32 * dt];
            u32x4 x; x.x = cvtpk(v[0], v[1]); x.y = cvtpk(v[2], v[3]); x.z = cvtpk(v[4], v[5]); x.w = cvtpk(v[6], v[7]);
            o[dt] = __builtin_amdgcn_mfma_f32_32x32x16_bf16(pf, __builtin_bit_cast(bf16x8, x), o[dt], 0, 0, 0);
        }
    }
}
template <int BR> __device__ __forceinline__ float sa_exp(f32x16& p, int k0, int hi, int qoff, const LAS float* bias_g, bool keep) {
    float sum = 0.f;
#pragma unroll
    for (int r = 0; r < 16; ++r) {
        const int kidx = k0 + crow(r, hi); const int rel = (BR == 0) ? qoff - (16 * kidx + 31) : qoff - kidx;
        const bool ok = rel >= 0 && (BR != 2 || rel < 512) && keep; const int ix = rel < 0 ? 0 : (rel > 128 ? 128 : rel);
        const float e = ok ? __builtin_amdgcn_exp2f(p[r] + bias_g[ix]) : 0.f; p[r] = e; sum += e;
    }
    return sum;
}
__device__ __forceinline__ void sa_reduce_store(f32x16 (&o)[4], float lsum, float* part_br, LAS unsigned char* lds, int wave, int lane, bool zero_it) {
    const int l31 = lane & 31, hi = lane >> 5, tid = wave * 64 + lane;
    LAS float* ob = (LAS float*)lds;
    LAS float* lx = (LAS float*)(lds + AL_LX);
    lsum += __shfl_xor(lsum, 32);
    if (hi == 0) lx[wave * 32 + l31] = lsum;
#pragma unroll
    for (int dt = 0; dt < 4; ++dt)
#pragma unroll
        for (int r = 0; r < 16; ++r) ob[(wave * 32 + crow(r, hi)) * 128 + 32 * dt + l31] = o[dt][r];
    AT_BAR();
    for (int u = tid; u < 32 * 128; u += NTHR) { float s = 0.f;
#pragma unroll
        for (int w = 0; w < 8; ++w) s += ob[w * 4096 + u];
        part_br[(u >> 7) * 132 + (u & 127)] = zero_it ? 0.f : s; }
    if (tid < 32) { float s = 0.f;
#pragma unroll
        for (int w = 0; w < 8; ++w) s += lx[w * 32 + tid];
        part_br[tid * 132 + 128] = zero_it ? 0.f : s; }
    AT_BAR();
}

__device__ __forceinline__ void attn_sample_unit(const SAttnP& P0, int b, int kv, int part, LAS unsigned char* lds, int wave, int lane) {
    SAttnP P = P0;
    asm volatile("" : "+s"(P.QBr), "+s"(P.qn_g), "+s"(P.gates), "+s"(P.relb), "+s"(P.KCS), "+s"(P.VCS), "+s"(P.cache_sel));
    asm volatile("" : "+s"(P.cache_win), "+s"(P.pt), "+s"(P.selnew), "+s"(P.winkv), "+s"(P.PART));
    const int l31 = lane & 31, hi = lane >> 5, tid = wave * 64 + lane;
    const int t = l31 >> 2, g = l31 & 3, head = kv * 4 + g, qpos = PAST + t;
    const size_t row = (size_t)MP + b * TS + t;
    LAS float* biasT = (LAS float*)(lds + AL_BIAS); LAS float* lx = (LAS float*)(lds + AL_LX); LAS float* imp = (LAS float*)(lds + SA_IMP);
    LAS int* ulist = (LAS int*)(lds + SA_UL); LAS unsigned* smw = (LAS unsigned*)(lds + SA_SM);
    for (int u = tid; u < 4 * 129; u += NTHR) { const int gg = u / 129, r = u % 129; biasT[gg * 132 + r] = P.relb[rel_bucket(r) * 8 + kv * 4 + gg] * LOG2E; }
    bf16x8 qf[8];
    load_q_frags(qf, P.QBr + row * LQ + head * 128, P.qn_g, hi);
    const LAS float* bias_g = biasT + g * 132;
    float* pbuf = P.PART + (((size_t)b * 2 + kv) * 4 + part) * (3 * 32 * 132);
    f32x16 o[4];
#pragma unroll
    for (int dt = 0; dt < 4; ++dt) o[dt] = (f32x16){0.f, 0.f, 0.f, 0.f, 0.f, 0.f, 0.f, 0.f, 0.f, 0.f, 0.f, 0.f, 0.f, 0.f, 0.f, 0.f};
    AT_BAR();
    {
        float lsum = 0.f;
#pragma unroll 1
        for (int u = 2 * wave; u < 2 * wave + 2; ++u) {
            STile T; T.kp = P.KCS + (((size_t)b * 512 + 32 * u) * 2 + kv) * 128; T.vp = nullptr; T.stride = 256; T.kmax = 31; T.k0 = 32 * u;
            f32x16 sc = sa_qk(T, qf, l31, hi); lsum += sa_exp<0>(sc, T.k0, hi, qpos, bias_g, true);
        }
        lsum += __shfl_xor(lsum, 32);
        if (hi == 0) lx[wave * 32 + l31] = lsum;
        AT_BAR();
        float ltot = 0.f;
#pragma unroll
        for (int w = 0; w < 8; ++w) ltot += lx[w * 32 + l31];
        const float inv = 1.0f / fmaxf(ltot, 1e-30f);
        float lkeep = 0.f;
#pragma unroll 1
        for (int u = 2 * wave; u < 2 * wave + 2; ++u) {
            STile T; T.kp = P.KCS + (((size_t)b * 512 + 32 * u) * 2 + kv) * 128; T.vp = P.VCS + (((size_t)b * 512 + 32 * u) * 2 + kv) * 128; T.stride = 256; T.kmax = 31; T.k0 = 32 * u;
            f32x16 sc = sa_qk(T, qf, l31, hi); lkeep += sa_exp<0>(sc, T.k0, hi, qpos, bias_g, true);
#pragma unroll
            for (int r = 0; r < 16; ++r) { const float pn = sc[r] * inv; float v = pn + __shfl_xor(pn, 1); v += __shfl_xor(v, 2); if (g == 0) imp[t * 512 + T.k0 + crow(r, hi)] = v; }
            if (part == 0) sa_pv(o, sc, T, l31, hi);
        }
        AT_BAR();
        sa_reduce_store(o, lkeep, pbuf + 0 * (32 * 132), lds, wave, lane, part != 0);
#pragma unroll
        for (int dt = 0; dt < 4; ++dt) o[dt] = (f32x16){0.f, 0.f, 0.f, 0.f, 0.f, 0.f, 0.f, 0.f, 0.f, 0.f, 0.f, 0.f, 0.f, 0.f, 0.f, 0.f};
        {
            const int tk = wave; float sc3[3];
#pragma unroll
            for (int j = 0; j < 3; ++j) { const int s = lane + 64 * j; float v = -INFINITY;
                if (s <= 128) { float a = 0.f; const LAS float* ip = imp + tk * 512 + 4 * s; asm volatile("" : "+v"(ip));
#pragma unroll
                    for (int c = -1; c <= 3; ++c) if (4 * s + c >= 0 && 4 * s + c < 512) a += ip[c];
                    const bool forced = (s == 0) || (s == 128) || (s == 127); v = a + (forced ? 1.0e6f : 0.f); }
                sc3[j] = v; }
            int rk[3] = {0, 0, 0};
#pragma unroll 1
            for (int tt = 0; tt < 129; ++tt) { const float u = __shfl(tt < 64 ? sc3[0] : (tt < 128 ? sc3[1] : sc3[2]), tt & 63);
#pragma unroll
                for (int j = 0; j < 3; ++j) { const int s = lane + 64 * j; rk[j] += (u > sc3[j] || (u == sc3[j] && tt < s)) ? 1 : 0; } }
            const unsigned long long m0 = __ballot(rk[0] < 16), m1 = __ballot(rk[1] < 16), m2 = __ballot(rk[2] < 16 && lane == 0);
            if (lane == 0) { smw[tk * 5] = (unsigned)m0; smw[tk * 5 + 1] = (unsigned)(m0 >> 32); smw[tk * 5 + 2] = (unsigned)m1; smw[tk * 5 + 3] = (unsigned)(m1 >> 32); smw[tk * 5 + 4] = (unsigned)(m2 & 1ull); }
        }
        AT_BAR();
    }
    const unsigned long long s0 = ((unsigned long long)smw[t * 5 + 1] << 32) | smw[t * 5], s1 = ((unsigned long long)smw[t * 5 + 3] << 32) | smw[t * 5 + 2]; const unsigned s2 = smw[t * 5 + 4];
    int nblk;
    {
        unsigned long long u0 = 0ull, u1 = 0ull; unsigned u2 = 0u;
#pragma unroll
        for (int k = 0; k < 8; ++k) { u0 |= ((unsigned long long)smw[k * 5 + 1] << 32) | smw[k * 5]; u1 |= ((unsigned long long)smw[k * 5 + 3] << 32) | smw[k * 5 + 2]; u2 |= smw[k * 5 + 4]; }
        const int n0 = __popcll(u0), n1 = __popcll(u1); nblk = n0 + n1 + (int)(u2 & 1u);
        if (wave == 0) {
            const unsigned long long below = (lane == 0) ? 0ull : (~0ull >> (64 - lane));
            if ((u0 >> lane) & 1ull) ulist[__popcll(u0 & below)] = lane;
            if ((u1 >> lane) & 1ull) ulist[n0 + __popcll(u1 & below)] = 64 + lane;
            if (lane == 0 && (u2 & 1u)) ulist[n0 + n1] = 128;
        }
    }
    AT_BAR();
    {
        float lsum = 0.f; const int nmine = (nblk - part + 3) >> 2;
#pragma unroll 1
        for (int it = wave; it < 2 * nmine; it += 8) {
            const int s = ulist[part + 4 * (it >> 1)], sub = it & 1;
            if (s == 128 && sub == 1) continue;
            STile T;
            if (s < 128) { const size_t pg = (size_t)P.pt[b * NPAGE + (s >> 1)] * PAGE + (s & 1) * 64 + sub * 32; T.kp = P.cache_sel + pg * 512 + kv * 128; T.vp = T.kp + 256; T.stride = 512; T.kmax = 31; }
            else { T.kp = P.selnew + (size_t)b * TS * 512 + kv * 128; T.vp = T.kp + 256; T.stride = 512; T.kmax = 7; }
            T.k0 = 64 * s + 32 * sub;
            const bool keep = (s < 64) ? (((s0 >> s) & 1ull) != 0ull) : (s < 128 ? (((s1 >> (s - 64)) & 1ull) != 0ull) : ((s2 & 1u) != 0u));
            f32x16 sc = sa_qk(T, qf, l31, hi); lsum += sa_exp<1>(sc, T.k0, hi, qpos, bias_g, keep);
            sa_pv(o, sc, T, l31, hi);
        }
        sa_reduce_store(o, lsum, pbuf + 1 * (32 * 132), lds, wave, lane, false);
#pragma unroll
        for (int dt = 0; dt < 4; ++dt) o[dt] = (f32x16){0.f, 0.f, 0.f, 0.f, 0.f, 0.f, 0.f, 0.f, 0.f, 0.f, 0.f, 0.f, 0.f, 0.f, 0.f, 0.f};
    }
    {
        float lsum = 0.f;
#pragma unroll 1
        for (int u = part + 4 * wave; u < 17; u += 32) {
            STile T;
            if (u < 16) { T.kp = P.cache_win + ((size_t)b * 512 + 32 * u) * 512 + kv * 128; T.vp = T.kp + 256; T.stride = 512; T.kmax = 31; }
            else { T.kp = P.winkv + ((size_t)MP + b * TS) * 512 + kv * 128; T.vp = T.kp + 256; T.stride = 512; T.kmax = 7; }
            T.k0 = 32 * u;
            f32x16 sc = sa_qk(T, qf, l31, hi); lsum += sa_exp<2>(sc, T.k0, hi, 512 + t, bias_g, true);
            sa_pv(o, sc, T, l31, hi);
        }
        sa_reduce_store(o, lsum, pbuf + 2 * (32 * 132), lds, wave, lane, false);
    }
}
__device__ __forceinline__ void attn_sample_combine(const float* PART, const float* gates, bf16* OB, int idx  , int lane) {
    const int rl = idx >> 3, head = idx & 7, b = rl >> 3, t = rl & 7, kv = head >> 2, g = head & 3, r = t * 4 + g;
    const float* base = PART + ((size_t)b * 2 + kv) * 4 * (3 * 32 * 132);
    float acc0 = 0.f, acc1 = 0.f;
#pragma unroll
    for (int br = 0; br < 3; ++br) {
        float l = 0.f, a0 = 0.f, a1 = 0.f;
#pragma unroll
        for (int p = 0; p < 4; ++p) { const float* q = base + ((size_t)p * 3 + br) * (32 * 132) + r * 132; l += q[128]; a0 += q[lane]; a1 += q[lane + 64]; }
        const float f = gates[((size_t)MP + rl) * 24 + head * 3 + br] / fmaxf(l, 1e-30f); acc0 += f * a0; acc1 += f * a1;
    }
    OB[((size_t)MP + rl) * 1024 + head * 128 + lane] = f2bf(acc0); OB[((size_t)MP + rl) * 1024 + head * 128 + lane + 64] = f2bf(acc1);
}

constexpr size_t al256(size_t x) { return (x + 255) & ~(size_t)255; }
constexpr size_t WS_BAR = 0;
constexpr size_t WS_WT_IN = al256(WS_BAR + XCD_BAR_WORDS * 4);
constexpr size_t WS_WT_BA = al256(WS_WT_IN + (size_t)NPROJ * D * 2);
constexpr size_t WS_WT_BB = al256(WS_WT_BA + (size_t)D * 1024 * 2);
constexpr size_t WS_WT_OUT = al256(WS_WT_BB + (size_t)D * 1024 * 2);
constexpr size_t WS_WT_1 = al256(WS_WT_OUT + (size_t)D * D * 2);
constexpr size_t WS_WT_2 = al256(WS_WT_1 + (size_t)DFF * D * 2);
constexpr size_t WS_MODS = al256(WS_WT_2 + (size_t)D * DFF * 2);
constexpr size_t WS_H = al256(WS_MODS + (size_t)34 * NMOD * 4);
constexpr size_t WS_PROJ = al256(WS_H + (size_t)MT * D * 2);
constexpr size_t WS_WINKV = al256(WS_PROJ + (size_t)0);
constexpr size_t WS_QN = al256(WS_WINKV + (size_t)MT * 512 * 4);
constexpr size_t WS_F = al256(WS_QN + (size_t)0);
constexpr size_t WS_ORAW = al256(WS_F + (size_t)MT * LQ * 4);
constexpr size_t WS_OA = al256(WS_ORAW + (size_t)MT * 1024 * 4);
constexpr size_t WS_OB = al256(WS_OA + (size_t)MT * 1024 * 2);
constexpr size_t WS_KCP = al256(WS_OB + (size_t)MT * 1024 * 2);
constexpr size_t WS_VCP = al256(WS_KCP + (size_t)0);
constexpr size_t WS_KCS = al256(WS_VCP + (size_t)0);
constexpr size_t WS_VCS = al256(WS_KCS + (size_t)32 * 512 * 256 * 4);
constexpr size_t WS_PCMP = al256(WS_VCS + (size_t)32 * 512 * 256 * 4);
constexpr size_t WS_IDX = al256(WS_PCMP + (size_t)0);
constexpr size_t WS_OCMP = al256(WS_IDX + (size_t)0);
constexpr size_t WS_OSEL = al256(WS_OCMP + (size_t)0);
constexpr size_t WS_OWIN = al256(WS_OSEL + (size_t)0);
constexpr size_t WS_T = al256(WS_OWIN + (size_t)0);
constexpr size_t WS_MERGED = al256(WS_T + (size_t)MT * D * 4);
constexpr size_t WS_X1 = al256(WS_MERGED + (size_t)MT * D * 2);
constexpr size_t WS_U = al256(WS_X1 + (size_t)MT * D * 4);
constexpr size_t WS_QNB = al256(WS_U + (size_t)MT * DFF * 2);
constexpr size_t WS_GATES = al256(WS_QNB + (size_t)0);
constexpr size_t WS_KSF = al256(WS_GATES + (size_t)MT * 24 * 4);
constexpr size_t WS_VSF = al256(WS_KSF + (size_t)4 * 128 * 4096 * 2);
constexpr size_t WS_KWF = al256(WS_VSF + (size_t)4 * 128 * 4096 * 2);
constexpr size_t WS_VWF = al256(WS_KWF + (size_t)4 * 128 * 4096 * 2);
constexpr size_t WS_KCF = al256(WS_VWF + (size_t)4 * 128 * 4096 * 2);
constexpr size_t WS_VCF = al256(WS_KCF + (size_t)4 * 8 * 4096 * 2);
constexpr size_t WS_OT = al256(WS_VCF + (size_t)4 * 8 * 4096 * 2);
constexpr size_t WS_IMP = al256(WS_OT + (size_t)0);
constexpr size_t WS_XHC = al256(WS_IMP + (size_t)0);
constexpr size_t WS_XHP = al256(WS_XHC + (size_t)256 * 256 * 2048 * 2);
constexpr size_t WS_WC1T = al256(WS_XHP + (size_t)2 * XHP_ROWS * 2048 * 2);
constexpr size_t WS_PREC = al256(WS_WC1T + (size_t)512 * 2048 * 2);
constexpr size_t WS_PREP = al256(WS_PREC + (size_t)2 * XHC_ROWS * 256 * 4);
constexpr size_t WS_HQS = al256(WS_PREP + (size_t)2 * XHP_ROWS * 256 * 4);
constexpr size_t WS_HOI = al256(WS_HQS + (size_t)MP * 1024 * 2);
constexpr size_t WS_HLB = al256(WS_HOI + (size_t)MP * 1024 * 4);
constexpr size_t WS_HDEC = al256(WS_HLB + (size_t)1024 * 16384 * 4);
constexpr size_t WS_HSPT = al256(WS_HDEC + (size_t)1024 * 128 * 4);
constexpr size_t WS_PART = al256(WS_HSPT + (size_t)1024 * 16384 * 2);
constexpr size_t WS_SLAB = al256(WS_PART + (size_t)64 * 4 * 3 * 32 * 132 * 4);
constexpr size_t WS_MODP = al256(WS_SLAB + (size_t)16 * 256 * 2048 * 4);
constexpr size_t WS_QAB = al256(WS_MODP + (size_t)8 * 34 * NMOD * 4);
constexpr size_t WS_IAB = al256(WS_QAB + (size_t)MT * LQ * 2);
constexpr size_t WS_GAS = al256(WS_IAB + (size_t)MT * LQ * 2);
constexpr size_t WS_QBR = al256(WS_GAS + (size_t)MT * LQ * 2);
constexpr size_t WS_MGAB = al256(WS_QBR + (size_t)MT * LQ * 4);
constexpr size_t WS_MGBB = al256(WS_MGAB + (size_t)MT * LMG * 2);
constexpr size_t WS_W2T = al256(WS_MGBB + (size_t)MT * LMG * 2);
constexpr size_t WS_END = al256(WS_W2T + (size_t)2 * 16384 * 2);

struct Args { const void* in[32]; float* out; unsigned char* ws; int ph_lo, ph_hi; };

#define G_x_p ((const float*)a.in[0])
#define G_x_s ((const float*)a.in[1])
#define G_c_p ((const float*)a.in[2])
#define G_c_s ((const float*)a.in[3])
#define G_cache_cmp ((const float*)a.in[4])
#define G_cache_sel ((const float*)a.in[5])
#define G_cache_win ((const float*)a.in[6])
#define G_state ((const float*)a.in[7])
#define G_pt ((const int*)a.in[8])
#define G_lbl ((const float*)a.in[9])
#define G_relb ((const float*)a.in[10])
#define G_ada_w ((const float*)a.in[11])
#define G_ada_b ((const float*)a.in[12])
#define G_norm1 ((const float*)a.in[13])
#define G_norm2 ((const float*)a.in[14])
#define G_w_in ((const float*)a.in[15])
#define G_onorm ((const float*)a.in[16])
#define G_qn_g ((const float*)a.in[17])
#define G_ks_g ((const float*)a.in[19])
#define G_kw_g ((const float*)a.in[20])
#define G_w_ba ((const float*)a.in[27])
#define G_w_bb ((const float*)a.in[28])
#define G_w_out ((const float*)a.in[29])
#define G_w1 ((const float*)a.in[30])
#define G_w2 ((const float*)a.in[31])
#define G_Wt_in ((bf16*)(a.ws + WS_WT_IN))
#define G_Wt_ba ((bf16*)(a.ws + WS_WT_BA))
#define G_Wt_bb ((bf16*)(a.ws + WS_WT_BB))
#define G_Wt_out ((bf16*)(a.ws + WS_WT_OUT))
#define G_Wt_1 ((bf16*)(a.ws + WS_WT_1))
#define G_Wt_2 ((bf16*)(a.ws + WS_WT_2))
#define G_mods ((float*)(a.ws + WS_MODS))
#define G_H ((bf16*)(a.ws + WS_H))
#define G_proj ((float*)(a.ws + WS_PROJ))
#define G_winkv ((float*)(a.ws + WS_WINKV))
#define G_QN ((float*)(a.ws + WS_QN))
#define G_F ((float*)(a.ws + WS_F))
#define G_oraw ((float*)(a.ws + WS_ORAW))
#define G_OA ((bf16*)(a.ws + WS_OA))
#define G_OB ((bf16*)(a.ws + WS_OB))
#define G_KCP ((float*)(a.ws + WS_KCP))
#define G_VCP ((float*)(a.ws + WS_VCP))
#define G_KCS ((float*)(a.ws + WS_KCS))
#define G_VCS ((float*)(a.ws + WS_VCS))
#define G_PCMP ((float*)(a.ws + WS_PCMP))
#define G_IDX ((int*)(a.ws + WS_IDX))
#define G_OCMP ((float*)(a.ws + WS_OCMP))
#define G_OSEL ((float*)(a.ws + WS_OSEL))
#define G_OWIN ((float*)(a.ws + WS_OWIN))
#define G_QNb ((bf16*)(a.ws + WS_QNB))
#define G_GATES ((float*)(a.ws + WS_GATES))
#define G_KSf ((bf16*)(a.ws + WS_KSF))
#define G_VSf ((bf16*)(a.ws + WS_VSF))
#define G_KWf ((bf16*)(a.ws + WS_KWF))
#define G_VWf ((bf16*)(a.ws + WS_VWF))
#define G_KCf ((bf16*)(a.ws + WS_KCF))
#define G_VCf ((bf16*)(a.ws + WS_VCF))
#define G_T ((float*)(a.ws + WS_T))
#define G_MERGED ((bf16*)(a.ws + WS_MERGED))
#define G_X1 ((float*)(a.ws + WS_X1))
#define G_U ((bf16*)(a.ws + WS_U))
#define G_XHC ((bf16*)(a.ws + WS_XHC))
#define G_XHP ((bf16*)(a.ws + WS_XHP))
#define G_Wc1t ((bf16*)(a.ws + WS_WC1T))
#define G_PREC ((float*)(a.ws + WS_PREC))
#define G_PREP ((float*)(a.ws + WS_PREP))
#define G_out (a.out)
#define G_ws (a.ws)
#define lane ((int)__builtin_amdgcn_mbcnt_hi(~0u, __builtin_amdgcn_mbcnt_lo(~0u, 0u)))
#define wave (wave_s)
#define tid (wave_s * 64 + lane)
#define sub2 (wave_s >> 2)
#define lt2 ((wave_s & 3) * 64 + lane)
#define sub4 (wave_s >> 1)
#define lt4 ((wave_s & 1) * 64 + lane)
__global__ void __launch_bounds__(NTHR, 2) mk_fwd(Args a) {
    extern __shared__ __attribute__((aligned(16))) unsigned char lds[];
    const int G = gridDim.x, bid = blockIdx.x;
    const int wave_s = __builtin_amdgcn_readfirstlane((int)threadIdx.x >> 6);
    if (threadIdx.x < 4) ((unsigned*)(lds + LDS_CTL))[threadIdx.x] = 0u;
    __syncthreads();
    const int lo = a.ph_lo, hi = a.ph_hi;
    XcdBarrier bar; bar.bar = (unsigned*)(G_ws + WS_BAR); bar.x = 0; bar.st = nullptr;
    if (hi - lo > 1) bar = xcd_barrier_post((unsigned*)(G_ws + WS_BAR), (volatile LAS unsigned*)(lds + LDS_CTL), wave_s);
#define IN(k) (lo <= (k) && (k) < hi)
#define MK_HGP() HgP hp; hp.QAb = (const bf16*)(G_ws + WS_QAB); hp.IAb = (const bf16*)(G_ws + WS_IAB); hp.GAs = (const bf16*)(G_ws + WS_GAS); hp.F = G_F; hp.QS = (bf16*)(G_ws + WS_HQS); hp.OI = (float*)(G_ws + WS_HOI); hp.Lb = (float*)(G_ws + WS_HLB); hp.DEC = (float*)(G_ws + WS_HDEC); hp.SPT = (bf16*)(G_ws + WS_HSPT)
#define SEAM(k) do { if (IN(k) && IN((k) + 1)) xcd_barrier(bar, wave_s); } while (0)
    float* ldsf = (float*)lds;

    if (IN(PH_PRO)) {
        constexpr int T_IN = (NPROJ / 128) * (D / 128), T_BA = (D / 128) * (1024 / 128), T_OUT = (D / 128) * (D / 128), T_1 = (DFF / 128) * (D / 128), T_2 = (D / 128) * (DFF / 128), T_C = 4 * 16;
        constexpr int NT = T_IN + 2 * T_BA + T_OUT + T_1 + T_2 + T_C + 2;
        for (int it = bid; it < NT; it += G) {
            int r = it;
            if (r < T_IN) { const int nb = r % (NPROJ / 128), kb = r / (NPROJ / 128), n0 = nb * 128; const int c0 = win_col(n0); const int lim = n0 < C_GATE ? 128 : (n0 == C_GATE ? 24 : 0);
                b_transpose128(G_w_in, IN_COLS, c0 < 0 ? 0 : c0, lim, G_Wt_in, D, n0, kb * 128, tid, ldsf); continue; } r -= T_IN;
            if (r < T_BA) { b_transpose128(G_w_ba, D, (r % 16) * 128, 128, G_Wt_ba, 1024, (r % 16) * 128, (r / 16) * 128, tid, ldsf); continue; } r -= T_BA;
            if (r < T_BA) { b_transpose128(G_w_bb, D, (r % 16) * 128, 128, G_Wt_bb, 1024, (r % 16) * 128, (r / 16) * 128, tid, ldsf); continue; } r -= T_BA;
            if (r < T_OUT) { b_transpose128(G_w_out, D, (r % 16) * 128, 128, G_Wt_out, D, (r % 16) * 128, (r / 16) * 128, tid, ldsf); continue; } r -= T_OUT;
            if (r < T_1) { b_transpose128(G_w1, DFF, (r % 64) * 128, 128, G_Wt_1, D, (r % 64) * 128, (r / 64) * 128, tid, ldsf); continue; } r -= T_1;
            if (r < T_2) { b_transpose128(G_w2, D, (r % 16) * 128, 128, G_Wt_2, DFF, (r % 16) * 128, (r / 16) * 128, tid, ldsf); continue; } r -= T_2;
            if (r >= T_C) { const int w = r - T_C; b_transpose128(w ? (const float*)a.in[26] : (const float*)a.in[23], 128, 0, 128, (bf16*)(G_ws + WS_W2T) + (size_t)w * 16384, 128, 0, 0, tid, ldsf); continue; }
            { const int wh = r >> 4, kb = r & 15;
              b_transpose128((wh >> 1 ? (const float*)a.in[24] : (const float*)a.in[21]) + (size_t)(wh & 1) * 2048 * 128, 128, 0, 128, G_Wc1t + (size_t)wh * 128 * 2048, 2048, 0, kb * 128, tid, ldsf); }
        }
        for (size_t u = (size_t)bid * NTHR + tid; u < (size_t)2 * 4 * 8 * 4096 / 8; u += (size_t)G * NTHR) { bf16* z = u < (size_t)4 * 8 * 4096 / 8 ? G_KCf + u * 8 : G_VCf + (u - (size_t)4 * 8 * 4096 / 8) * 8; *(u32x4*)z = (u32x4){0u, 0u, 0u, 0u}; }
        for (size_t u = (size_t)bid * NTHR + tid; u < (size_t)2 * 256 * 2048 / 8; u += (size_t)G * NTHR) { const size_t w = u / (256 * 256), r = u % (256 * 256); *(u32x4*)(G_XHP + ((size_t)w * XHP_ROWS + 1024) * 2048 + r * 8) = (u32x4){0u, 0u, 0u, 0u}; }
        for (int it = G - 1 - bid; it < 192; it += G) b_mods_part(G_c_p, G_c_s, G_ada_w, (float*)(G_ws + WS_MODP), it % 24, it / 24, tid, ldsf);
    }
    SEAM(PH_PRO);
    if (IN(PH_MRED)) { const float* mp = (const float*)(G_ws + WS_MODP);
        for (int u = bid * NTHR + tid; u < 34 * NMOD; u += G * NTHR) { float s = G_ada_b[u % NMOD];
#pragma unroll
            for (int kc = 0; kc < 8; ++kc) s += mp[(size_t)kc * 34 * NMOD + u];
            G_mods[u] = s; } }
    SEAM(PH_MRED);
    if (IN(PH_NORM1)) { for (int row = bid * 2 + sub2; row < MT; row += G * 2) b_hnorm(G_x_p, G_x_s, G_norm1, G_mods, 0, 1, G_H, row, lt2, ldsf + sub2 * 4); }
    SEAM(PH_NORM1);
    if (IN(PH_INPROJ)) {
        pg8::Gemm g{G_H, G_Wt_in, MT, NPROJ, D, D, nullptr, nullptr};
        EpiInProj E; E.o.QAb = (bf16*)(G_ws + WS_QAB); E.o.F = G_F; E.o.IAb = (bf16*)(G_ws + WS_IAB); E.o.GAs = (bf16*)(G_ws + WS_GAS); E.o.QBr = (float*)(G_ws + WS_QBR); E.o.out = G_out; E.o.XHP = G_XHP; E.o.WINKV = G_winkv;
        E.o.MGAb = (bf16*)(G_ws + WS_MGAB); E.o.MGBb = (bf16*)(G_ws + WS_MGBB); E.o.GATES = G_GATES; E.o.lbl = G_lbl;
        const int ksplit = (bid >> 3) % 6;
        { RangeOrder<pg8::StaticOrder> S; S.B.init(MT, NPROJ, G, bid, D); S.i0 = 0; S.i1 = ksplit;
          pg8::gemm_phase<EpiInProj, RangeOrder<pg8::StaticOrder>, false>((PG8_LAS unsigned char*)lds, g, S, E, nullptr, wave_s); }
        { bf16* panel = G_XHC + (size_t)bid * 256 * 2048; const int L = bid;
          __syncthreads();
          b_xhc_panel(G_cache_cmp, G_pt, panel, L, tid);
          __syncthreads();
          pg8::Gemm gc{panel, G_Wc1t, 256, 512, 2048, 2048, nullptr, nullptr}; OneOrder S; S.pn = L >> 7; EpiGen<FStorePre> Ec; Ec.f.C = G_PREC; Ec.f.rowoff = L * 256; Ec.f.pad = 0; Ec.slab = nullptr; Ec.slab_n = 0; Ec.kslice = 1;
          pg8::gemm_phase<EpiGen<FStorePre>, OneOrder, false>((PG8_LAS unsigned char*)lds, gc, S, Ec, nullptr, wave_s); }
        { RangeOrder<pg8::StaticOrder> S; S.B.init(MT, NPROJ, G, bid, D); S.i0 = ksplit; S.i1 = 1 << 20;
          pg8::gemm_phase<EpiInProj, RangeOrder<pg8::StaticOrder>, false>((PG8_LAS unsigned char*)lds, g, S, E, nullptr, wave_s); }
    }
    SEAM(PH_INPROJ);
    if (IN(PH_MIX1)) {
        for (int x = 16 + bid * 4 + sub4; x < 16 + 256; x += G * 4) b_hgrn_seq((const bf16*)(G_ws + WS_QAB), (const bf16*)(G_ws + WS_IAB), G_F, G_state, G_oraw, G_out, x, lt4);
        const int NW = G - 10;
        if (bid < NW) for (int it = NW - 1 - bid; it < 1024; it += NW) { const int which = it >> 9, r = it & 511, b = r >> 8, kv = (r >> 7) & 1, Tt = r & 127; const size_t to = (((size_t)b * 2 + kv) * 128 + Tt) * 4096;
            float* wout = (which == 1 && Tt >= 112) ? G_out + O_WINP + ((size_t)b * 512 + 32 * (Tt - 112)) * 512 : nullptr;
            prep_kv_tile(which == 0 ? G_out + O_SELP : G_winkv, which == 0 ? G_ks_g : G_kw_g, (which == 0 ? G_KSf : G_KWf) + to, (which == 0 ? G_VSf : G_VWf) + to, wout, b, kv, Tt, tid, ldsf + 20480); }
        for (int it = bid; it < 32; it += G) prep_kv_sample(G_out, G_winkv, G_ks_g, G_kw_g, it * 32 + (tid >> 4), tid & 15);
        { const size_t n = (size_t)BS * 504 * 512 / 4;
          for (size_t i = (size_t)bid * NTHR + tid; i < n; i += (size_t)G * NTHR) { const size_t b = i / (504 * 128), r = i % (504 * 128); *(f32x4*)(G_out + O_WINS + b * 512 * 512 + r * 4) = *(const f32x4*)(G_cache_win + b * 512 * 512 + 8 * 512 + r * 4); } }
        { MK_HGP();
          if (bid < NW)
#pragma unroll 1
          for (int item = bid; item < 1024; item += NW) hgrn_local(hp, item, (LAS unsigned char*)lds, tid); }
        { pg8::Gemm g{G_XHP, G_Wc1t, 2 * XHP_ROWS, 512, 2048, 2048, nullptr, nullptr}; DiagOrder S; S.n = 10; S.per = 5; S.G = G; S.c = G - 1 - bid; EpiGen<FStorePre> E; E.f.C = G_PREP; E.f.rowoff = 0; E.f.pad = 0; E.slab = nullptr; E.slab_n = 0; E.kslice = 1;
          __syncthreads();
          pg8::gemm_phase<EpiGen<FStorePre>, DiagOrder, false>((PG8_LAS unsigned char*)lds, g, S, E, nullptr, wave_s); }
    }
    SEAM(PH_MIX1);
    if (IN(PH_CFIN)) {
        CmpW cw; cw.kw1 = (const float*)a.in[21]; cw.kb1 = (const float*)a.in[22]; cw.kw2 = (const float*)a.in[23]; cw.vw1 = (const float*)a.in[24]; cw.vb1 = (const float*)a.in[25]; cw.vw2 = (const float*)a.in[26]; cw.kc_g = (const float*)a.in[18];
        { MK_HGP();
          const int bh = bid >> 4, k = (bid & 15) * 8 + wave;
#pragma unroll 1
          for (int e = 0; e < 2; ++e) hgrn_carry(hp, G_out + O_HGP, bh, k, lane + 64 * e); }
        for (int item = bid * 8 + wave; item < 64 + 2048; item += G * 8) b_cfin_mfma(G_PREC, G_PREP, (const bf16*)(G_ws + WS_W2T), cw, G_KCf, G_VCf, G_KCS, G_VCS, item, lane);
    }
    SEAM(PH_CFIN);
    if (IN(PH_ATTN)) {
        for (int row = MP + bid * 2 + sub2; row < MT; row += G * 2) b_hgrn_out(G_oraw, (const bf16*)(G_ws + WS_GAS), G_onorm, G_OA, row, lt2);
        { MK_HGP();
#pragma unroll 1
          for (int item = bid; item < 1024; item += G) hgrn_output(hp, G_onorm, G_OA, item, (LAS unsigned char*)lds, tid); }
        AttnP P; P.QBr = (const float*)(G_ws + WS_QBR); P.qn_g = G_qn_g; P.KSf = G_KSf; P.VSf = G_VSf; P.KWf = G_KWf; P.VWf = G_VWf; P.KCf = G_KCf; P.VCf = G_VCf; P.gates = G_GATES; P.relb = G_relb; P.OB = G_OB; P.OT = (float*)(G_ws + WS_OT); P.IMP = (float*)(G_ws + WS_IMP);
#pragma unroll 1
        for (int k = 0; k < 2; ++k) { const int u = bid, bk = u & 3, m = u >> 2; attn_prompt_unit(P, bk >> 1, bk & 1, k ? m : 127 - m, (LAS unsigned char*)lds, wave, lane); }
    }
    SEAM(PH_ATTN);
    if (IN(PH_SATTN)) {
        SAttnP P; P.QBr = (const float*)(G_ws + WS_QBR); P.qn_g = G_qn_g; P.gates = G_GATES; P.relb = G_relb; P.KCS = G_KCS; P.VCS = G_VCS; P.cache_sel = G_cache_sel; P.cache_win = G_cache_win; P.pt = G_pt; P.selnew = G_out + O_SELS; P.winkv = G_winkv; P.PART = (float*)(G_ws + WS_PART);
        { const int u = bid; attn_sample_unit(P, u >> 3, (u >> 2) & 1, u & 3, (LAS unsigned char*)lds, wave, lane); }
    }
    SEAM(PH_SATTN);
    if (IN(PH_SCOMB)) { for (int idx = bid * 8 + wave; idx < 2048; idx += G * 8) attn_sample_combine((const float*)(G_ws + WS_PART), G_GATES, G_OB, idx, lane); }
    SEAM(PH_SCOMB);
#define SLABP(off) ((float*)(G_ws + WS_SLAB) + (size_t)(off))
    if (IN(PH_BR)) { pg8::Gemm g{G_OA, G_Wt_ba, MT, D, 1024, 1024, G_OB, G_Wt_bb}; PairOrder S; S.init(D, 1024, 4, G, bid);
        EpiBranch E; E.mga = (const bf16*)(G_ws + WS_MGAB); E.mgb = (const bf16*)(G_ws + WS_MGBB); E.T = G_T; E.merged = G_MERGED; E.slab = SLABP(0); E.kslice = 256; E.pad = 0;
        pg8::gemm_phase<EpiBranch, PairOrder, false>((PG8_LAS unsigned char*)lds, g, S, E, nullptr, wave_s); }
    SEAM(PH_BR);
    if (IN(PH_RMERGE)) {
        const float* sa = SLABP(0); const float* sb = SLABP(4 * 256 * 2048);
        for (int u = bid * NTHR + tid; u < 256 * 512; u += G * NTHR) { const int r = u >> 9, c = (u & 511) * 4; f32x4 x = {0.f, 0.f, 0.f, 0.f}, y = x;
#pragma unroll
            for (int ks = 0; ks < 4; ++ks) { x += *(const f32x4*)(sa + ((size_t)ks * 256 + r) * 2048 + c); y += *(const f32x4*)(sb + ((size_t)ks * 256 + r) * 2048 + c); }
            const ushort4 ga = *(const ushort4*)((const bf16*)(G_ws + WS_MGAB) + ((size_t)MP + r) * LMG + c), gb = *(const ushort4*)((const bf16*)(G_ws + WS_MGBB) + ((size_t)MP + r) * LMG + c); ushort4 o;
            o.x = f2bf(bf2f(ga.x) * x[0] + bf2f(gb.x) * y[0]); o.y = f2bf(bf2f(ga.y) * x[1] + bf2f(gb.y) * y[1]); o.z = f2bf(bf2f(ga.z) * x[2] + bf2f(gb.z) * y[2]); o.w = f2bf(bf2f(ga.w) * x[3] + bf2f(gb.w) * y[3]);
            *(ushort4*)(G_MERGED + ((size_t)MP + r) * D + c) = o; }
    }
    SEAM(PH_RMERGE);
    if (IN(PH_OUT)) { pg8::Gemm g{G_MERGED, G_Wt_out, MT, D, D, D, nullptr, nullptr}; MixOrder S; S.init(D, D, 8, G, bid); EpiGen<FRes1> E; E.f.xp = G_x_p; E.f.xs = G_x_s; E.f.mods = G_mods; E.f.X1 = G_X1; E.slab = SLABP(0); E.slab_n = D; E.kslice = 256;
        pg8::gemm_phase<EpiGen<FRes1>, MixOrder, false>((PG8_LAS unsigned char*)lds, g, S, E, nullptr, wave_s); }
    SEAM(PH_OUT);
    if (IN(PH_NORM2)) {
        for (int row = MP + bid * 2 + sub2; row < MT; row += G * 2) b_norm2_sample(G_x_s, SLABP(0), G_norm2, G_mods, G_X1, G_H, row, lt2, ldsf + sub2 * 4);
        for (int row = bid * 2 + sub2; row < MP; row += G * 2) b_hnorm(G_X1, G_X1 + (size_t)MP * D, G_norm2, G_mods, 3, 4, G_H, row, lt2, ldsf + sub2 * 4);
    }
    SEAM(PH_NORM2);
    if (IN(PH_MLP1)) { pg8::Gemm g{G_H, G_Wt_1, MT, DFF, D, D, nullptr, nullptr}; MixOrder S; S.init(DFF, D, 4, G, bid); EpiGen<FRelu2> E; E.f.U = G_U; E.slab = SLABP(0); E.slab_n = DFF; E.kslice = 512;
        pg8::gemm_phase<EpiGen<FRelu2>, MixOrder, false>((PG8_LAS unsigned char*)lds, g, S, E, nullptr, wave_s); }
    SEAM(PH_MLP1);
    if (IN(PH_RU)) {
        const float* su = SLABP(0);
        for (int u = bid * NTHR + tid; u < 256 * 2048; u += G * NTHR) { const int r = u >> 11, c = (u & 2047) * 4; f32x4 x = {0.f, 0.f, 0.f, 0.f};
#pragma unroll
            for (int ks = 0; ks < 4; ++ks) x += *(const f32x4*)(su + ((size_t)ks * 256 + r) * DFF + c);
            ushort4 o; float t; t = fmaxf(x[0], 0.f); o.x = f2bf(t * t); t = fmaxf(x[1], 0.f); o.y = f2bf(t * t); t = fmaxf(x[2], 0.f); o.z = f2bf(t * t); t = fmaxf(x[3], 0.f); o.w = f2bf(t * t);
            *(ushort4*)(G_U + ((size_t)MP + r) * DFF + c) = o; }
    }
    SEAM(PH_RU);
    if (IN(PH_MLP2)) { pg8::Gemm g{G_U, G_Wt_2, MT, D, DFF, DFF, nullptr, nullptr}; MixOrder S; S.init(D, DFF, 16, G, bid); EpiGen<FRes2> E; E.f.X1 = G_X1; E.f.mods = G_mods; E.f.out = G_out; E.slab = SLABP(0); E.slab_n = D; E.kslice = 512;
        pg8::gemm_phase<EpiGen<FRes2>, MixOrder, false>((PG8_LAS unsigned char*)lds, g, S, E, nullptr, wave_s); }
    SEAM(PH_MLP2);
    if (IN(PH_RY)) {
        const float* sy = SLABP(0);
        for (int u = bid * NTHR + tid; u < 256 * 512; u += G * NTHR) { const int r = u >> 9, c = (u & 511) * 4; f32x4 x = {0.f, 0.f, 0.f, 0.f};
#pragma unroll
            for (int ks = 0; ks < 16; ++ks) x += *(const f32x4*)(sy + ((size_t)ks * 256 + r) * 2048 + c);
            const f32x4 xv = *(const f32x4*)(G_X1 + ((size_t)MP + r) * D + c), g2 = *(const f32x4*)(G_mods + (size_t)modrow(MP + r) * NMOD + 5 * D + c);
            *(f32x4*)(G_out + ((size_t)MP + r) * D + c) = xv + g2 * x; }
    }
#undef SLABP
#undef IN
#undef SEAM
}
#undef G_x_p
#undef G_x_s
#undef G_c_p
#undef G_c_s
#undef G_cache_cmp
#undef G_cache_sel
#undef G_cache_win
#undef G_state
#undef G_pt
#undef G_lbl
#undef G_relb
#undef G_ada_w
#undef G_ada_b
#undef G_norm1
#undef G_norm2
#undef G_w_in
#undef G_onorm
#undef G_qn_g
#undef G_ks_g
#undef G_kw_g
#undef G_w_ba
#undef G_w_bb
#undef G_w_out
#undef G_w1
#undef G_w2
#undef G_Wt_in
#undef G_Wt_ba
#undef G_Wt_bb
#undef G_Wt_out
#undef G_Wt_1
#undef G_Wt_2
#undef G_mods
#undef G_H
#undef G_proj
#undef G_winkv
#undef G_QN
#undef G_F
#undef G_oraw
#undef G_OA
#undef G_OB
#undef G_KCP
#undef G_VCP
#undef G_KCS
#undef G_VCS
#undef G_PCMP
#undef G_IDX
#undef G_OCMP
#undef G_OSEL
#undef G_OWIN
#undef G_QNb
#undef G_GATES
#undef G_KSf
#undef G_VSf
#undef G_KWf
#undef G_VWf
#undef G_KCf
#undef G_VCf
#undef G_T
#undef G_MERGED
#undef G_X1
#undef G_U
#undef G_XHC
#undef G_XHP
#undef G_Wc1t
#undef G_PREC
#undef G_PREP
#undef G_out
#undef G_ws
#undef tid
#undef lane
#undef wave
#undef sub2
#undef lt2
#undef sub4
#undef lt4


#ifndef MK_N_LAUNCHES
#define MK_N_LAUNCHES 1
#endif
extern "C" void kernel_launch(void* const* d_in, const int* in_sizes, int n_in, void* d_out, int out_size, void* d_ws, size_t ws_size, hipStream_t stream) {
    (void)in_sizes; (void)out_size;
    static int grid = 0;
    if (grid == 0) {
        if (n_in != 32 || ws_size < WS_END) { fprintf(stderr, "kernel_launch: unexpected inputs (%d) or workspace (%zu < %zu)\n", n_in, ws_size, (size_t)WS_END); grid = -1; return; }
        int dev = 0, cus = 0, per_cu = 0;
        (void)hipGetDevice(&dev); (void)hipDeviceGetAttribute(&cus, hipDeviceAttributeMultiprocessorCount, dev);
        if (hipFuncSetAttribute((const void*)mk_fwd, hipFuncAttributeMaxDynamicSharedMemorySize, LDS_BYTES) != hipSuccess) { fprintf(stderr, "kernel_launch: hipFuncSetAttribute failed\n"); grid = -1; return; }
        if (hipOccupancyMaxActiveBlocksPerMultiprocessor(&per_cu, (const void*)mk_fwd, NTHR, LDS_BYTES) != hipSuccess || per_cu < 1) { fprintf(stderr, "kernel_launch: occupancy query says %d\n", per_cu); }
        (void)hipGetLastError();
        if (cus != 256) { fprintf(stderr, "kernel_launch: built for a 256-CU device, found %d CUs\n", cus); grid = -1; return; }
        grid = 256;
    }
    if (grid < 0) return;
    (void)hipMemsetAsync((char*)d_ws + WS_BAR, 0, XCD_BAR_WORDS * 4, stream);
    Args a{};
    for (int i = 0; i < 32; ++i) a.in[i] = d_in[i];
    a.out = (float*)d_out; a.ws = (unsigned char*)d_ws;
    if (MK_N_LAUNCHES == 1) { a.ph_lo = 0; a.ph_hi = N_PHASES; hipLaunchKernelGGL(mk_fwd, dim3(grid), dim3(NTHR), LDS_BYTES, stream, a); }
    else { for (int k = 0; k < N_PHASES; ++k) { a.ph_lo = k; a.ph_hi = k + 1; hipLaunchKernelGGL(mk_fwd, dim3(grid), dim3(NTHR), LDS_BYTES, stream, a); } }
}
```

```cpp
#include <hip/hip_runtime.h>
#include <stdint.h>
#include <math.h>
#include <cstdio>

namespace pg8 {
#define PG8_LAS __attribute__((address_space(3)))
typedef unsigned short bf16_t;
typedef short bf16x8 __attribute__((ext_vector_type(8)));
typedef float f32x4 __attribute__((ext_vector_type(4)));
typedef unsigned u32x4 __attribute__((ext_vector_type(4)));
constexpr int BM = 256, BK = 64, HALF = 128, HTB = HALF * BK * 2  , STAGE_BYTES = 8 * HTB, NXCD = 8, WGM = 8;

__host__ __device__ __forceinline__ int lds_byte(int r, int c) { const int st = (r >> 4) * 2 + (c >> 5), rr = r & 15, cc = c & 31, ob = rr * 64 + cc * 2; return st * 1024 + (ob ^ (((ob >> 9) & 1) << 5)); }
__host__ __device__ __forceinline__ void stage_rc(int b, int& R, int& C) { const int st = b / 1024, sb = b % 1024, swz = sb ^ (((sb >> 9) & 1) << 5); R = (st >> 1) * 16 + swz / 64; C = (st & 1) * 32 + (swz % 64) / 2; }
__host__ __device__ __forceinline__ int perm32(int rho) { const int n = rho >> 4, i = rho & 15; return 8 * (i >> 2) + 4 * n + (i & 3); }

struct Unit { int pm, pn, k0, nt, sel; };
struct Gemm { const bf16_t* A; const bf16_t* Bt; int M, N, K, ld; const bf16_t* A2; const bf16_t* Bt2; };

struct StaticOrder {
    int nM, nN, nwg, G, c, nt0;
    __host__ __device__ void init(int M, int N, int G_, int c_, int K_ = 0) { nM = M / BM; nN = N / BM; nwg = nM * nN; G = G_; c = c_; nt0 = K_ / BK; }
    __host__ __device__ bool next(int i, Unit& u) const {
        const long L = (long)i * G + c; if (L >= nwg) return false;
        int wgid = (int)L; { const int q = nwg / NXCD, r = nwg % NXCD, xcd = wgid % NXCD, off = wgid / NXCD; wgid = (xcd < r ? xcd * (q + 1) : r * (q + 1) + (xcd - r) * q) + off; }
        const int nig = WGM * nN, gid = wgid / nig, fm = gid * WGM, gsz = (nM - fm) < WGM ? (nM - fm) : WGM;
        u.pm = fm + ((wgid % nig) % gsz); u.pn = (wgid % nig) / gsz; u.k0 = 0; u.nt = nt0; u.sel = 0; return true;
    }
    __device__ __forceinline__ void a_ready(const Unit&) const {}
    __device__ __forceinline__ void done(const Unit&) const {}
};
template <class Epi, class Sched, bool STAMP = false>
__device__ __forceinline__ void gemm_phase(PG8_LAS unsigned char* lds, const Gemm g, const Sched& S, const Epi& E, unsigned long long* stamps, int pg8_wave_id) {
    const int wid = __builtin_amdgcn_readfirstlane(pg8_wave_id), lane = (int)__builtin_amdgcn_mbcnt_hi(~0u, __builtin_amdgcn_mbcnt_lo(~0u, 0u)), tid = wid * 64 + lane, wr = wid >> 2, wc = wid & 3, fr = lane & 15, fq = lane >> 4;
    const int K = g.ld;
    int ts_lo = 0, ts_hi = 0, nts = 0; const unsigned long long rt_entry = STAMP ? (unsigned long long)wall_clock64() : 0ull;
#define PG8_STAMP() do { if (STAMP && wid == 0 && nts < 64) { const unsigned long long _c = (unsigned long long)clock64(); \
        ts_lo = (lane == nts) ? (int)(unsigned)_c : ts_lo; ts_hi = (lane == nts) ? (int)(unsigned)(_c >> 32) : ts_hi; ++nts; } } while (0)
    PG8_STAMP();
    unsigned voffA[2], voffB[2];
#pragma unroll
    for (int i = 0; i < 2; ++i) { int R, C; stage_rc(tid * 16 + i * 8192, R, C); const int Rb = Epi::PERM ? ((R & ~31) + perm32(R & 31)) : R;
        voffA[i] = (unsigned)(R * K + C) * 2u; voffB[i] = (unsigned)(Rb * K + C) * 2u; }
    const size_t kstep = (size_t)(BK * 2);
    const size_t hstep = (size_t)HALF * K * 2;
    const size_t tstep = 2 * hstep;
    const unsigned ldsw = (unsigned)wid * 1024u;
    const int aoff = lds_byte(wr * 64 + fr, fq * 8), boff = lds_byte(wc * 32 + fr, fq * 8);
#define PG8_SA(b, h) (((b) * 2 + (h)) * HTB)
#define PG8_SB(b, h) ((4 + (b) * 2 + (h)) * HTB)
#define PG8_STAGE(bufoff, gbase, voff) do { _Pragma("unroll") for (int _i = 0; _i < 2; ++_i) \
        __builtin_amdgcn_global_load_lds((const unsigned*)((const char*)(gbase) + (voff)[_i]), (PG8_LAS unsigned*)(lds + (bufoff) + ldsw + _i * 8192), 16, 0, 0); } while (0)
#define PG8_LDA(dst, b, h) do { _Pragma("unroll") for (int m = 0; m < 4; ++m) _Pragma("unroll") for (int k = 0; k < 2; ++k) dst[m][k] = *(const PG8_LAS bf16x8*)(lds + PG8_SA(b, h) + aoff + m * 2048 + k * 1024); } while (0)
#define PG8_LDB(dst, b, h) do { _Pragma("unroll") for (int n = 0; n < 2; ++n) _Pragma("unroll") for (int k = 0; k < 2; ++k) dst[n][k] = *(const PG8_LAS bf16x8*)(lds + PG8_SB(b, h) + boff + n * 2048 + k * 1024); } while (0)
#define PG8_MMA(ai, bj, At, Bt) do { __builtin_amdgcn_s_setprio(1); _Pragma("unroll") for (int m = 0; m < 4; ++m) _Pragma("unroll") for (int n = 0; n < 2; ++n) _Pragma("unroll") for (int k = 0; k < 2; ++k) \
        acc[ai][bj][m][n] = __builtin_amdgcn_mfma_f32_16x16x32_bf16(Bt[n][k], At[m][k], acc[ai][bj][m][n], 0, 0, 0); __builtin_amdgcn_s_setprio(0); } while (0)
#define PG8_WAIT_V(n) asm volatile("s_waitcnt vmcnt(" #n ")" ::: "memory")
#define PG8_WAIT_L(n) asm volatile("s_waitcnt lgkmcnt(" #n ")" ::: "memory")
#define PG8_BAR __builtin_amdgcn_s_barrier()
#define PG8_SCHED __builtin_amdgcn_sched_barrier(0)
    Unit cur, nxt; int ui = 0;
    if (!S.next(0, cur)) return;
    f32x4 acc[2][2][4][2];
#pragma unroll
    for (int a = 0; a < 2; ++a)
#pragma unroll
        for (int b = 0; b < 2; ++b)
#pragma unroll
            for (int m = 0; m < 4; ++m)
#pragma unroll
                for (int n = 0; n < 2; ++n) acc[a][b][m][n] = (f32x4){0.f, 0.f, 0.f, 0.f};
    bf16x8 At[4][2], B0[2][2], B1[2][2];
    const char* cA = (const char*)(cur.sel ? g.A2 : g.A) + (size_t)cur.pm * tstep + (size_t)cur.k0 * 2; const char* cB = (const char*)(cur.sel ? g.Bt2 : g.Bt) + (size_t)cur.pn * tstep + (size_t)cur.k0 * 2;
    S.a_ready(cur);
    PG8_STAGE(PG8_SB(0, 0), cB, voffB); PG8_STAGE(PG8_SA(0, 0), cA, voffA); PG8_STAGE(PG8_SB(0, 1), cB + hstep, voffB); PG8_STAGE(PG8_SA(0, 1), cA + hstep, voffA);
    if (wr == 1) PG8_BAR;
    PG8_WAIT_V(4); PG8_BAR;
    PG8_STAGE(PG8_SB(1, 0), cB + kstep, voffB); PG8_STAGE(PG8_SA(1, 0), cA + kstep, voffA); PG8_STAGE(PG8_SB(1, 1), cB + hstep + kstep, voffB);
    PG8_WAIT_V(6); PG8_BAR;
    PG8_STAMP();
    for (;;) {
        const bool has_next = S.next(ui + 1, nxt);
        const char* nA = has_next ? (const char*)(nxt.sel ? g.A2 : g.A) + (size_t)nxt.pm * tstep + (size_t)nxt.k0 * 2 : cA; const char* nB = has_next ? (const char*)(nxt.sel ? g.Bt2 : g.Bt) + (size_t)nxt.pn * tstep + (size_t)nxt.k0 * 2 : cB;
        const int nt = cur.nt;
        for (int t = 0; t < nt; t += 2) {
            const bool last = (t == nt - 2);
            const char* a1 = cA + (size_t)(t + 1) * kstep;
            const char* a2 = last ? nA : cA + (size_t)(t + 2) * kstep; const char* b2 = last ? nB : cB + (size_t)(t + 2) * kstep;
            const char* a3 = a2 + kstep; const char* b3 = b2 + kstep;
            if (last && has_next) S.a_ready(nxt);
            PG8_LDB(B0, 0, 0); PG8_SCHED; PG8_LDA(At, 0, 0); PG8_STAGE(PG8_SA(1, 1), a1 + hstep, voffA);
            PG8_WAIT_L(8); PG8_BAR; PG8_WAIT_L(0); PG8_MMA(0, 0, At, B0); PG8_BAR; PG8_SCHED;
            PG8_LDB(B1, 0, 1); PG8_STAGE(PG8_SB(0, 0), b2, voffB);
            PG8_BAR; PG8_WAIT_L(0); PG8_MMA(0, 1, At, B1); PG8_BAR;
            PG8_LDA(At, 0, 1); PG8_STAGE(PG8_SA(0, 0), a2, voffA);
            PG8_BAR; PG8_WAIT_L(0); PG8_MMA(1, 0, At, B0); PG8_BAR; PG8_SCHED;
            PG8_STAGE(PG8_SB(0, 1), b2 + hstep, voffB);
            PG8_WAIT_V(6); PG8_BAR; PG8_MMA(1, 1, At, B1); PG8_BAR;
            PG8_LDB(B0, 1, 0); PG8_SCHED; PG8_LDA(At, 1, 0); PG8_STAGE(PG8_SA(0, 1), a2 + hstep, voffA);
            PG8_WAIT_L(8); PG8_BAR; PG8_WAIT_L(0); PG8_MMA(0, 0, At, B0); PG8_BAR; PG8_SCHED;
            PG8_LDB(B1, 1, 1); PG8_STAGE(PG8_SB(1, 0), b3, voffB);
            PG8_BAR; PG8_WAIT_L(0); PG8_MMA(0, 1, At, B1); PG8_BAR;
            PG8_LDA(At, 1, 1); PG8_STAGE(PG8_SA(1, 0), a3, voffA);
            PG8_BAR; PG8_WAIT_L(0); PG8_MMA(1, 0, At, B0); PG8_BAR; PG8_SCHED;
            PG8_STAGE(PG8_SB(1, 1), b3 + hstep, voffB);
            PG8_WAIT_V(6); PG8_BAR; PG8_MMA(1, 1, At, B1); PG8_BAR;
        }
        PG8_STAMP();
        if constexpr (!Epi::AFTER_DRAIN) { E(acc, cur, wr, wc, fr, fq); S.done(cur); }
        PG8_STAMP();
        if (!has_next) break;
#pragma unroll
        for (int a = 0; a < 2; ++a)
#pragma unroll
            for (int b = 0; b < 2; ++b)
#pragma unroll
                for (int m = 0; m < 4; ++m)
#pragma unroll
                    for (int n = 0; n < 2; ++n) acc[a][b][m][n] = (f32x4){0.f, 0.f, 0.f, 0.f};
        cur = nxt; cA = nA; cB = nB; ++ui;
    }
    PG8_WAIT_V(0);
    if (wr == 0) PG8_BAR;
    PG8_BAR;
    if constexpr (Epi::AFTER_DRAIN) { E.fused(acc, cur, wr, wc, fr, fq, lds, wid, lane); S.done(cur); }
    PG8_STAMP();
    if (STAMP && wid == 0) { stamps[lane] = lane < nts ? (((unsigned long long)(unsigned)ts_hi << 32) | (unsigned)ts_lo) : 0ull;
        if (lane == 62) stamps[62] = rt_entry; if (lane == 63) stamps[63] = (unsigned long long)wall_clock64(); }
#undef PG8_STAMP
#undef PG8_SA
#undef PG8_SB
#undef PG8_STAGE
#undef PG8_LDA
#undef PG8_LDB
#undef PG8_MMA
#undef PG8_WAIT_V
#undef PG8_WAIT_L
#undef PG8_BAR
#undef PG8_SCHED
}
}

#define XB_TMO      128
#define XB_XCNT(j)  (256  + 64 * (j))
#define XB_XSUB(j)  (1280 + 64 * (j))
#define XB_XGEN(j)  (2304 + 64 * (j))
#define XB_TOP      3328
#define XB_TOPGEN   3392
#define XCD_BAR_WORDS 3456
#define XB_SPIN_CAP (1u << 22)
#define LAS __attribute__((address_space(3)))

__device__ __forceinline__ unsigned xb_ld(unsigned* p)              { return __hip_atomic_load(p, __ATOMIC_RELAXED, __HIP_MEMORY_SCOPE_AGENT); }
__device__ __forceinline__ unsigned xb_add(unsigned* p, unsigned v) { return __hip_atomic_fetch_add(p, v, __ATOMIC_RELAXED, __HIP_MEMORY_SCOPE_AGENT); }
__device__ __forceinline__ unsigned xb_xcc_id() { return (unsigned)__builtin_amdgcn_s_getreg((3 << 11) | 20) & 0xFu; }
#define XB_SPIN(cond, bar) do { unsigned _sp = 0; while (cond) { __builtin_amdgcn_s_sleep(1); \
    if ((++_sp & 255u) == 0u) { if (xb_ld(&(bar)[XB_TMO])) break; if (_sp > XB_SPIN_CAP) { atomicAdd(&(bar)[XB_TMO], 1u); break; } } } } while (0)

#define xb_thread0() (xb_wave_s == 0 && __builtin_amdgcn_mbcnt_hi(~0u, __builtin_amdgcn_mbcnt_lo(~0u, 0u)) == 0u)
struct XcdBarrier {
    unsigned* bar; unsigned x;
    volatile LAS unsigned* st;
};

__device__ __forceinline__ XcdBarrier xcd_barrier_post(unsigned* bar, volatile LAS unsigned* st, int xb_wave_s) {
    XcdBarrier b; b.bar = bar; b.x = xb_xcc_id(); b.st = st;
    if (xb_thread0()) (void)xb_add(&bar[XB_XCNT(b.x)], 1u);
    return b;
}
__device__ __forceinline__ void xcd_barrier_complete(unsigned* bar, unsigned x, unsigned& nloc, unsigned& nx) {
    const unsigned G = gridDim.x * gridDim.y * gridDim.z;
    unsigned sum, cnt, mine, sp = 0u;
    for (;;) {
        sum = 0u; cnt = 0u; mine = 0u;
#pragma unroll
        for (unsigned j = 0; j < 16; ++j) { const unsigned c = xb_ld(&bar[XB_XCNT(j)]); sum += c; cnt += (c > 0u) ? 1u : 0u; mine = (j == x) ? c : mine; }
        if (sum == G) break;
        __builtin_amdgcn_s_sleep(1);
        if ((++sp & 255u) == 0u) { if (xb_ld(&bar[XB_TMO])) break; if (sp > XB_SPIN_CAP) { atomicAdd(&bar[XB_TMO], 1u); break; } }
    }
    nloc = mine > 0u ? mine : 1u; nx = cnt > 0u ? cnt : 1u;
}

__device__ __forceinline__ void xcd_barrier(const XcdBarrier& b, int xb_wave_s) {
    asm volatile("s_waitcnt vmcnt(0)" ::: "memory");
    __syncthreads();
    if (xb_thread0()) {
        unsigned* bar = b.bar;
        __builtin_amdgcn_s_waitcnt(0);
        unsigned nloc = b.st[0], nx = b.st[1];
        if (nloc == 0u) { xcd_barrier_complete(bar, b.x, nloc, nx); b.st[0] = nloc; b.st[1] = nx; }
        const unsigned old = xb_add(&bar[XB_XSUB(b.x)], 1u);
        const unsigned gen = old / nloc;
        if (old + 1u == (gen + 1u) * nloc) {
            __builtin_amdgcn_fence(__ATOMIC_RELEASE, "agent");
            asm volatile("s_waitcnt vmcnt(0)" ::: "memory");
            const unsigned og = xb_add(&bar[XB_TOP], 1u);
            const unsigned tg = og / nx;
            if (og + 1u == (tg + 1u) * nx) xb_add(&bar[XB_TOPGEN], 1u);
            else XB_SPIN(xb_ld(&bar[XB_TOPGEN]) == tg, bar);
            __builtin_amdgcn_fence(__ATOMIC_ACQUIRE, "agent");
            xb_add(&bar[XB_XGEN(b.x)], 1u);
            asm volatile("s_waitcnt vmcnt(0)" ::: "memory");
        } else {
            XB_SPIN(xb_ld(&bar[XB_XGEN(b.x)]) == gen, bar);
            __builtin_amdgcn_fence(__ATOMIC_ACQUIRE, "agent");
            asm volatile("s_waitcnt vmcnt(0)" ::: "memory");
        }
    }
    __syncthreads();
}

typedef unsigned short bf16;
typedef float f32x4 __attribute__((ext_vector_type(4)));
typedef float f32x2 __attribute__((ext_vector_type(2)));
constexpr int D = 2048, TP = 4096, MP = 8192, BS = 32, TS = 8, MS = 256, MT = 8448;
constexpr int PAST = 8192, NPAGE = 64, PAGE = 128, NMOD = 12288, DFF = 8192;
constexpr int NPROJ = 11008;
constexpr int C_QA = 0, C_ZA = 1024, C_IA = 2048, C_GA = 3072, C_QB = 4096, C_KC = 5120, C_VC = 5376, C_KS = 5632, C_VS = 5888, C_KW = 6144, C_VW = 6400, C_MGA = 6656, C_MGB = 8704, C_GATE = 10752;
constexpr int IN_COLS = 10776;
constexpr int LQ = 1024 + 64, LMG = 2048 + 64;
constexpr size_t O_YP = 0, O_YS = 16777216, O_CMPP = 17301504, O_CMPS = 21495808, O_SELP = 21626880, O_SELS = 25821184, O_WINP = 25952256, O_WINS = 26476544, O_HGP = 34865152, O_HGS = 35127296, O_END = 39321600;
constexpr float EPS = 1e-6f;
typedef short bf16x8 __attribute__((ext_vector_type(8)));
typedef float f32x16 __attribute__((ext_vector_type(16)));
typedef float f32x2_t __attribute__((ext_vector_type(2))); typedef __bf16 bf16x2_t __attribute__((ext_vector_type(2)));
typedef unsigned u32x4 __attribute__((ext_vector_type(4)));
constexpr float LOG2E = 1.4426950408889634f;
__device__ __forceinline__ unsigned cvtpk(float lo, float hi) { f32x2_t v = {lo, hi}; bf16x2_t b = __builtin_convertvector(v, bf16x2_t); return __builtin_bit_cast(unsigned, b); }

__device__ __forceinline__ bf16 f2bf(float f) { unsigned u = __float_as_uint(f); u += 0x7FFFu + ((u >> 16) & 1u); return (bf16)(u >> 16); }
__device__ __forceinline__ float bf2f(bf16 b) { return __uint_as_float(((unsigned)b) << 16); }
__device__ __forceinline__ float sigmoidf_(float x) { return __builtin_amdgcn_rcpf(1.0f + __builtin_amdgcn_exp2f(-1.4426950408889634f * x)); }
__device__ __forceinline__ float siluf_(float x) { return x * sigmoidf_(x); }
__device__ __forceinline__ int modrow(int r) { return r < MP ? (r >> 12) : 2 + ((r - MP) >> 3); }
__device__ __forceinline__ int win_col(int n) {
    if (n < C_MGA) return n;
    if (n < C_MGB) return 6680 + (n - C_MGA);
    if (n < C_GATE) return 8728 + (n - C_MGB);
    if (n < C_GATE + 24) return 6656 + (n - C_GATE);
    return -1;
}
__device__ __forceinline__ int rel_bucket(int rel) {
    const int n = rel > 0 ? rel : 0;
    if (n < 16) return n;
    const float nf = (float)n;
    const int large = 16 + (int)(logf(nf / 16.0f) / 2.0794415416798357f * 16.0f);
    return large < 31 ? large : 31;
}
__device__ __forceinline__ float wave_sum(float v) {
#pragma unroll
    for (int o = 32; o >= 1; o >>= 1) v += __shfl_xor(v, o);
    return v;
}
__device__ __forceinline__ float wave_max(float v) {
#pragma unroll
    for (int o = 32; o >= 1; o >>= 1) v = fmaxf(v, __shfl_xor(v, o));
    return v;
}

__device__ __forceinline__ void b_transpose128(const float* __restrict__ W, int ldw, int c0, int lim, bf16* __restrict__ Wt, int K, int n0, int k0, int tid, float* tile) {
#pragma unroll
    for (int p = 0; p < 8; ++p) { const int k = p * 16 + (tid >> 5), n4 = (tid & 31) * 4; f32x4 v = {0.f, 0.f, 0.f, 0.f};
        if (n4 < lim) v = *(const f32x4*)(W + (size_t)(k0 + k) * ldw + c0 + n4);
        float* t = tile + k * 129 + n4; t[0] = v[0]; t[1] = v[1]; t[2] = v[2]; t[3] = v[3]; }
    __syncthreads();
#pragma unroll
    for (int p = 0; p < 4; ++p) { const int n = p * 32 + (tid >> 4), kg = tid & 15; const float* t = tile + (8 * kg) * 129 + n;
        u32x4 w; w.x = cvtpk(t[0], t[129]); w.y = cvtpk(t[2 * 129], t[3 * 129]); w.z = cvtpk(t[4 * 129], t[5 * 129]); w.w = cvtpk(t[6 * 129], t[7 * 129]);
        *(u32x4*)(Wt + (size_t)(n0 + n) * K + k0 + 8 * kg) = w; }
    __syncthreads();
}
__device__ __forceinline__ void b_mods_part(const float* __restrict__ cp, const float* __restrict__ cs, const float* __restrict__ ada_w, float* __restrict__ MODP, int cg, int kc, int tid, float* tbl) {
    { float cv[17];
#pragma unroll
      for (int i = 0; i < 17; ++i) { const int u = tid + 512 * i, r = u >> 8, k = 256 * kc + (u & 255); cv[i] = (r < 2 ? cp + r * D : cs + (r - 2) * D)[k]; }
#pragma unroll
      for (int i = 0; i < 17; ++i) tbl[tid + 512 * i] = siluf_(cv[i]); }
    __syncthreads();
    const int col = cg * 512 + tid; float acc[34];
#pragma unroll
    for (int r = 0; r < 34; ++r) acc[r] = 0.f;
    const float* p = ada_w + (size_t)(256 * kc) * NMOD + col;
#pragma unroll 1
    for (int k0 = 0; k0 < 256; k0 += 32) {
        float w[32];
#pragma unroll
        for (int j = 0; j < 32; ++j) { w[j] = *p; p += NMOD; asm volatile("" : "+v"(p)); }
#pragma unroll
        for (int r = 0; r < 34; ++r) {
            float a0 = 0.f, a1 = 0.f;
#pragma unroll
            for (int j = 0; j < 32; j += 8) { const f32x4 s4 = *(const f32x4*)(tbl + r * 256 + k0 + j), t4 = *(const f32x4*)(tbl + r * 256 + k0 + j + 4);
                a0 += (s4[0] * w[j] + s4[1] * w[j + 1]) + (s4[2] * w[j + 2] + s4[3] * w[j + 3]); a1 += (t4[0] * w[j + 4] + t4[1] * w[j + 5]) + (t4[2] * w[j + 6] + t4[3] * w[j + 7]); }
            acc[r] += a0 + a1;
            __builtin_amdgcn_sched_barrier(0);
        }
    }
    float* q = MODP + (size_t)kc * 34 * NMOD + col;
#pragma unroll
    for (int r = 0; r < 34; ++r) { *q = acc[r]; q += NMOD; asm volatile("" : "+v"(q)); }
    __syncthreads();
}
__device__ __forceinline__ void b_hnorm(const float* __restrict__ xa, const float* __restrict__ xb, const float* __restrict__ gain, const float* __restrict__ mods, int sh_idx, int sc_idx, bf16* __restrict__ out, int row, int lt, float* red) {
    const float* x = row < MP ? xa + (size_t)row * D : xb + (size_t)(row - MP) * D;
    float v[8]; float ss = 0.f;
#pragma unroll
    for (int j = 0; j < 8; ++j) { v[j] = x[lt * 8 + j]; ss += v[j] * v[j]; }
    ss = wave_sum(ss); if ((lt & 63) == 0) red[lt >> 6] = ss; __syncthreads();
    ss = red[0] + red[1] + red[2] + red[3];
    const float r = rsqrtf(ss * (1.0f / D) + EPS);
    const float* m = mods + (size_t)modrow(row) * NMOD;
#pragma unroll
    for (int j = 0; j < 8; ++j) { const int c = lt * 8 + j; out[(size_t)row * D + c] = f2bf(v[j] * r * gain[c] * (1.0f + m[sc_idx * D + c]) + m[sh_idx * D + c]); }
    __syncthreads();
}
__device__ __forceinline__ void b_norm2_sample(const float* __restrict__ xs, const float* __restrict__ slab, const float* __restrict__ gain, const float* __restrict__ mods, float* __restrict__ X1, bf16* __restrict__ out, int row, int lt, float* red) {
    const int r = row - MP; const float* m = mods + (size_t)modrow(row) * NMOD;
    float v[8]; float ss = 0.f;
#pragma unroll
    for (int j = 0; j < 8; ++j) { const int c = lt * 8 + j; float s = 0.f;
#pragma unroll
        for (int ks = 0; ks < 8; ++ks) s += slab[((size_t)ks * 256 + r) * 2048 + c];
        v[j] = xs[(size_t)r * D + c] + m[2 * D + c] * s; X1[(size_t)row * D + c] = v[j]; ss += v[j] * v[j]; }
    ss = wave_sum(ss); if ((lt & 63) == 0) red[lt >> 6] = ss; __syncthreads();
    ss = red[0] + red[1] + red[2] + red[3];
    const float rn = rsqrtf(ss * (1.0f / D) + EPS);
#pragma unroll
    for (int j = 0; j < 8; ++j) { const int c = lt * 8 + j; out[(size_t)row * D + c] = f2bf(v[j] * rn * gain[c] * (1.0f + m[4 * D + c]) + m[3 * D + c]); }
    __syncthreads();
}
__device__ __forceinline__ void b_hgrn_seq(const bf16* __restrict__ QAb, const bf16* __restrict__ IAb, const float* __restrict__ F, const float* __restrict__ state, float* __restrict__ oraw, float* __restrict__ out, int x, int v) {
    const bool pr = x < 16;
    const int b = pr ? (x >> 3) : ((x - 16) >> 3), h = x & 7;
    const int T = pr ? TP : TS; const size_t row0 = pr ? (size_t)b * TP : (size_t)MP + b * TS;
    float S[128];
#pragma unroll
    for (int k = 0; k < 128; ++k) S[k] = pr ? 0.f : state[(((size_t)b * 8 + h) * 128 + k) * 128 + v];
    for (int t = 0; t < T; ++t) {
        const bf16* qp = QAb + (row0 + t) * LQ + h * 128; const float* f = F + (row0 + t) * LQ + h * 128;
        const float vi = bf2f(IAb[(row0 + t) * LQ + h * 128 + v]); float o = 0.f;
#pragma unroll
        for (int k = 0; k < 128; ++k) { const float fk = f[k]; S[k] = fk * S[k] + (1.0f - fk) * vi; o += S[k] * bf2f(qp[k]); }
        oraw[(row0 + t) * 1024 + h * 128 + v] = o;
    }
    float* so = out + (pr ? O_HGP : O_HGS) + ((size_t)b * 8 + h) * 16384;
#pragma unroll
    for (int k = 0; k < 128; ++k) so[k * 128 + v] = S[k];
}
__device__ __forceinline__ void b_hgrn_seq_s(const bf16* __restrict__ QAb, const bf16* __restrict__ IAb, const float* __restrict__ F, const float* __restrict__ state, float* __restrict__ oraw, float* __restrict__ out, int bh, int tid, float* fl, float* ql) {
    const int b = bh >> 3, h = bh & 7; const size_t row0 = (size_t)MP + b * TS;
    if (tid < 128) {
#pragma unroll
        for (int t = 0; t < 8; ++t) { fl[t * 128 + tid] = F[(row0 + t) * LQ + h * 128 + tid]; ql[t * 128 + tid] = bf2f(QAb[(row0 + t) * LQ + h * 128 + tid]); } }
    __syncthreads();
    if (tid < 128) {
        const int v = tid; float S[128];
#pragma unroll
        for (int k = 0; k < 128; ++k) S[k] = state[(((size_t)b * 8 + h) * 128 + k) * 128 + v];
#pragma unroll 1
        for (int t = 0; t < 8; ++t) {
            const float vi = bf2f(IAb[(row0 + t) * LQ + h * 128 + v]); float o = 0.f;
#pragma unroll
            for (int k4 = 0; k4 < 32; ++k4) { const f32x4 f4 = *(const f32x4*)(fl + t * 128 + 4 * k4), q4 = *(const f32x4*)(ql + t * 128 + 4 * k4);
#pragma unroll
                for (int e = 0; e < 4; ++e) { const int k = 4 * k4 + e; S[k] = f4[e] * S[k] + (1.0f - f4[e]) * vi; o += S[k] * q4[e]; }
                if ((k4 & 3) == 3) __builtin_amdgcn_sched_barrier(0); }
            oraw[(row0 + t) * 1024 + h * 128 + v] = o;
        }
        float* so = out + O_HGS + ((size_t)b * 8 + h) * 16384;
#pragma unroll
        for (int k = 0; k < 128; ++k) so[k * 128 + v] = S[k];
    }
    __syncthreads();
}
__device__ __forceinline__ void b_hgrn_out(const float* __restrict__ oraw, const bf16* __restrict__ GAs, const float* __restrict__ onorm, bf16* __restrict__ OA, int row, int tid) {
    float o[4]; float ss = 0.f;
#pragma unroll
    for (int j = 0; j < 4; ++j) { o[j] = oraw[(size_t)row * 1024 + tid * 4 + j]; ss += o[j] * o[j]; }
#pragma unroll
    for (int s = 16; s >= 1; s >>= 1) ss += __shfl_xor(ss, s);
    const float r = rsqrtf(ss * (1.0f / 128) + EPS);
#pragma unroll
    for (int j = 0; j < 4; ++j) { const int c = tid * 4 + j; OA[(size_t)row * 1024 + c] = f2bf(o[j] * r * onorm[c] * bf2f(GAs[(size_t)row * LQ + c])); }
}

template <class F> struct EpiGen {
    static constexpr bool PERM = false, AFTER_DRAIN = false;
    F f; float* slab; int slab_n, kslice;
    __device__ __forceinline__ void operator()(const pg8::f32x4 (&acc)[2][2][4][2], const pg8::Unit& u, int wr, int wc, int fr0, int fq0) const {
        int fr = fr0, fq = fq0; asm volatile("" : "+v"(fr), "+v"(fq));
        const int row0 = u.pm * 256 + wr * 64 + fr, col0 = u.pn * 256 + wc * 32 + 4 * fq;
        if (slab != nullptr && u.pm == 32) {
            float* sp = slab + ((size_t)(u.k0 / kslice) * 256 + (row0 - MP)) * slab_n + col0;
#pragma unroll
            for (int ai = 0; ai < 2; ++ai)
#pragma unroll
                for (int m = 0; m < 4; ++m)
#pragma unroll
                    for (int bj = 0; bj < 2; ++bj)
#pragma unroll
                        for (int n = 0; n < 2; ++n) *(f32x4*)(sp + (size_t)(ai * 128 + m * 16) * slab_n + bj * 128 + n * 16) = acc[ai][bj][m][n];
            return;
        }
#pragma unroll
        for (int ai = 0; ai < 2; ++ai)
#pragma unroll
            for (int m = 0; m < 4; ++m)
#pragma unroll
                for (int bj = 0; bj < 2; ++bj)
#pragma unroll
                    for (int n = 0; n < 2; ++n) f(row0 + ai * 128 + m * 16, col0 + bj * 128 + n * 16, acc[ai][bj][m][n]);
    }
};
struct MixOrder {
    pg8::StaticOrder P; int nN, nsl, ntS, kslice;
    __device__ __forceinline__ void init(int N, int K, int nsl_, int G, int c) { P.init(MP, N, G, c, K); nN = N / 256; nsl = nsl_; kslice = K / nsl_; ntS = kslice / 64; }
    __device__ __forceinline__ bool next(int i, pg8::Unit& u) const {
        const int L = i * P.G + P.c; if (L < P.nwg) return P.next(i, u);
        const int idx = L - P.nwg; if (idx >= nN * nsl) return false;
        u.pm = 32; u.pn = idx % nN; u.k0 = (idx / nN) * kslice; u.nt = ntS; u.sel = 0; return true; }
    __device__ __forceinline__ void a_ready(const pg8::Unit&) const {}
    __device__ __forceinline__ void done(const pg8::Unit&) const {}
};
template <class Base> struct RangeOrder {
    Base B; int i0, i1;
    __device__ __forceinline__ bool next(int i, pg8::Unit& u) const { return (i0 + i < i1) ? B.next(i0 + i, u) : false; }
    __device__ __forceinline__ void a_ready(const pg8::Unit&) const {}
    __device__ __forceinline__ void done(const pg8::Unit&) const {}
};
struct PairOrder {
    pg8::StaticOrder P; int nN, nsl, ntS, kslice;
    __device__ __forceinline__ void init(int N, int K, int nsl_, int G, int c) { P.init(MP, N, G, c, K); nN = N / 256; nsl = nsl_; kslice = K / nsl_; ntS = kslice / 64; }
    __device__ __forceinline__ bool next(int i, pg8::Unit& u) const {
        if (i < 2) { const bool ok = P.next(0, u); u.sel = i; return ok; }
        const int idx = (i - 2) * P.G + P.c; if (idx >= 2 * nN * nsl) return false;
        const int half = nN * nsl, w = idx >= half ? 1 : 0, id2 = idx - w * half;
        u.pm = 32; u.pn = id2 % nN; u.k0 = (id2 / nN) * kslice; u.nt = ntS; u.sel = w; return true; }
    __device__ __forceinline__ void a_ready(const pg8::Unit&) const {}
    __device__ __forceinline__ void done(const pg8::Unit&) const {}
};
struct EpiBranch {
    static constexpr bool PERM = false, AFTER_DRAIN = false;
    const bf16* mga; const bf16* mgb; float* T; bf16* merged; float* slab; int kslice, pad;
    __device__ __forceinline__ void operator()(const pg8::f32x4 (&acc)[2][2][4][2], const pg8::Unit& u, int wr, int wc, int fr0, int fq0) const {
        int fr = fr0, fq = fq0; asm volatile("" : "+v"(fr), "+v"(fq));
        const int row0 = u.pm * 256 + wr * 64 + fr, col0 = u.pn * 256 + wc * 32 + 4 * fq;
#define EB_LOOP(...) _Pragma("unroll") for (int ai = 0; ai < 2; ++ai) _Pragma("unroll") for (int m = 0; m < 4; ++m) _Pragma("unroll") for (int bj = 0; bj < 2; ++bj) _Pragma("unroll") for (int n = 0; n < 2; ++n) { \
            const int r = row0 + ai * 128 + m * 16, c = col0 + bj * 128 + n * 16; const f32x4 v = acc[ai][bj][m][n]; __VA_ARGS__ }
        if (u.pm == 32) { float* sp = slab + ((size_t)u.sel * 4 * 256 + (size_t)(u.k0 / kslice) * 256) * D; EB_LOOP( *(f32x4*)(sp + (size_t)(r - MP) * D + c) = v; ) }
        else if (u.sel == 0) { EB_LOOP( const ushort4 g = *(const ushort4*)(mga + (size_t)r * LMG + c); f32x4 o; o[0] = bf2f(g.x) * v[0]; o[1] = bf2f(g.y) * v[1]; o[2] = bf2f(g.z) * v[2]; o[3] = bf2f(g.w) * v[3]; *(f32x4*)(T + (size_t)r * D + c) = o; ) }
        else { EB_LOOP( const ushort4 g = *(const ushort4*)(mgb + (size_t)r * LMG + c); const f32x4 t = *(const f32x4*)(T + (size_t)r * D + c); ushort4 o;
                        o.x = f2bf(t[0] + bf2f(g.x) * v[0]); o.y = f2bf(t[1] + bf2f(g.y) * v[1]); o.z = f2bf(t[2] + bf2f(g.z) * v[2]); o.w = f2bf(t[3] + bf2f(g.w) * v[3]); *(ushort4*)(merged + (size_t)r * D + c) = o; ) }
#undef EB_LOOP
    }
};
struct FStoreF32 { float* C; int ldc; int pad;
    __device__ __forceinline__ void operator()(int r, int c, f32x4 v) const { *(f32x4*)(C + (size_t)r * ldc + c) = v; } };
struct FGateA { const bf16* mga; float* T;
    __device__ __forceinline__ void operator()(int r, int c, f32x4 v) const { const ushort4 g = *(const ushort4*)(mga + (size_t)r * LMG + c); f32x4 o;
        o[0] = bf2f(g.x) * v[0]; o[1] = bf2f(g.y) * v[1]; o[2] = bf2f(g.z) * v[2]; o[3] = bf2f(g.w) * v[3];
        *(f32x4*)(T + (size_t)r * D + c) = o; } };
struct FGateB { const bf16* mgb; const float* T; bf16* merged;
    __device__ __forceinline__ void operator()(int r, int c, f32x4 v) const { const ushort4 g = *(const ushort4*)(mgb + (size_t)r * LMG + c); const f32x4 t = *(const f32x4*)(T + (size_t)r * D + c); ushort4 o;
        o.x = f2bf(t[0] + bf2f(g.x) * v[0]); o.y = f2bf(t[1] + bf2f(g.y) * v[1]); o.z = f2bf(t[2] + bf2f(g.z) * v[2]); o.w = f2bf(t[3] + bf2f(g.w) * v[3]);
        *(ushort4*)(merged + (size_t)r * D + c) = o; } };
struct FRes1 { const float* xp; const float* xs; const float* mods; float* X1;
    __device__ __forceinline__ void operator()(int r, int c, f32x4 v) const { const float* x = r < MP ? xp + (size_t)r * D : xs + (size_t)(r - MP) * D; const f32x4 xv = *(const f32x4*)(x + c);
        const f32x4 g = *(const f32x4*)(mods + (size_t)modrow(r) * NMOD + 2 * D + c); *(f32x4*)(X1 + (size_t)r * D + c) = xv + g * v; } };
struct FRelu2 { bf16* U;
    __device__ __forceinline__ void operator()(int r, int c, f32x4 v) const { ushort4 o; float a;
        a = fmaxf(v[0], 0.f); o.x = f2bf(a * a); a = fmaxf(v[1], 0.f); o.y = f2bf(a * a); a = fmaxf(v[2], 0.f); o.z = f2bf(a * a); a = fmaxf(v[3], 0.f); o.w = f2bf(a * a);
        *(ushort4*)(U + (size_t)r * DFF + c) = o; } };
struct FRes2 { const float* X1; const float* mods; float* out;
    __device__ __forceinline__ void operator()(int r, int c, f32x4 v) const { const f32x4 xv = *(const f32x4*)(X1 + (size_t)r * D + c);
        const f32x4 g = *(const f32x4*)(mods + (size_t)modrow(r) * NMOD + 5 * D + c); *(f32x4*)(out + (size_t)r * D + c) = xv + g * v; } };

struct InProjOut { bf16* QAb; float* F; bf16* IAb; bf16* GAs; float* QBr; float* out; bf16* XHP; float* WINKV; bf16* MGAb; bf16* MGBb; float* GATES; const float* lbl; };
__device__ __forceinline__ void st_bf16x4(bf16* p, f32x4 v) { typedef unsigned u32x2v __attribute__((ext_vector_type(2))); u32x2v w; w.x = cvtpk(v[0], v[1]); w.y = cvtpk(v[2], v[3]); *(u32x2v*)p = w; }
struct EpiInProj {
    static constexpr bool PERM = false, AFTER_DRAIN = false;
    InProjOut o;
#define EPI_LOOP(...) _Pragma("unroll") for (int bj = 0; bj < 2; ++bj) _Pragma("unroll") for (int n = 0; n < 2; ++n) { const int c = ct0 + bj * 128 + n * 16; \
        _Pragma("unroll") for (int ai = 0; ai < 2; ++ai) _Pragma("unroll") for (int m = 0; m < 4; ++m) { const int row = row0 + ai * 128 + m * 16; const f32x4 v = acc[ai][bj][m][n]; __VA_ARGS__ } }
    __device__ __forceinline__ void operator()(const pg8::f32x4 (&acc)[2][2][4][2], const pg8::Unit& u, int wr, int wc, int fr0, int fq0) const {
        int fr = fr0, fq = fq0; asm volatile("" : "+v"(fr), "+v"(fq));
        const int row0 = u.pm * 256 + wr * 64 + fr, ct0 = wc * 32 + 4 * fq, pn = u.pn;
        if (pn < 4) { bf16* p = o.QAb + pn * 256; EPI_LOOP( st_bf16x4(p + (size_t)row * LQ + c, v); ) }
        else if (pn < 8) {
            float* p = o.F + (pn - 4) * 256;
#pragma unroll
            for (int bj = 0; bj < 2; ++bj)
#pragma unroll
                for (int n = 0; n < 2; ++n) { const int c = ct0 + bj * 128 + n * 16; const int cc = (pn - 4) * 256 + c; const f32x4 l0 = *(const f32x4*)(o.lbl + cc), l1 = *(const f32x4*)(o.lbl + 1024 + cc); f32x4 lb;
#pragma unroll
                    for (int j = 0; j < 4; ++j) lb[j] = sigmoidf_(l0[j] - l1[j]);
#pragma unroll
                    for (int ai = 0; ai < 2; ++ai)
#pragma unroll
                        for (int m = 0; m < 4; ++m) { const int row = row0 + ai * 128 + m * 16; const f32x4 v = acc[ai][bj][m][n]; f32x4 f;
#pragma unroll
                            for (int j = 0; j < 4; ++j) f[j] = lb[j] + (1.0f - lb[j]) * sigmoidf_(v[j]);
                            *(f32x4*)(p + (size_t)row * LQ + c) = f; } }
        }
        else if (pn < 12) { bf16* p = o.IAb + (pn - 8) * 256; EPI_LOOP( st_bf16x4(p + (size_t)row * LQ + c, v); ) }
        else if (pn < 16) { bf16* p = o.GAs + (pn - 12) * 256; EPI_LOOP( f32x4 s; s[0] = siluf_(v[0]); s[1] = siluf_(v[1]); s[2] = siluf_(v[2]); s[3] = siluf_(v[3]); st_bf16x4(p + (size_t)row * LQ + c, s); ) }
        else if (pn < 20) { float* p = o.QBr + (pn - 16) * 256; EPI_LOOP( *(f32x4*)(p + (size_t)row * LQ + c) = v; ) }
        else if (pn < 22) { const int w = pn & 1; const bool pr = u.pm < 32; float* p = o.out + (pr ? O_CMPP : O_CMPS) + w * 256 - (pr ? (size_t)0 : (size_t)MP * 512); bf16* xp = o.XHP + (size_t)w * 1280 * 2048;
            EPI_LOOP( *(f32x4*)(p + (size_t)row * 512 + c) = v;
                      { const int kv = c >> 7, d = c & 127; size_t r; int j; if (pr) { const int b = row >> 12, t = row & 4095; r = ((size_t)b * 256 + (t >> 4)) * 2 + kv; j = t & 15; } else { const int lrow = row - MP; r = 1024 + (size_t)(lrow >> 3) * 2 + kv; j = lrow & 7; }
                        st_bf16x4(xp + r * 2048 + j * 128 + d, v); } ) }
        else if (pn < 24) { const int w = pn & 1; const bool pr = u.pm < 32; float* p = o.out + (pr ? O_SELP : O_SELS) + w * 256 - (pr ? (size_t)0 : (size_t)MP * 512); EPI_LOOP( *(f32x4*)(p + (size_t)row * 512 + c) = v; ) }
        else if (pn < 26) { float* p = o.WINKV + (pn & 1) * 256; EPI_LOOP( *(f32x4*)(p + (size_t)row * 512 + c) = v; ) }
        else if (pn < 42) { bf16* p = (pn < 34) ? o.MGAb + (pn - 26) * 256 : o.MGBb + (pn - 34) * 256;
            EPI_LOOP( f32x4 s; s[0] = sigmoidf_(v[0]); s[1] = sigmoidf_(v[1]); s[2] = sigmoidf_(v[2]); s[3] = sigmoidf_(v[3]); st_bf16x4(p + (size_t)row * LMG + c, s); ) }
        else { EPI_LOOP( if (c < 24) { f32x4 s; s[0] = sigmoidf_(v[0]); s[1] = sigmoidf_(v[1]); s[2] = sigmoidf_(v[2]); s[3] = sigmoidf_(v[3]); *(f32x4*)(o.GATES + (size_t)row * 24 + c) = s; } ) }
    }
#undef EPI_LOOP
};

constexpr int NTHR = 512;
constexpr int LDS_STAGE = 131072;
constexpr int LDS_CTL = LDS_STAGE;
constexpr int LDS_BYTES = 163840;
enum { PH_PRO = 0, PH_MRED, PH_NORM1, PH_INPROJ, PH_MIX1, PH_CFIN, PH_ATTN, PH_SATTN, PH_SCOMB, PH_BR, PH_RMERGE, PH_OUT, PH_NORM2, PH_MLP1, PH_RU, PH_MLP2, PH_RY, N_PHASES };


__device__ __forceinline__ int crow(int r, int hi) { return (r & 3) + 8 * (r >> 2) + 4 * hi; }
constexpr int AL_BIAS = LDS_CTL + 64;
constexpr int AL_LX = AL_BIAS + 4 * 132 * 4;
constexpr int AL_FX = AL_LX + 8 * 32 * 4;
constexpr int AL_SEL = AL_FX + 8 * 32 * 4;
constexpr int AL_IMPA = AL_SEL + 32 * 2 * 4;
constexpr int AL_IMPB = AL_IMPA + 32 * 64 * 4;
constexpr int AL_SCT = AL_IMPB + 32 * 64 * 4;
constexpr int AL_END = AL_SCT + 32 * 64 * 4;
static_assert(AL_END <= LDS_BYTES, "attention LDS control region");

struct AttnP { const float* QBr; const float* qn_g; const bf16* KSf; const bf16* VSf; const bf16* KWf; const bf16* VWf; const bf16* KCf; const bf16* VCf; const float* gates; const float* relb; bf16* OB; float* OT; float* IMP; };

__device__ __forceinline__ void dma_copy(LAS unsigned char* dst, const bf16* src, int nchunks  , int wave, int lane) {
    for (int c = wave; c < nchunks; c += 8) __builtin_amdgcn_global_load_lds((const unsigned*)((const char*)src + c * 1024 + lane * 16), (LAS unsigned*)(dst + c * 1024), 16, 0, 0);
}
#define AT_WAITV0() asm volatile("s_waitcnt vmcnt(0)" ::: "memory")
#define AT_BAR() do { asm volatile("s_waitcnt vmcnt(0) lgkmcnt(0)" ::: "memory"); __builtin_amdgcn_s_barrier(); asm volatile("" ::: "memory"); } while (0)

__device__ __forceinline__ f32x16 at_qk(const LAS unsigned char* kb, const bf16x8 (&qf)[8], int lane) {
    f32x16 p = {0.f, 0.f, 0.f, 0.f, 0.f, 0.f, 0.f, 0.f, 0.f, 0.f, 0.f, 0.f, 0.f, 0.f, 0.f, 0.f};
#pragma unroll
    for (int s = 0; s < 8; ++s) { const bf16x8 kf = *(const LAS bf16x8*)(kb + s * 1024 + lane * 16); p = __builtin_amdgcn_mfma_f32_32x32x16_bf16(kf, qf[s], p, 0, 0, 0); if (s == 3) __builtin_amdgcn_sched_barrier(0); }
    return p;
}
__device__ __forceinline__ void at_pv(f32x16 (&o)[4], const f32x16& e, const LAS unsigned char* vb, int lane) {
#pragma unroll
    for (int ks = 0; ks < 2; ++ks) {
        u32x4 w; w.x = cvtpk(e[8 * ks + 0], e[8 * ks + 1]); w.y = cvtpk(e[8 * ks + 2], e[8 * ks + 3]); w.z = cvtpk(e[8 * ks + 4], e[8 * ks + 5]); w.w = cvtpk(e[8 * ks + 6], e[8 * ks + 7]);
        const bf16x8 pf = __builtin_bit_cast(bf16x8, w);
#pragma unroll
        for (int dt = 0; dt < 4; ++dt) { const bf16x8 vf = *(const LAS bf16x8*)(vb + (ks * 4 + dt) * 1024 + lane * 16); o[dt] = __builtin_amdgcn_mfma_f32_32x32x16_bf16(pf, vf, o[dt], 0, 0, 0); }
    }
}
template <int MODE> __device__ __forceinline__ float at_exp(f32x16& p, int tok, int key0  , int hi, const LAS float* bias_g, float b31, int maxrel, bool keep) {
    float sum = 0.f;
#pragma unroll
    for (int r = 0; r < 16; ++r) {
        float e;
        if (MODE == 0) e = __builtin_amdgcn_exp2f(p[r] + b31);
        else { const int rel = tok - (key0 + crow(r, hi)); const bool ok = rel >= 0 && rel < maxrel; const int ix = rel < 0 ? 0 : (rel > 128 ? 128 : rel); e = ok ? __builtin_amdgcn_exp2f(p[r] + bias_g[ix]) : 0.f; }
        e = keep ? e : 0.f; p[r] = e; sum += e;
    }
    return sum;
}

__device__ __forceinline__ void load_q_frags(bf16x8 (&qf)[8], const float* qrow, const float* qn_g, int hi) {
    f32x4 x[8], y[8]; float ss = 0.f;
#pragma unroll
    for (int s = 0; s < 8; ++s) { x[s] = *(const f32x4*)(qrow + 16 * s + 8 * hi); y[s] = *(const f32x4*)(qrow + 16 * s + 8 * hi + 4);
        ss += (x[s][0] * x[s][0] + x[s][1] * x[s][1]) + (x[s][2] * x[s][2] + x[s][3] * x[s][3]) + (y[s][0] * y[s][0] + y[s][1] * y[s][1]) + (y[s][2] * y[s][2] + y[s][3] * y[s][3]); }
    ss += __shfl_xor(ss, 32);
    const float r = rsqrtf(ss * (1.0f / 128) + EPS) * (0.08838834764831845f * LOG2E);
#pragma unroll
    for (int s = 0; s < 8; ++s) { const f32x4 g0 = *(const f32x4*)(qn_g + 16 * s + 8 * hi), g1 = *(const f32x4*)(qn_g + 16 * s + 8 * hi + 4);
        u32x4 w; w.x = cvtpk(x[s][0] * g0[0] * r, x[s][1] * g0[1] * r); w.y = cvtpk(x[s][2] * g0[2] * r, x[s][3] * g0[3] * r); w.z = cvtpk(y[s][0] * g1[0] * r, y[s][1] * g1[1] * r); w.w = cvtpk(y[s][2] * g1[2] * r, y[s][3] * g1[3] * r);
        qf[s] = __builtin_bit_cast(bf16x8, w); }
}
__device__ __forceinline__ void at_stage_tile(LAS unsigned char* slot, const bf16* Kf, const bf16* Vf, int j, int wave, int lane) {
#pragma unroll
    for (int c = 0; c < 2; ++c) { const int ch = wave + 8 * c;
        __builtin_amdgcn_global_load_lds((const unsigned*)((const char*)(Kf + (size_t)j * 8192) + ch * 1024 + lane * 16), (LAS unsigned*)(slot + ch * 1024), 16, 0, 0);
        __builtin_amdgcn_global_load_lds((const unsigned*)((const char*)(Vf + (size_t)j * 8192) + ch * 1024 + lane * 16), (LAS unsigned*)(slot + 16384 + ch * 1024), 16, 0, 0); }
}
__device__ __forceinline__ void attn_prompt_unit(const AttnP& P0, int b, int kv, int i, LAS unsigned char* lds, int wave, int lane0) {
    int lane = lane0; asm volatile("" : "+v"(lane));
    AttnP P = P0;
    asm volatile("" : "+s"(P.QBr), "+s"(P.qn_g), "+s"(P.KSf), "+s"(P.VSf), "+s"(P.KWf), "+s"(P.VWf), "+s"(P.KCf), "+s"(P.VCf));
    asm volatile("" : "+s"(P.gates), "+s"(P.relb), "+s"(P.OB), "+s"(P.OT));
    const int rg = wave & 3, par = wave >> 2, q = lane & 31, hi = lane >> 5, tid = wave * 64 + lane;
    const int tok = 32 * i + 8 * rg + (q >> 2), g = q & 3, head = kv * 4 + g, cur = i >> 1;
    const size_t row = (size_t)b * TP + tok;
    LAS float* biasT = (LAS float*)(lds + AL_BIAS); LAS float* lx = (LAS float*)(lds + AL_LX); LAS float* fx = (LAS float*)(lds + AL_FX); LAS unsigned* selw = (LAS unsigned*)(lds + AL_SEL);
    LAS float* impA = (LAS float*)(lds + AL_IMPA); LAS float* impB = (LAS float*)(lds + AL_IMPB); LAS float* scT = (LAS float*)(lds + AL_SCT);
    for (int u = tid; u < 4 * 129; u += NTHR) { const int gg = u / 129, r = u % 129; biasT[gg * 132 + r] = P.relb[rel_bucket(r) * 8 + kv * 4 + gg] * LOG2E; }
    bf16x8 qf[8];
    load_q_frags(qf, P.QBr + row * LQ + head * 128, P.qn_g, hi);
    const float g0 = P.gates[row * 24 + head * 3 + 0], g1 = P.gates[row * 24 + head * 3 + 1], g2 = P.gates[row * 24 + head * 3 + 2];
    const LAS float* bias_g = biasT + g * 132;
    f32x16 ob[4], ot[4];
#pragma unroll
    for (int dt = 0; dt < 4; ++dt) { ob[dt] = (f32x16){0.f, 0.f, 0.f, 0.f, 0.f, 0.f, 0.f, 0.f, 0.f, 0.f, 0.f, 0.f, 0.f, 0.f, 0.f, 0.f}; ot[dt] = ob[dt]; }
    const size_t seqkv = (size_t)b * 2 + kv;

    {
        int nct = ((2 * i + 3) >> 6) + 1; nct = nct > 4 ? 4 : nct;
        dma_copy(lds, P.KCf + seqkv * 8 * 4096, nct * 16, wave, lane);
        dma_copy(lds + 65536, P.VCf + seqkv * 8 * 4096, nct * 16, wave, lane);
        AT_BAR();
        float lsum = 0.f;
#pragma unroll 1
        for (int t = 0; t < 2; ++t) {
            const int ct = par + 2 * t;
            if (ct < nct) {
#pragma unroll 1
                for (int sub = 0; sub < 2; ++sub) {
                    f32x16 sc = at_qk(lds + ct * 16384 + sub * 8192, qf, lane);
#pragma unroll
                    for (int r = 0; r < 16; ++r) { const int c = 64 * ct + 32 * sub + crow(r, hi); const int rel = tok - (16 * c + 31); const int ix = rel < 0 ? 0 : (rel > 128 ? 128 : rel);
                        const float e = rel >= 0 ? __builtin_amdgcn_exp2f(sc[r] + bias_g[ix]) : 0.f; lsum += e; }
                }
            }
        }
        lsum += __shfl_xor(lsum, 32);
        if (hi == 0) lx[wave * 32 + q] = lsum;
        AT_BAR();
        const float ltot = lx[rg * 32 + q] + lx[(rg + 4) * 32 + q];
        const float inv = 1.0f / fmaxf(ltot, 1e-30f);
#pragma unroll 1
        for (int t = 0; t < 2; ++t) {
            const int ct = par + 2 * t;
            if (ct < nct) {
#pragma unroll 1
                for (int sub = 0; sub < 2; ++sub) {
                    f32x16 sc = at_qk(lds + ct * 16384 + sub * 8192, qf, lane);
#pragma unroll
                    for (int r = 0; r < 16; ++r) { const int c = 64 * ct + 32 * sub + crow(r, hi); const int rel = tok - (16 * c + 31); const int ix = rel < 0 ? 0 : (rel > 128 ? 128 : rel);
                        sc[r] = (rel >= 0 ? __builtin_amdgcn_exp2f(sc[r] + bias_g[ix]) : 0.f) * inv; }
#pragma unroll
                    for (int m = 0; m < 4; ++m) { float sa = (sc[4 * m] + sc[4 * m + 1]) + (sc[4 * m + 2] + sc[4 * m + 3]), sb = sc[4 * m + 3];
                        sa += __shfl_xor(sa, 1); sa += __shfl_xor(sa, 2); sb += __shfl_xor(sb, 1); sb += __shfl_xor(sb, 2);
                        if (g == 0) { const int s = 16 * ct + 8 * sub + 2 * m + hi; impA[(8 * rg + (q >> 2)) * 64 + s] = sa; impB[(8 * rg + (q >> 2)) * 64 + s] = sb; } }
#pragma unroll
                    for (int r = 0; r < 16; ++r) sc[r] *= g0;
                    at_pv(ot, sc, lds + 65536 + ct * 16384 + sub * 8192, lane);
                }
            }
        }
        AT_BAR();
#pragma unroll 1
        for (int tt = 0; tt < 4; ++tt) {
            const int tl = 4 * wave + tt, s = lane; float score = -INFINITY;
            if (s <= cur) { const float a = impA[tl * 64 + s] + (s > 0 ? impB[tl * 64 + s - 1] : 0.f); const bool forced = (s == 0) || (s == cur) || (s == cur - 1); score = a + (forced ? 1.0e6f : 0.f); }
            scT[tl * 64 + s] = score;
        }
        asm volatile("s_waitcnt lgkmcnt(0)" ::: "memory"); __builtin_amdgcn_wave_barrier();
#pragma unroll 1
        for (int tt = 0; tt < 4; ++tt) {
            const int tl = 4 * wave + tt, s = lane; const float score = scT[tl * 64 + s]; int rank = 0;
#pragma unroll 2
            for (int t4 = 0; t4 < 16; ++t4) { const f32x4 u4 = *(const LAS f32x4*)(scT + tl * 64 + 4 * t4);
#pragma unroll
                for (int e = 0; e < 4; ++e) { const int t = 4 * t4 + e; rank += (u4[e] > score || (u4[e] == score && t < s)) ? 1 : 0; } }
            const unsigned long long m = __ballot(rank < 16);
            if (lane == 0) { selw[tl * 2] = (unsigned)m; selw[tl * 2 + 1] = (unsigned)(m >> 32); }
        }
        AT_BAR();
    }
    const unsigned long long smask = ((unsigned long long)selw[(8 * rg + (q >> 2)) * 2 + 1] << 32) | selw[(8 * rg + (q >> 2)) * 2];
    const float b31 = bias_g[128];
    const int t0 = 32 * i + 8 * rg;

#pragma unroll 1
    for (int br = 1; br <= 2; ++br) {
        const bf16* Kf = (br == 1 ? P.KSf : P.KWf) + seqkv * 128 * 4096; const bf16* Vf = (br == 1 ? P.VSf : P.VWf) + seqkv * 128 * 4096;
        const int j0 = (br == 1) ? 0 : ((32 * i >= 511) ? ((32 * i - 511) >> 6) : 0);
        const int ntile = cur - j0 + 1; const int maxrel = (br == 1) ? 0x40000000 : 512;
        float lsum = 0.f;
        at_stage_tile(lds, Kf, Vf, j0, wave, lane);
        if (ntile > 1) at_stage_tile(lds + 32768, Kf, Vf, j0 + 1, wave, lane);
        if (ntile > 2) at_stage_tile(lds + 65536, Kf, Vf, j0 + 2, wave, lane);
#pragma unroll 1
        for (int t = 0; t < ntile; ++t) {
            const int ahead = ntile - 1 - t;
            if (ahead >= 2) asm volatile("s_waitcnt vmcnt(8)" ::: "memory"); else if (ahead == 1) asm volatile("s_waitcnt vmcnt(4)" ::: "memory"); else asm volatile("s_waitcnt vmcnt(0)" ::: "memory");
            asm volatile("s_waitcnt lgkmcnt(0)" ::: "memory"); __builtin_amdgcn_s_barrier(); asm volatile("" ::: "memory");
            if (t + 3 < ntile) at_stage_tile(lds + ((t + 3) & 3) * 32768, Kf, Vf, j0 + t + 3, wave, lane);
            const int j = j0 + t;
            const bool keep = (br == 1) ? (((smask >> j) & 1ull) != 0ull) : true;
            const int relmin = t0 - (64 * j + 63), relmax = t0 + 7 - 64 * j;
            const bool skip = (br == 2) && (relmin > 511);
            if (__ballot(keep) != 0ull && !skip) {
                const LAS unsigned char* kb = lds + (t & 3) * 32768 + par * 8192; const LAS unsigned char* vb = kb + 16384;
                f32x16 p0 = at_qk(kb, qf, lane);
                if (relmin >= 128 && relmax < maxrel) lsum += at_exp<0>(p0, tok, 64 * j + 32 * par, hi, bias_g, b31, maxrel, keep);
                else lsum += at_exp<1>(p0, tok, 64 * j + 32 * par, hi, bias_g, b31, maxrel, keep);
                at_pv(ob, p0, vb, lane);
            }
        }
        lsum += __shfl_xor(lsum, 32);
        if (hi == 0) lx[wave * 32 + q] = lsum;
        AT_BAR();
        { const float ltot = lx[rg * 32 + q] + lx[(rg + 4) * 32 + q]; const float f = (br == 1 ? g1 : g2) / fmaxf(ltot, 1e-30f); if (hi == 0) fx[wave * 32 + q] = f; }
        asm volatile("s_waitcnt lgkmcnt(0)" ::: "memory"); __builtin_amdgcn_wave_barrier();
#pragma unroll
        for (int m = 0; m < 4; ++m) { const f32x4 fv = *(const LAS f32x4*)(fx + wave * 32 + 8 * m + 4 * hi);
#pragma unroll
            for (int dt = 0; dt < 4; ++dt)
#pragma unroll
                for (int e = 0; e < 4; ++e) { ot[dt][4 * m + e] += fv[e] * ob[dt][4 * m + e]; ob[dt][4 * m + e] = 0.f; } }
        AT_BAR();
        if (br == 1) {   }
    }
    LAS float* obuf = (LAS float*)lds;
    if (par == 1) {
#pragma unroll
        for (int dt = 0; dt < 4; ++dt)
#pragma unroll
            for (int r = 0; r < 16; ++r) obuf[(rg * 32 + crow(r, hi)) * 128 + 32 * dt + q] = ot[dt][r];
    }
    AT_BAR();
    if (par == 0) {
#pragma unroll
        for (int dt = 0; dt < 4; ++dt)
#pragma unroll
            for (int r = 0; r < 16; ++r) { LAS float* o = obuf + (rg * 32 + crow(r, hi)) * 128 + 32 * dt + q; *o = *o + ot[dt][r]; }
    }
    AT_BAR();
    for (int u = tid; u < 2048; u += NTHR) {
        const int rr = u >> 4, ch = u & 15, rgg = rr >> 5, qq = rr & 31;
        const f32x4 a = *(const LAS f32x4*)(obuf + rr * 128 + ch * 8), c = *(const LAS f32x4*)(obuf + rr * 128 + ch * 8 + 4);
        u32x4 w; w.x = cvtpk(a[0], a[1]); w.y = cvtpk(a[2], a[3]); w.z = cvtpk(c[0], c[1]); w.w = cvtpk(c[2], c[3]);
        *(u32x4*)(P.OB + ((size_t)b * TP + 32 * i + 8 * rgg + (qq >> 2)) * 1024 + (kv * 4 + (qq & 3)) * 128 + ch * 8) = w;
    }
    AT_BAR();
}

__device__ __forceinline__ void prep_kv_tile(float* __restrict__ T, const float* __restrict__ gain, bf16* __restrict__ Kf, bf16* __restrict__ Vf, float* __restrict__ wout, int b, int kv, int Tt, int tid, float* kl  ) {
    const int key = tid >> 4, part = tid & 15, lane = tid & 63, x = tid >> 6, l31 = lane & 31, h = lane >> 5;
    float* rowp = T + ((size_t)b * TP + 32 * Tt + key) * 512 + kv * 128 + part * 8;
    f32x4 k0 = *(const f32x4*)rowp, k1 = *(const f32x4*)(rowp + 4);
    float ss = (k0[0] * k0[0] + k0[1] * k0[1]) + (k0[2] * k0[2] + k0[3] * k0[3]) + (k1[0] * k1[0] + k1[1] * k1[1]) + (k1[2] * k1[2] + k1[3] * k1[3]);
    ss += __shfl_xor(ss, 1); ss += __shfl_xor(ss, 2); ss += __shfl_xor(ss, 4); ss += __shfl_xor(ss, 8);
    const float r = rsqrtf(ss * (1.0f / 128) + EPS); const f32x4 g0 = *(const f32x4*)(gain + part * 8), g1 = *(const f32x4*)(gain + part * 8 + 4);
    k0 = k0 * g0 * r; k1 = k1 * g1 * r;
    *(f32x4*)rowp = k0; *(f32x4*)(rowp + 4) = k1;
    *(f32x4*)(kl + key * 132 + part * 8) = k0; *(f32x4*)(kl + key * 132 + part * 8 + 4) = k1;
    if (wout != nullptr) { float* wo = wout + (size_t)key * 512 + kv * 128 + part * 8; *(f32x4*)wo = k0; *(f32x4*)(wo + 4) = k1;
        *(f32x4*)(wo + 256) = *(const f32x4*)(rowp + 256); *(f32x4*)(wo + 260) = *(const f32x4*)(rowp + 260); }
    __syncthreads();
    { const float* s = kl + l31 * 132 + 16 * x + 8 * h; const f32x4 a0 = *(const f32x4*)s, a1 = *(const f32x4*)(s + 4);
      u32x4 w; w.x = cvtpk(a0[0], a0[1]); w.y = cvtpk(a0[2], a0[3]); w.z = cvtpk(a1[0], a1[1]); w.w = cvtpk(a1[2], a1[3]); *(u32x4*)(Kf + (size_t)(x * 64 + lane) * 8) = w; }
    { const int ks = x >> 2, dt = x & 3; const float* vb = T + ((size_t)b * TP + 32 * Tt) * 512 + 256 + kv * 128 + 32 * dt + l31; float v[8];
#pragma unroll
      for (int j = 0; j < 8; ++j) v[j] = vb[(size_t)(16 * ks + 8 * (j >> 2) + 4 * h + (j & 3)) * 512];
      u32x4 w; w.x = cvtpk(v[0], v[1]); w.y = cvtpk(v[2], v[3]); w.z = cvtpk(v[4], v[5]); w.w = cvtpk(v[6], v[7]); *(u32x4*)(Vf + (size_t)((ks * 4 + dt) * 64 + lane) * 8) = w; }
    __syncthreads();
}
__device__ __forceinline__ void prep_kv_sample(float* __restrict__ out, float* __restrict__ WINKV, const float* __restrict__ ks_g, const float* __restrict__ kw_g, int grp, int part) {
    const int which = grp >> 9, r = (grp >> 1) & 255, kv = grp & 1;
    float* rowp = (which == 0 ? out + O_SELS + (size_t)r * 512 : WINKV + ((size_t)MP + r) * 512) + kv * 128 + part * 8;
    f32x4 k0 = *(const f32x4*)rowp, k1 = *(const f32x4*)(rowp + 4);
    float ss = (k0[0] * k0[0] + k0[1] * k0[1]) + (k0[2] * k0[2] + k0[3] * k0[3]) + (k1[0] * k1[0] + k1[1] * k1[1]) + (k1[2] * k1[2] + k1[3] * k1[3]);
    ss += __shfl_xor(ss, 1); ss += __shfl_xor(ss, 2); ss += __shfl_xor(ss, 4); ss += __shfl_xor(ss, 8);
    const float* gain = which == 0 ? ks_g : kw_g;
    const float rr = rsqrtf(ss * (1.0f / 128) + EPS); const f32x4 g0 = *(const f32x4*)(gain + part * 8), g1 = *(const f32x4*)(gain + part * 8 + 4);
    k0 = k0 * g0 * rr; k1 = k1 * g1 * rr;
    *(f32x4*)rowp = k0; *(f32x4*)(rowp + 4) = k1;
    if (which == 1) { float* wo = out + O_WINS + ((size_t)(r >> 3) * 512 + 504 + (r & 7)) * 512 + kv * 128 + part * 8; *(f32x4*)wo = k0; *(f32x4*)(wo + 4) = k1;
        *(f32x4*)(wo + 256) = *(const f32x4*)(rowp + 256); *(f32x4*)(wo + 260) = *(const f32x4*)(rowp + 260); }
}
template <class SrcK, class SrcV> __device__ __forceinline__ void pack_tile(bf16* Kf, bf16* Vf, const SrcK& sk, const SrcV& sv, int tid) {
    const int lane = tid & 63, x = tid >> 6, l31 = lane & 31, h = lane >> 5;
    { const int s = x; u32x4 w; float v[8];
#pragma unroll
        for (int j = 0; j < 8; ++j) v[j] = sk(l31, 16 * s + 8 * h + j);
        w.x = cvtpk(v[0], v[1]); w.y = cvtpk(v[2], v[3]); w.z = cvtpk(v[4], v[5]); w.w = cvtpk(v[6], v[7]); *(u32x4*)(Kf + (size_t)(s * 64 + lane) * 8) = w; }
    { const int ks = x >> 2, dt = x & 3; u32x4 w; float v[8];
#pragma unroll
        for (int j = 0; j < 8; ++j) v[j] = sv(16 * ks + 8 * (j >> 2) + 4 * h + (j & 3), 32 * dt + l31);
        w.x = cvtpk(v[0], v[1]); w.y = cvtpk(v[2], v[3]); w.z = cvtpk(v[4], v[5]); w.w = cvtpk(v[6], v[7]); *(u32x4*)(Vf + (size_t)((ks * 4 + dt) * 64 + lane) * 8) = w; }
}
struct SrcRowsLim { const float* base; size_t stride; int lim; __device__ __forceinline__ float operator()(int key, int d) const { return key < lim ? base[(size_t)key * stride + d] : 0.f; } };

constexpr int XHC_ROWS = 32768, XHP_ROWS = 1280;
__device__ __forceinline__ void b_xhc_panel(const float* __restrict__ cache, const int* __restrict__ pt, bf16* __restrict__ panel, int L, int tid) {
    const int w = L >> 7, p = L & 127, b = p >> 2, lane16 = tid & 15, x = tid >> 4;
    const int ptv = pt[b * NPAGE + (p & 3) * 16 + lane16];
#pragma unroll 1
    for (int pg2 = 0; pg2 < 16; pg2 += 2) {
        const size_t base0 = (size_t)__builtin_amdgcn_readlane(ptv, pg2) * PAGE, base1 = (size_t)__builtin_amdgcn_readlane(ptv, pg2 + 1) * PAGE;
        f32x4 xa[16], ya[16];
#pragma unroll
        for (int i = 0; i < 16; ++i) {
            const int seg = (pg2 * 8 + i) * 32 + x; const int r = seg >> 4, j = seg & 15, n7 = (r >> 1) & 7, kv = r & 1;
            const float* s = cache + ((i < 8 ? base0 : base1) + n7 * 16 + j) * 512 + w * 256 + kv * 128 + lane16 * 8;
            xa[i] = *(const f32x4*)s; ya[i] = *(const f32x4*)(s + 4);
        }
#pragma unroll
        for (int i = 0; i < 16; ++i) {
            const int seg = (pg2 * 8 + i) * 32 + x; const int r = seg >> 4, j = seg & 15;
            u32x4 o; o.x = cvtpk(xa[i][0], xa[i][1]); o.y = cvtpk(xa[i][2], xa[i][3]); o.z = cvtpk(ya[i][0], ya[i][1]); o.w = cvtpk(ya[i][2], ya[i][3]);
            *(u32x4*)(panel + (size_t)r * 2048 + j * 128 + lane16 * 8) = o;
        }
    }
}
struct OneOrder {
    int pn;
    __device__ __forceinline__ bool next(int i, pg8::Unit& u) const { if (i > 0) return false; u.pm = 0; u.pn = pn; u.k0 = 0; u.nt = 32; u.sel = 0; return true; }
    __device__ __forceinline__ void a_ready(const pg8::Unit&) const {}
    __device__ __forceinline__ void done(const pg8::Unit&) const {}
};
struct DiagOrder {
    int n, per, G, c;
    __device__ __forceinline__ bool next(int i, pg8::Unit& u) const { const int L = i * G + c; if (L >= n) return false; u.pm = L; u.pn = L / per; u.k0 = 0; u.nt = 32; u.sel = 0; return true; }
    __device__ __forceinline__ void a_ready(const pg8::Unit&) const {}
    __device__ __forceinline__ void done(const pg8::Unit&) const {}
};
struct FStorePre { float* C; int rowoff, pad; __device__ __forceinline__ void operator()(int r, int c, f32x4 v) const { *(f32x4*)(C + (size_t)(rowoff + r) * 256 + (c & 255)) = v; } };
struct CmpW { const float *kw1, *kb1, *kw2, *vw1, *vb1, *vw2, *kc_g; };
__device__ __forceinline__ void b_cfin(const float* __restrict__ PREC, const float* __restrict__ PREP, const CmpW& cw, float* __restrict__ KCP, float* __restrict__ VCP, float* __restrict__ KCS, float* __restrict__ VCS,
                                       int grp, int tid, float* hid, float* red) {
    const int NP = 2040;
    float* dst[4]; int w = 0;
#pragma unroll
    for (int r4 = 0; r4 < 4; ++r4) {
        int x = grp * 4 + r4; bool pr; int b, i, kv; const float *p0, *p1;
        if (x < NP) { pr = true; kv = x & 1; x >>= 1; i = x % 255; x /= 255; b = x & 1; w = x >> 1;
            p0 = PREP + ((size_t)w * XHP_ROWS + ((size_t)b * 256 + i) * 2 + kv) * 256; p1 = PREP + ((size_t)w * XHP_ROWS + ((size_t)b * 256 + i + 1) * 2 + kv) * 256 + 128; }
        else { x -= NP; pr = false; kv = x & 1; x >>= 1; i = x & 511; x >>= 9; b = x & 31; w = x >> 5;
            p0 = PREC + ((size_t)w * XHC_ROWS + ((size_t)b * 512 + i) * 2 + kv) * 256;
            p1 = (i < 511) ? PREC + ((size_t)w * XHC_ROWS + ((size_t)b * 512 + i + 1) * 2 + kv) * 256 + 128 : PREP + ((size_t)w * XHP_ROWS + 1024 + b * 2 + kv) * 256 + 128; }
        const float* b1 = w ? cw.vb1 : cw.kb1;
        hid[r4 * 128 + tid] = siluf_(p0[tid] + p1[tid] + b1[tid]);
        dst[r4] = pr ? (w ? VCP : KCP) + (((size_t)b * 256 + i) * 2 + kv) * 128 : (w ? VCS : KCS) + (((size_t)b * 512 + i) * 2 + kv) * 128;
    }
    __syncthreads();
    const float* w2 = w ? cw.vw2 : cw.kw2;
    float o[4] = {0.f, 0.f, 0.f, 0.f};
    for (int k = 0; k < 128; ++k) { const float wv = w2[k * 128 + tid];
#pragma unroll
        for (int r4 = 0; r4 < 4; ++r4) o[r4] += hid[r4 * 128 + k] * wv; }
#pragma unroll
    for (int r4 = 0; r4 < 4; ++r4) { const float ss = wave_sum(o[r4] * o[r4]); if ((tid & 63) == 0) red[r4 * 2 + (tid >> 6)] = ss; }
    __syncthreads();
#pragma unroll
    for (int r4 = 0; r4 < 4; ++r4) { float v = o[r4]; if (w == 0) v = v * rsqrtf((red[r4 * 2] + red[r4 * 2 + 1]) * (1.0f / 128) + EPS) * cw.kc_g[tid]; dst[r4][tid] = v; }
    __syncthreads();
}

__device__ __forceinline__ void b_cfin_mfma(const float* __restrict__ PREC, const float* __restrict__ PREP, const bf16* __restrict__ W2T, const CmpW& cw,
                                            bf16* __restrict__ KCf, bf16* __restrict__ VCf, float* __restrict__ KCS, float* __restrict__ VCS, int item, int lane) {
    const int l31 = lane & 31, hi = lane >> 5;
    int x, xmax;
    if (item < 64) { const int w0 = item >> 5; x = 1020 * w0 + 32 * (item & 31) + l31; xmax = 1020 * w0 + 1019; } else { x = 2040 + 32 * (item - 64) + l31; xmax = 2040 + 65535; }
    const bool valid = x <= xmax; x = valid ? x : xmax;
    bool pr; int b, i, kv, w; const float *p0, *p1; float* dst;
    if (x < 2040) { int y = x; pr = true; kv = y & 1; y >>= 1; i = y % 255; y /= 255; b = y & 1; w = y >> 1;
        p0 = PREP + ((size_t)w * XHP_ROWS + ((size_t)b * 256 + i) * 2 + kv) * 256; p1 = PREP + ((size_t)w * XHP_ROWS + ((size_t)b * 256 + i + 1) * 2 + kv) * 256 + 128;
        dst = nullptr; }
    else { int y = x - 2040; pr = false; kv = y & 1; y >>= 1; i = y & 511; y >>= 9; b = y & 31; w = y >> 5;
        p0 = PREC + ((size_t)w * XHC_ROWS + ((size_t)b * 512 + i) * 2 + kv) * 256;
        p1 = (i < 511) ? PREC + ((size_t)w * XHC_ROWS + ((size_t)b * 512 + i + 1) * 2 + kv) * 256 + 128 : PREP + ((size_t)w * XHP_ROWS + 1024 + b * 2 + kv) * 256 + 128;
        dst = (w ? VCS : KCS) + (((size_t)b * 512 + i) * 2 + kv) * 128; }
    (void)pr;
    const int wu = __builtin_amdgcn_readfirstlane(w);
    const float* b1 = wu ? cw.vb1 : cw.kb1; const bf16* wt = W2T + (size_t)wu * 16384;
    f32x16 d[4];
#pragma unroll
    for (int cb = 0; cb < 4; ++cb) d[cb] = (f32x16){0.f, 0.f, 0.f, 0.f, 0.f, 0.f, 0.f, 0.f, 0.f, 0.f, 0.f, 0.f, 0.f, 0.f, 0.f, 0.f};
    f32x4 pa[16], pc[16];
#pragma unroll
    for (int s = 0; s < 8; ++s) { const int k0 = 16 * s + 8 * hi; pa[2 * s] = *(const f32x4*)(p0 + k0); pa[2 * s + 1] = *(const f32x4*)(p0 + k0 + 4); pc[2 * s] = *(const f32x4*)(p1 + k0); pc[2 * s + 1] = *(const f32x4*)(p1 + k0 + 4); }
#pragma unroll
    for (int s = 0; s < 8; ++s) {
        const int k0 = 16 * s + 8 * hi;
        const f32x4 a0 = pa[2 * s], a1 = pa[2 * s + 1], c0 = pc[2 * s], c1 = pc[2 * s + 1], e0 = *(const f32x4*)(b1 + k0), e1 = *(const f32x4*)(b1 + k0 + 4);
        u32x4 hw; hw.x = cvtpk(siluf_(a0[0] + c0[0] + e0[0]), siluf_(a0[1] + c0[1] + e0[1])); hw.y = cvtpk(siluf_(a0[2] + c0[2] + e0[2]), siluf_(a0[3] + c0[3] + e0[3]));
        hw.z = cvtpk(siluf_(a1[0] + c1[0] + e1[0]), siluf_(a1[1] + c1[1] + e1[1])); hw.w = cvtpk(siluf_(a1[2] + c1[2] + e1[2]), siluf_(a1[3] + c1[3] + e1[3]));
        const bf16x8 hf = __builtin_bit_cast(bf16x8, hw);
#pragma unroll
        for (int cb = 0; cb < 4; ++cb) { const bf16x8 wf = *(const bf16x8*)(wt + (size_t)(32 * cb + l31) * 128 + k0); d[cb] = __builtin_amdgcn_mfma_f32_32x32x16_bf16(wf, hf, d[cb], 0, 0, 0); }
    }
    float rs = 1.0f;
    if (wu == 0) { float ss = 0.f;
#pragma unroll
        for (int cb = 0; cb < 4; ++cb)
#pragma unroll
            for (int r = 0; r < 16; ++r) ss += d[cb][r] * d[cb][r];
        ss += __shfl_xor(ss, 32); rs = rsqrtf(ss * (1.0f / 128) + EPS); }
    const bool prm = (item < 64);
    if (valid) {
#pragma unroll
        for (int cb = 0; cb < 4; ++cb)
#pragma unroll
            for (int m = 0; m < 4; ++m) { const int col = 32 * cb + 8 * m + 4 * hi; f32x4 o;
#pragma unroll
                for (int e = 0; e < 4; ++e) o[e] = d[cb][4 * m + e] * rs;
                if (wu == 0) { const f32x4 gg = *(const f32x4*)(cw.kc_g + col); o = o * gg; }
                if (!prm) *(f32x4*)(dst + col) = o;
                else { const int T = i >> 5, kl = i & 31; bf16* tb = (wu ? VCf : KCf) + (((size_t)b * 2 + kv) * 8 + T) * 4096;
                    if (wu == 0) { typedef unsigned u32x2v __attribute__((ext_vector_type(2))); u32x2v pk; pk.x = cvtpk(o[0], o[1]); pk.y = cvtpk(o[2], o[3]);
                        *(u32x2v*)(tb + (size_t)((2 * cb + (m >> 1)) * 64 + kl + 32 * (m & 1)) * 8 + 4 * hi) = pk; }
                    else { const int ks = kl >> 4, kk = kl & 15, hh = (kk >> 2) & 1, jj = (kk >> 3) * 4 + (kk & 3);
#pragma unroll
                        for (int e = 0; e < 4; ++e) { const int dcol = col + e; tb[(size_t)(((ks * 4 + (dcol >> 5)) * 64) + (dcol & 31) + 32 * hh) * 8 + jj] = f2bf(o[e]); } } }
            }
    }
}

constexpr int HG_QPP = 0, HG_KPP = 17408, HG_KET = 34816, HG_VT = 53248, HG_QSUM = 71680;
constexpr int HG_RS = 136, HG_TS = 72;
struct HgP { const bf16* QAb; const bf16* IAb; const bf16* GAs; const float* F; bf16* QS; float* OI; float* Lb; float* DEC; bf16* SPT; };

__device__ __forceinline__ bf16x8 hg_pack8(const float (&v)[16], int o) { u32x4 w; w.x = cvtpk(v[o], v[o + 1]); w.y = cvtpk(v[o + 2], v[o + 3]); w.z = cvtpk(v[o + 4], v[o + 5]); w.w = cvtpk(v[o + 6], v[o + 7]); return __builtin_bit_cast(bf16x8, w); }

__device__ __forceinline__ void hgrn_local(const HgP& P0, int item, LAS unsigned char* lds, int tid) {
    HgP P = P0; asm volatile("" : "+s"(P.QAb), "+s"(P.IAb), "+s"(P.F), "+s"(P.QS), "+s"(P.OI), "+s"(P.Lb), "+s"(P.DEC));
    const int b = item >> 9, h = (item >> 6) & 7, c = item & 63; const size_t row0 = (size_t)b * TP + 64 * c;
    const int lane = tid & 63, wave = __builtin_amdgcn_readfirstlane(tid >> 6), l31 = lane & 31, hi = lane >> 5;
    const int k0 = 2 * lane, to = wave;
    LAS bf16* QPP = (LAS bf16*)(lds + HG_QPP); LAS bf16* KPP = (LAS bf16*)(lds + HG_KPP); LAS bf16* KET = (LAS bf16*)(lds + HG_KET); LAS bf16* VT = (LAS bf16*)(lds + HG_VT);
    LAS float* qsum = (LAS float*)(lds + HG_QSUM);
    f32x2 fk[8]; unsigned q2[8], v2[8];
#pragma unroll
    for (int i = 0; i < 8; ++i) { const size_t r = (row0 + 8 * to + i) * LQ + h * 128 + k0; fk[i] = *(const f32x2*)(P.F + r); q2[i] = *(const unsigned*)(P.QAb + r); v2[i] = *(const unsigned*)(P.IAb + r); }
    float bl0[8], bl1[8];
    { float r0 = 0.f, r1 = 0.f;
#pragma unroll
        for (int i = 0; i < 8; ++i) { r0 += __logf(fk[i][0]); r1 += __logf(fk[i][1]); bl0[i] = r0; bl1[i] = r1; }
        *(LAS f32x2*)(qsum + to * 128 + k0) = (f32x2){r0, r1}; }
    asm volatile("s_waitcnt lgkmcnt(0)" ::: "memory"); __builtin_amdgcn_s_barrier(); asm volatile("" ::: "memory");
    float pre0 = 0.f, pre1 = 0.f, bend0 = 0.f, bend1 = 0.f;
#pragma unroll
    for (int j = 0; j < 8; ++j) { const f32x2 s = *(const LAS f32x2*)(qsum + j * 128 + k0); bend0 += s[0]; bend1 += s[1]; pre0 += (j < to) ? s[0] : 0.f; pre1 += (j < to) ? s[1] : 0.f; }
    {
        float ke0[8], ke1[8];
#pragma unroll
        for (int i = 0; i < 8; ++i) {
            const int t = 8 * to + i; const float eb0 = pre0 + bl0[i], eb1 = pre1 + bl1[i];
            const float qa = bf2f((bf16)(q2[i] & 0xffffu)), qb = bf2f((bf16)(q2[i] >> 16)), ka = 1.0f - fk[i][0], kb = 1.0f - fk[i][1];
            *(unsigned*)(P.QS + (row0 + t) * 1024 + h * 128 + k0) = cvtpk(qa * __expf(eb0), qb * __expf(eb1));
            *(LAS unsigned*)(QPP + t * HG_RS + k0) = cvtpk(qa * __expf(fminf(eb0 - 0.5f * bend0, 80.f)), qb * __expf(fminf(eb1 - 0.5f * bend1, 80.f)));
            *(LAS unsigned*)(KPP + t * HG_RS + k0) = cvtpk(ka * __expf(fminf(0.5f * bend0 - eb0, 80.f)), kb * __expf(fminf(0.5f * bend1 - eb1, 80.f)));
            ke0[i] = ka * __expf(bend0 - eb0); ke1[i] = kb * __expf(bend1 - eb1);
        }
        { u32x4 w; w.x = cvtpk(ke0[0], ke0[1]); w.y = cvtpk(ke0[2], ke0[3]); w.z = cvtpk(ke0[4], ke0[5]); w.w = cvtpk(ke0[6], ke0[7]); *(LAS u32x4*)(KET + k0 * HG_TS + 8 * to) = w; }
        { u32x4 w; w.x = cvtpk(ke1[0], ke1[1]); w.y = cvtpk(ke1[2], ke1[3]); w.z = cvtpk(ke1[4], ke1[5]); w.w = cvtpk(ke1[6], ke1[7]); *(LAS u32x4*)(KET + (k0 + 1) * HG_TS + 8 * to) = w; }
        { u32x4 w; w.x = (v2[0] & 0xffffu) | (v2[1] << 16); w.y = (v2[2] & 0xffffu) | (v2[3] << 16); w.z = (v2[4] & 0xffffu) | (v2[5] << 16); w.w = (v2[6] & 0xffffu) | (v2[7] << 16); *(LAS u32x4*)(VT + k0 * HG_TS + 8 * to) = w; }
        { u32x4 w; w.x = (v2[0] >> 16) | (v2[1] & 0xffff0000u); w.y = (v2[2] >> 16) | (v2[3] & 0xffff0000u); w.z = (v2[4] >> 16) | (v2[5] & 0xffff0000u); w.w = (v2[6] >> 16) | (v2[7] & 0xffff0000u); *(LAS u32x4*)(VT + (k0 + 1) * HG_TS + 8 * to) = w; }
        if (to == 7) *(f32x2*)(P.DEC + (size_t)item * 128 + k0) = (f32x2){__expf(bend0), __expf(bend1)};
    }
    asm volatile("s_waitcnt lgkmcnt(0)" ::: "memory"); __builtin_amdgcn_s_barrier(); asm volatile("" ::: "memory");
    const int tb = (wave < 4) ? 1 : 0, vb = wave & 3;
    f32x16 z = {0.f, 0.f, 0.f, 0.f, 0.f, 0.f, 0.f, 0.f, 0.f, 0.f, 0.f, 0.f, 0.f, 0.f, 0.f, 0.f};
#pragma unroll 1
    for (int sb = 0; sb <= tb; ++sb) {
        f32x16 x = {0.f, 0.f, 0.f, 0.f, 0.f, 0.f, 0.f, 0.f, 0.f, 0.f, 0.f, 0.f, 0.f, 0.f, 0.f, 0.f};
#pragma unroll
        for (int st = 0; st < 8; ++st) { const bf16x8 af = *(const LAS bf16x8*)(KPP + (32 * sb + l31) * HG_RS + 16 * st + 8 * hi), bf = *(const LAS bf16x8*)(QPP + (32 * tb + l31) * HG_RS + 16 * st + 8 * hi);
            x = __builtin_amdgcn_mfma_f32_32x32x16_bf16(af, bf, x, 0, 0, 0); }
        if (sb == tb) {
#pragma unroll
            for (int r = 0; r < 16; ++r) x[r] = (crow(r, hi) <= l31) ? x[r] : 0.f;
        }
#pragma unroll
        for (int ks = 0; ks < 2; ++ks) {
            u32x4 w; w.x = cvtpk(x[8 * ks + 0], x[8 * ks + 1]); w.y = cvtpk(x[8 * ks + 2], x[8 * ks + 3]); w.z = cvtpk(x[8 * ks + 4], x[8 * ks + 5]); w.w = cvtpk(x[8 * ks + 6], x[8 * ks + 7]);
            typedef unsigned u32x2v __attribute__((ext_vector_type(2)));
            const LAS bf16* vp = VT + (32 * vb + l31) * HG_TS + 32 * sb + 16 * ks + 4 * hi;
            const u32x2v lo = *(const LAS u32x2v*)vp, hh = *(const LAS u32x2v*)(vp + 8);
            u32x4 vv; vv.x = lo.x; vv.y = lo.y; vv.z = hh.x; vv.w = hh.y;
            z = __builtin_amdgcn_mfma_f32_32x32x16_bf16(__builtin_bit_cast(bf16x8, w), __builtin_bit_cast(bf16x8, vv), z, 0, 0, 0);
        }
    }
    { float* o = P.OI + (row0 + 32 * tb) * 1024 + h * 128 + 32 * vb + l31;
#pragma unroll
        for (int r = 0; r < 16; ++r) o[(size_t)crow(r, hi) * 1024] = z[r]; }
    const int nt = (wave < 4) ? 1 : 3, t0 = (wave < 4) ? wave : 4 + 3 * (wave - 4);
#pragma unroll 1
    for (int ti = 0; ti < nt; ++ti) {
        const int kb = (t0 + ti) >> 2, vb2 = (t0 + ti) & 3;
        f32x16 d = {0.f, 0.f, 0.f, 0.f, 0.f, 0.f, 0.f, 0.f, 0.f, 0.f, 0.f, 0.f, 0.f, 0.f, 0.f, 0.f};
#pragma unroll
        for (int st = 0; st < 4; ++st) { const bf16x8 af = *(const LAS bf16x8*)(KET + (32 * kb + l31) * HG_TS + 16 * st + 8 * hi), bf = *(const LAS bf16x8*)(VT + (32 * vb2 + l31) * HG_TS + 16 * st + 8 * hi);
            d = __builtin_amdgcn_mfma_f32_32x32x16_bf16(af, bf, d, 0, 0, 0); }
        float* o = P.Lb + (size_t)item * 16384 + (size_t)(32 * kb) * 128 + 32 * vb2 + l31;
#pragma unroll
        for (int r = 0; r < 16; ++r) o[crow(r, hi) * 128] = d[r];
    }
    asm volatile("s_waitcnt lgkmcnt(0)" ::: "memory"); __builtin_amdgcn_s_barrier(); asm volatile("" ::: "memory");
}
__device__ __forceinline__ void hgrn_carry(const HgP& P, float* hg_out, int bh, int k, int v) {
    const float* lb = P.Lb + (size_t)bh * 64 * 16384 + (size_t)k * 128;
    const float* dc = P.DEC + (size_t)bh * 64 * 128 + k;
    bf16* sp = P.SPT + (size_t)bh * 64 * 16384 + (size_t)k * 128;
    float L[64], dd[64];
#pragma unroll
    for (int c = 0; c < 64; ++c) { L[c] = (lb + (size_t)c * 16384)[v]; dd[c] = dc[c * 128]; }
    float S = 0.f;
#pragma unroll
    for (int c = 0; c < 64; ++c) { (sp + (size_t)c * 16384)[v] = f2bf(S); S = dd[c] * S + L[c]; }
    hg_out[(size_t)bh * 16384 + (size_t)k * 128 + v] = S;
}
__device__ __forceinline__ void hgrn_output(const HgP& P0, const float* onorm0, bf16* OA0, int item, LAS unsigned char* lds, int tid) {
    HgP P = P0; const float* onorm = onorm0; bf16* OA = OA0; asm volatile("" : "+s"(P.GAs), "+s"(P.QS), "+s"(P.OI), "+s"(P.SPT), "+s"(onorm), "+s"(OA));
    const int b = item >> 9, h = (item >> 6) & 7, c = item & 63; const size_t row0 = (size_t)b * TP + 64 * c;
    const int lane = tid & 63, wave = __builtin_amdgcn_readfirstlane(tid >> 6), l31 = lane & 31, hi = lane >> 5, tb = wave >> 2, vb = wave & 3;
    f32x16 acc;
    { const float* o = P.OI + (row0 + 32 * tb) * 1024 + h * 128 + 32 * vb + l31;
#pragma unroll
        for (int r = 0; r < 16; ++r) acc[r] = o[(size_t)crow(r, hi) * 1024]; }
    LAS bf16* sl = (LAS bf16*)(lds + 40960);
#pragma unroll
    for (int c4 = 0; c4 < 4; ++c4) { const int e = (c4 * 512 + tid) * 8; *(LAS u32x4*)(sl + (e >> 7) * 136 + (e & 127)) = *(const u32x4*)(P.SPT + (size_t)item * 16384 + e); }
    asm volatile("s_waitcnt vmcnt(0) lgkmcnt(0)" ::: "memory"); __builtin_amdgcn_s_barrier(); asm volatile("" ::: "memory");
#pragma unroll
    for (int st = 0; st < 8; ++st) {
        const bf16x8 af = *(const bf16x8*)(P.QS + (row0 + 32 * tb + l31) * 1024 + h * 128 + 16 * st + 8 * hi);
        const LAS bf16* sp = sl + (16 * st + 8 * hi) * 136 + 32 * vb + l31;
        u32x4 w; w.x = (unsigned)sp[0] | ((unsigned)sp[136] << 16); w.y = (unsigned)sp[2 * 136] | ((unsigned)sp[3 * 136] << 16); w.z = (unsigned)sp[4 * 136] | ((unsigned)sp[5 * 136] << 16); w.w = (unsigned)sp[6 * 136] | ((unsigned)sp[7 * 136] << 16);
        acc = __builtin_amdgcn_mfma_f32_32x32x16_bf16(af, __builtin_bit_cast(bf16x8, w), acc, 0, 0, 0);
    }
    LAS float* ol = (LAS float*)lds;
#pragma unroll
    for (int r = 0; r < 16; ++r) ol[(32 * tb + crow(r, hi)) * 132 + 32 * vb + l31] = acc[r];
    asm volatile("s_waitcnt lgkmcnt(0)" ::: "memory"); __builtin_amdgcn_s_barrier(); asm volatile("" ::: "memory");
    {
        const int t = tid >> 3, sg = tid & 7; float o[16]; float ss = 0.f;
#pragma unroll
        for (int j = 0; j < 16; ++j) { o[j] = ol[t * 132 + 16 * sg + j]; ss += o[j] * o[j]; }
        ss += __shfl_xor(ss, 1); ss += __shfl_xor(ss, 2); ss += __shfl_xor(ss, 4);
        const float r = rsqrtf(ss * (1.0f / 128) + EPS); const bf16* g = P.GAs + (row0 + t) * LQ + h * 128 + 16 * sg; const float* on = onorm + h * 128 + 16 * sg;
#pragma unroll
        for (int j = 0; j < 16; ++j) o[j] = o[j] * r * on[j] * bf2f(g[j]);
        bf16* dst = OA + (row0 + t) * 1024 + h * 128 + 16 * sg;
        *(bf16x8*)dst = hg_pack8(o, 0); *(bf16x8*)(dst + 8) = hg_pack8(o, 8);
    }
    asm volatile("s_waitcnt lgkmcnt(0)" ::: "memory"); __builtin_amdgcn_s_barrier(); asm volatile("" ::: "memory");
}

constexpr int SA_IMP = AL_IMPA;
constexpr int SA_UL = AL_END;
constexpr int SA_SM = SA_UL + 136 * 4;
constexpr int SA_END = SA_SM + 8 * 5 * 4;
static_assert(SA_END <= LDS_BYTES, "sample attention LDS control region");
struct SAttnP { const float* QBr; const float* qn_g; const float* gates; const float* relb; const float* KCS; const float* VCS; const float* cache_sel; const float* cache_win; const int* pt; const float* selnew; const float* winkv; float* PART; };
struct STile { const float* kp; const float* vp; int stride; int kmax; int k0; };

__device__ __forceinline__ bf16x8 sa_kfrag(const float* rowp, int s, int hi) {
    const f32x4 a = *(const f32x4*)(rowp + 16 * s + 8 * hi), c = *(const f32x4*)(rowp + 16 * s + 8 * hi + 4);
    u32x4 w; w.x = cvtpk(a[0], a[1]); w.y = cvtpk(a[2], a[3]); w.z = cvtpk(c[0], c[1]); w.w = cvtpk(c[2], c[3]); return __builtin_bit_cast(bf16x8, w);
}
__device__ __forceinline__ f32x16 sa_qk(const STile& T, const bf16x8 (&qf)[8], int l31, int hi) {
    const int kl = l31 < T.kmax ? l31 : T.kmax; const float* rowp = T.kp + (size_t)kl * T.stride;
    f32x16 p = {0.f, 0.f, 0.f, 0.f, 0.f, 0.f, 0.f, 0.f, 0.f, 0.f, 0.f, 0.f, 0.f, 0.f, 0.f, 0.f};
#pragma unroll
    for (int s = 0; s < 8; ++s) p = __builtin_amdgcn_mfma_f32_32x32x16_bf16(sa_kfrag(rowp, s, hi), qf[s], p, 0, 0, 0);
    return p;
}
__device__ __forceinline__ void sa_pv(f32x16 (&o)[4], const f32x16& e, const STile& T, int l31, int hi) {
#pragma unroll
    for (int ks = 0; ks < 2; ++ks) {
        u32x4 w; w.x = cvtpk(e[8 * ks + 0], e[8 * ks + 1]); w.y = cvtpk(e[8 * ks + 2], e[8 * ks + 3]); w.z = cvtpk(e[8 * ks + 4], e[8 * ks + 5]); w.w = cvtpk(e[8 * ks + 6], e[8 * ks + 7]);
        const bf16x8 pf = __builtin_bit_cast(bf16x8, w);
        const float* rp[8];
#pragma unroll
        for (int j = 0; j < 8; ++j) { int key = 16 * ks + 8 * (j >> 2) + 4 * hi + (j & 3); key = key < T.kmax ? key : T.kmax; rp[j] = T.vp + (size_t)key * T.stride + l31; }
#pragma unroll
        for (int dt = 0; dt < 4; ++dt) {
            float v[8];
#pragma unroll
            for (int j = 0; j < 8; ++j) v[j] = rp[j][32 * dt];
            u32x4 x; x.x = cvtpk(v[0], v[1]); x.y = cvtpk(v[2], v[3]); x.z = cvtpk(v[4], v[5]); x.w = cvtpk(v[6], v[7]);
            o[dt] = __builtin_amdgcn_mfma_f32_32x32x16_bf16(pf, __builtin_bit_cast(bf16x8, x), o[dt], 0, 0, 0);
        }
    }
}
template <int BR> __device__ __forceinline__ float sa_exp(f32x16& p, int k0, int hi, int qoff, const LAS float* bias_g, bool keep) {
    float sum = 0.f;
#pragma unroll
    for (int r = 0; r < 16; ++r) {
        const int kidx = k0 + crow(r, hi); const int rel = (BR == 0) ? qoff - (16 * kidx + 31) : qoff - kidx;
        const bool ok = rel >= 0 && (BR != 2 || rel < 512) && keep; const int ix = rel < 0 ? 0 : (rel > 128 ? 128 : rel);
        const float e = ok ? __builtin_amdgcn_exp2f(p[r] + bias_g[ix]) : 0.f; p[r] = e; sum += e;
    }
    return sum;
}
__device__ __forceinline__ void sa_reduce_store(f32x16 (&o)[4], float lsum, float* part_br, LAS unsigned char* lds, int wave, int lane, bool zero_it) {
    const int l31 = lane & 31, hi = lane >> 5, tid = wave * 64 + lane;
    LAS float* ob = (LAS float*)lds;
    LAS float* lx = (LAS float*)(lds + AL_LX);
    lsum += __shfl_xor(lsum, 32);
    if (hi == 0) lx[wave * 32 + l31] = lsum;
#pragma unroll
    for (int dt = 0; dt < 4; ++dt)
#pragma unroll
        for (int r = 0; r < 16; ++r) ob[(wave * 32 + crow(r, hi)) * 128 + 32 * dt + l31] = o[dt][r];
    AT_BAR();
    for (int u = tid; u < 32 * 128; u += NTHR) { float s = 0.f;
#pragma unroll
        for (int w = 0; w < 8; ++w) s += ob[w * 4096 + u];
        part_br[(u >> 7) * 132 + (u & 127)] = zero_it ? 0.f : s; }
    if (tid < 32) { float s = 0.f;
#pragma unroll
        for (int w = 0; w < 8; ++w) s += lx[w * 32 + tid];
        part_br[tid * 132 + 128] = zero_it ? 0.f : s; }
    AT_BAR();
}

__device__ __forceinline__ void attn_sample_unit(const SAttnP& P0, int b, int kv, int part, LAS unsigned char* lds, int wave, int lane) {
    SAttnP P = P0;
    asm volatile("" : "+s"(P.QBr), "+s"(P.qn_g), "+s"(P.gates), "+s"(P.relb), "+s"(P.KCS), "+s"(P.VCS), "+s"(P.cache_sel));
    asm volatile("" : "+s"(P.cache_win), "+s"(P.pt), "+s"(P.selnew), "+s"(P.winkv), "+s"(P.PART));
    const int l31 = lane & 31, hi = lane >> 5, tid = wave * 64 + lane;
    const int t = l31 >> 2, g = l31 & 3, head = kv * 4 + g, qpos = PAST + t;
    const size_t row = (size_t)MP + b * TS + t;
    LAS float* biasT = (LAS float*)(lds + AL_BIAS); LAS float* lx = (LAS float*)(lds + AL_LX); LAS float* imp = (LAS float*)(lds + SA_IMP);
    LAS int* ulist = (LAS int*)(lds + SA_UL); LAS unsigned* smw = (LAS unsigned*)(lds + SA_SM);
    for (int u = tid; u < 4 * 129; u += NTHR) { const int gg = u / 129, r = u % 129; biasT[gg * 132 + r] = P.relb[rel_bucket(r) * 8 + kv * 4 + gg] * LOG2E; }
    bf16x8 qf[8];
    load_q_frags(qf, P.QBr + row * LQ + head * 128, P.qn_g, hi);
    const LAS float* bias_g = biasT + g * 132;
    float* pbuf = P.PART + (((size_t)b * 2 + kv) * 4 + part) * (3 * 32 * 132);
    f32x16 o[4];
#pragma unroll
    for (int dt = 0; dt < 4; ++dt) o[dt] = (f32x16){0.f, 0.f, 0.f, 0.f, 0.f, 0.f, 0.f, 0.f, 0.f, 0.f, 0.f, 0.f, 0.f, 0.f, 0.f, 0.f};
    AT_BAR();
    {
        float lsum = 0.f;
#pragma unroll 1
        for (int u = 2 * wave; u < 2 * wave + 2; ++u) {
            STile T; T.kp = P.KCS + (((size_t)b * 512 + 32 * u) * 2 + kv) * 128; T.vp = nullptr; T.stride = 256; T.kmax = 31; T.k0 = 32 * u;
            f32x16 sc = sa_qk(T, qf, l31, hi); lsum += sa_exp<0>(sc, T.k0, hi, qpos, bias_g, true);
        }
        lsum += __shfl_xor(lsum, 32);
        if (hi == 0) lx[wave * 32 + l31] = lsum;
        AT_BAR();
        float ltot = 0.f;
#pragma unroll
        for (int w = 0; w < 8; ++w) ltot += lx[w * 32 + l31];
        const float inv = 1.0f / fmaxf(ltot, 1e-30f);
        float lkeep = 0.f;
#pragma unroll 1
        for (int u = 2 * wave; u < 2 * wave + 2; ++u) {
            STile T; T.kp = P.KCS + (((size_t)b * 512 + 32 * u) * 2 + kv) * 128; T.vp = P.VCS + (((size_t)b * 512 + 32 * u) * 2 + kv) * 128; T.stride = 256; T.kmax = 31; T.k0 = 32 * u;
            f32x16 sc = sa_qk(T, qf, l31, hi); lkeep += sa_exp<0>(sc, T.k0, hi, qpos, bias_g, true);
#pragma unroll
            for (int r = 0; r < 16; ++r) { const float pn = sc[r] * inv; float v = pn + __shfl_xor(pn, 1); v += __shfl_xor(v, 2); if (g == 0) imp[t * 512 + T.k0 + crow(r, hi)] = v; }
            if (part == 0) sa_pv(o, sc, T, l31, hi);
        }
        AT_BAR();
        sa_reduce_store(o, lkeep, pbuf + 0 * (32 * 132), lds, wave, lane, part != 0);
#pragma unroll
        for (int dt = 0; dt < 4; ++dt) o[dt] = (f32x16){0.f, 0.f, 0.f, 0.f, 0.f, 0.f, 0.f, 0.f, 0.f, 0.f, 0.f, 0.f, 0.f, 0.f, 0.f, 0.f};
        {
            const int tk = wave; float sc3[3];
#pragma unroll
            for (int j = 0; j < 3; ++j) { const int s = lane + 64 * j; float v = -INFINITY;
                if (s <= 128) { float a = 0.f; const LAS float* ip = imp + tk * 512 + 4 * s; asm volatile("" : "+v"(ip));
#pragma unroll
                    for (int c = -1; c <= 3; ++c) if (4 * s + c >= 0 && 4 * s + c < 512) a += ip[c];
                    const bool forced = (s == 0) || (s == 128) || (s == 127); v = a + (forced ? 1.0e6f : 0.f); }
                sc3[j] = v; }
            int rk[3] = {0, 0, 0};
#pragma unroll 1
            for (int tt = 0; tt < 129; ++tt) { const float u = __shfl(tt < 64 ? sc3[0] : (tt < 128 ? sc3[1] : sc3[2]), tt & 63);
#pragma unroll
                for (int j = 0; j < 3; ++j) { const int s = lane + 64 * j; rk[j] += (u > sc3[j] || (u == sc3[j] && tt < s)) ? 1 : 0; } }
            const unsigned long long m0 = __ballot(rk[0] < 16), m1 = __ballot(rk[1] < 16), m2 = __ballot(rk[2] < 16 && lane == 0);
            if (lane == 0) { smw[tk * 5] = (unsigned)m0; smw[tk * 5 + 1] = (unsigned)(m0 >> 32); smw[tk * 5 + 2] = (unsigned)m1; smw[tk * 5 + 3] = (unsigned)(m1 >> 32); smw[tk * 5 + 4] = (unsigned)(m2 & 1ull); }
        }
        AT_BAR();
    }
    const unsigned long long s0 = ((unsigned long long)smw[t * 5 + 1] << 32) | smw[t * 5], s1 = ((unsigned long long)smw[t * 5 + 3] << 32) | smw[t * 5 + 2]; const unsigned s2 = smw[t * 5 + 4];
    int nblk;
    {
        unsigned long long u0 = 0ull, u1 = 0ull; unsigned u2 = 0u;
#pragma unroll
        for (int k = 0; k < 8; ++k) { u0 |= ((unsigned long long)smw[k * 5 + 1] << 32) | smw[k * 5]; u1 |= ((unsigned long long)smw[k * 5 + 3] << 32) | smw[k * 5 + 2]; u2 |= smw[k * 5 + 4]; }
        const int n0 = __popcll(u0), n1 = __popcll(u1); nblk = n0 + n1 + (int)(u2 & 1u);
        if (wave == 0) {
            const unsigned long long below = (lane == 0) ? 0ull : (~0ull >> (64 - lane));
            if ((u0 >> lane) & 1ull) ulist[__popcll(u0 & below)] = lane;
            if ((u1 >> lane) & 1ull) ulist[n0 + __popcll(u1 & below)] = 64 + lane;
            if (lane == 0 && (u2 & 1u)) ulist[n0 + n1] = 128;
        }
    }
    AT_BAR();
    {
        float lsum = 0.f; const int nmine = (nblk - part + 3) >> 2;
#pragma unroll 1
        for (int it = wave; it < 2 * nmine; it += 8) {
            const int s = ulist[part + 4 * (it >> 1)], sub = it & 1;
            if (s == 128 && sub == 1) continue;
            STile T;
            if (s < 128) { const size_t pg = (size_t)P.pt[b * NPAGE + (s >> 1)] * PAGE + (s & 1) * 64 + sub * 32; T.kp = P.cache_sel + pg * 512 + kv * 128; T.vp = T.kp + 256; T.stride = 512; T.kmax = 31; }
            else { T.kp = P.selnew + (size_t)b * TS * 512 + kv * 128; T.vp = T.kp + 256; T.stride = 512; T.kmax = 7; }
            T.k0 = 64 * s + 32 * sub;
            const bool keep = (s < 64) ? (((s0 >> s) & 1ull) != 0ull) : (s < 128 ? (((s1 >> (s - 64)) & 1ull) != 0ull) : ((s2 & 1u) != 0u));
            f32x16 sc = sa_qk(T, qf, l31, hi); lsum += sa_exp<1>(sc, T.k0, hi, qpos, bias_g, keep);
            sa_pv(o, sc, T, l31, hi);
        }
        sa_reduce_store(o, lsum, pbuf + 1 * (32 * 132), lds, wave, lane, false);
#pragma unroll
        for (int dt = 0; dt < 4; ++dt) o[dt] = (f32x16){0.f, 0.f, 0.f, 0.f, 0.f, 0.f, 0.f, 0.f, 0.f, 0.f, 0.f, 0.f, 0.f, 0.f, 0.f, 0.f};
    }
    {
        float lsum = 0.f;
#pragma unroll 1
        for (int u = part + 4 * wave; u < 17; u += 32) {
            STile T;
            if (u < 16) { T.kp = P.cache_win + ((size_t)b * 512 + 32 * u) * 512 + kv * 128; T.vp = T.kp + 256; T.stride = 512; T.kmax = 31; }
            else { T.kp = P.winkv + ((size_t)MP + b * TS) * 512 + kv * 128; T.vp = T.kp + 256; T.stride = 512; T.kmax = 7; }
            T.k0 = 32 * u;
            f32x16 sc = sa_qk(T, qf, l31, hi); lsum += sa_exp<2>(sc, T.k0, hi, 512 + t, bias_g, true);
            sa_pv(o, sc, T, l31, hi);
        }
        sa_reduce_store(o, lsum, pbuf + 2 * (32 * 132), lds, wave, lane, false);
    }
}
__device__ __forceinline__ void attn_sample_combine(const float* PART, const float* gates, bf16* OB, int idx  , int lane) {
    const int rl = idx >> 3, head = idx & 7, b = rl >> 3, t = rl & 7, kv = head >> 2, g = head & 3, r = t * 4 + g;
    const float* base = PART + ((size_t)b * 2 + kv) * 4 * (3 * 32 * 132);
    float acc0 = 0.f, acc1 = 0.f;
#pragma unroll
    for (int br = 0; br < 3; ++br) {
        float l = 0.f, a0 = 0.f, a1 = 0.f;
#pragma unroll
        for (int p = 0; p < 4; ++p) { const float* q = base + ((size_t)p * 3 + br) * (32 * 132) + r * 132; l += q[128]; a0 += q[lane]; a1 += q[lane + 64]; }
        const float f = gates[((size_t)MP + rl) * 24 + head * 3 + br] / fmaxf(l, 1e-30f); acc0 += f * a0; acc1 += f * a1;
    }
    OB[((size_t)MP + rl) * 1024 + head * 128 + lane] = f2bf(acc0); OB[((size_t)MP + rl) * 1024 + head * 128 + lane + 64] = f2bf(acc1);
}

constexpr size_t al256(size_t x) { return (x + 255) & ~(size_t)255; }
constexpr size_t WS_BAR = 0;
constexpr size_t WS_WT_IN = al256(WS_BAR + XCD_BAR_WORDS * 4);
constexpr size_t WS_WT_BA = al256(WS_WT_IN + (size_t)NPROJ * D * 2);
constexpr size_t WS_WT_BB = al256(WS_WT_BA + (size_t)D * 1024 * 2);
constexpr size_t WS_WT_OUT = al256(WS_WT_BB + (size_t)D * 1024 * 2);
constexpr size_t WS_WT_1 = al256(WS_WT_OUT + (size_t)D * D * 2);
constexpr size_t WS_WT_2 = al256(WS_WT_1 + (size_t)DFF * D * 2);
constexpr size_t WS_MODS = al256(WS_WT_2 + (size_t)D * DFF * 2);
constexpr size_t WS_H = al256(WS_MODS + (size_t)34 * NMOD * 4);
constexpr size_t WS_PROJ = al256(WS_H + (size_t)MT * D * 2);
constexpr size_t WS_WINKV = al256(WS_PROJ + (size_t)0);
constexpr size_t WS_QN = al256(WS_WINKV + (size_t)MT * 512 * 4);
constexpr size_t WS_F = al256(WS_QN + (size_t)0);
constexpr size_t WS_ORAW = al256(WS_F + (size_t)MT * LQ * 4);
constexpr size_t WS_OA = al256(WS_ORAW + (size_t)MT * 1024 * 4);
constexpr size_t WS_OB = al256(WS_OA + (size_t)MT * 1024 * 2);
constexpr size_t WS_KCP = al256(WS_OB + (size_t)MT * 1024 * 2);
constexpr size_t WS_VCP = al256(WS_KCP + (size_t)0);
constexpr size_t WS_KCS = al256(WS_VCP + (size_t)0);
constexpr size_t WS_VCS = al256(WS_KCS + (size_t)32 * 512 * 256 * 4);
constexpr size_t WS_PCMP = al256(WS_VCS + (size_t)32 * 512 * 256 * 4);
constexpr size_t WS_IDX = al256(WS_PCMP + (size_t)0);
constexpr size_t WS_OCMP = al256(WS_IDX + (size_t)0);
constexpr size_t WS_OSEL = al256(WS_OCMP + (size_t)0);
constexpr size_t WS_OWIN = al256(WS_OSEL + (size_t)0);
constexpr size_t WS_T = al256(WS_OWIN + (size_t)0);
constexpr size_t WS_MERGED = al256(WS_T + (size_t)MT * D * 4);
constexpr size_t WS_X1 = al256(WS_MERGED + (size_t)MT * D * 2);
constexpr size_t WS_U = al256(WS_X1 + (size_t)MT * D * 4);
constexpr size_t WS_QNB = al256(WS_U + (size_t)MT * DFF * 2);
constexpr size_t WS_GATES = al256(WS_QNB + (size_t)0);
constexpr size_t WS_KSF = al256(WS_GATES + (size_t)MT * 24 * 4);
constexpr size_t WS_VSF = al256(WS_KSF + (size_t)4 * 128 * 4096 * 2);
constexpr size_t WS_KWF = al256(WS_VSF + (size_t)4 * 128 * 4096 * 2);
constexpr size_t WS_VWF = al256(WS_KWF + (size_t)4 * 128 * 4096 * 2);
constexpr size_t WS_KCF = al256(WS_VWF + (size_t)4 * 128 * 4096 * 2);
constexpr size_t WS_VCF = al256(WS_KCF + (size_t)4 * 8 * 4096 * 2);
constexpr size_t WS_OT = al256(WS_VCF + (size_t)4 * 8 * 4096 * 2);
constexpr size_t WS_IMP = al256(WS_OT + (size_t)0);
constexpr size_t WS_XHC = al256(WS_IMP + (size_t)0);
constexpr size_t WS_XHP = al256(WS_XHC + (size_t)256 * 256 * 2048 * 2);
constexpr size_t WS_WC1T = al256(WS_XHP + (size_t)2 * XHP_ROWS * 2048 * 2);
constexpr size_t WS_PREC = al256(WS_WC1T + (size_t)512 * 2048 * 2);
constexpr size_t WS_PREP = al256(WS_PREC + (size_t)2 * XHC_ROWS * 256 * 4);
constexpr size_t WS_HQS = al256(WS_PREP + (size_t)2 * XHP_ROWS * 256 * 4);
constexpr size_t WS_HOI = al256(WS_HQS + (size_t)MP * 1024 * 2);
constexpr size_t WS_HLB = al256(WS_HOI + (size_t)MP * 1024 * 4);
constexpr size_t WS_HDEC = al256(WS_HLB + (size_t)1024 * 16384 * 4);
constexpr size_t WS_HSPT = al256(WS_HDEC + (size_t)1024 * 128 * 4);
constexpr size_t WS_PART = al256(WS_HSPT + (size_t)1024 * 16384 * 2);
constexpr size_t WS_SLAB = al256(WS_PART + (size_t)64 * 4 * 3 * 32 * 132 * 4);
constexpr size_t WS_MODP = al256(WS_SLAB + (size_t)16 * 256 * 2048 * 4);
constexpr size_t WS_QAB = al256(WS_MODP + (size_t)8 * 34 * NMOD * 4);
constexpr size_t WS_IAB = al256(WS_QAB + (size_t)MT * LQ * 2);
constexpr size_t WS_GAS = al256(WS_IAB + (size_t)MT * LQ * 2);
constexpr size_t WS_QBR = al256(WS_GAS + (size_t)MT * LQ * 2);
constexpr size_t WS_MGAB = al256(WS_QBR + (size_t)MT * LQ * 4);
constexpr size_t WS_MGBB = al256(WS_MGAB + (size_t)MT * LMG * 2);
constexpr size_t WS_W2T = al256(WS_MGBB + (size_t)MT * LMG * 2);
constexpr size_t WS_END = al256(WS_W2T + (size_t)2 * 16384 * 2);

struct Args { const void* in[32]; float* out; unsigned char* ws; int ph_lo, ph_hi; };

#define G_x_p ((const float*)a.in[0])
#define G_x_s ((const float*)a.in[1])
#define G_c_p ((const float*)a.in[2])
#define G_c_s ((const float*)a.in[3])
#define G_cache_cmp ((const float*)a.in[4])
#define G_cache_sel ((const float*)a.in[5])
#define G_cache_win ((const float*)a.in[6])
#define G_state ((const float*)a.in[7])
#define G_pt ((const int*)a.in[8])
#define G_lbl ((const float*)a.in[9])
#define G_relb ((const float*)a.in[10])
#define G_ada_w ((const float*)a.in[11])
#define G_ada_b ((const float*)a.in[12])
#define G_norm1 ((const float*)a.in[13])
#define G_norm2 ((const float*)a.in[14])
#define G_w_in ((const float*)a.in[15])
#define G_onorm ((const float*)a.in[16])
#define G_qn_g ((const float*)a.in[17])
#define G_ks_g ((const float*)a.in[19])
#define G_kw_g ((const float*)a.in[20])
#define G_w_ba ((const float*)a.in[27])
#define G_w_bb ((const float*)a.in[28])
#define G_w_out ((const float*)a.in[29])
#define G_w1 ((const float*)a.in[30])
#define G_w2 ((const float*)a.in[31])
#define G_Wt_in ((bf16*)(a.ws + WS_WT_IN))
#define G_Wt_ba ((bf16*)(a.ws + WS_WT_BA))
#define G_Wt_bb ((bf16*)(a.ws + WS_WT_BB))
#define G_Wt_out ((bf16*)(a.ws + WS_WT_OUT))
#define G_Wt_1 ((bf16*)(a.ws + WS_WT_1))
#define G_Wt_2 ((bf16*)(a.ws + WS_WT_2))
#define G_mods ((float*)(a.ws + WS_MODS))
#define G_H ((bf16*)(a.ws + WS_H))
#define G_proj ((float*)(a.ws + WS_PROJ))
#define G_winkv ((float*)(a.ws + WS_WINKV))
#define G_QN ((float*)(a.ws + WS_QN))
#define G_F ((float*)(a.ws + WS_F))
#define G_oraw ((float*)(a.ws + WS_ORAW))
#define G_OA ((bf16*)(a.ws + WS_OA))
#define G_OB ((bf16*)(a.ws + WS_OB))
#define G_KCP ((float*)(a.ws + WS_KCP))
#define G_VCP ((float*)(a.ws + WS_VCP))
#define G_KCS ((float*)(a.ws + WS_KCS))
#define G_VCS ((float*)(a.ws + WS_VCS))
#define G_PCMP ((float*)(a.ws + WS_PCMP))
#define G_IDX ((int*)(a.ws + WS_IDX))
#define G_OCMP ((float*)(a.ws + WS_OCMP))
#define G_OSEL ((float*)(a.ws + WS_OSEL))
#define G_OWIN ((float*)(a.ws + WS_OWIN))
#define G_QNb ((bf16*)(a.ws + WS_QNB))
#define G_GATES ((float*)(a.ws + WS_GATES))
#define G_KSf ((bf16*)(a.ws + WS_KSF))
#define G_VSf ((bf16*)(a.ws + WS_VSF))
#define G_KWf ((bf16*)(a.ws + WS_KWF))
#define G_VWf ((bf16*)(a.ws + WS_VWF))
#define G_KCf ((bf16*)(a.ws + WS_KCF))
#define G_VCf ((bf16*)(a.ws + WS_VCF))
#define G_T ((float*)(a.ws + WS_T))
#define G_MERGED ((bf16*)(a.ws + WS_MERGED))
#define G_X1 ((float*)(a.ws + WS_X1))
#define G_U ((bf16*)(a.ws + WS_U))
#define G_XHC ((bf16*)(a.ws + WS_XHC))
#define G_XHP ((bf16*)(a.ws + WS_XHP))
#define G_Wc1t ((bf16*)(a.ws + WS_WC1T))
#define G_PREC ((float*)(a.ws + WS_PREC))
#define G_PREP ((float*)(a.ws + WS_PREP))
#define G_out (a.out)
#define G_ws (a.ws)
#define lane ((int)__builtin_amdgcn_mbcnt_hi(~0u, __builtin_amdgcn_mbcnt_lo(~0u, 0u)))
#define wave (wave_s)
#define tid (wave_s * 64 + lane)
#define sub2 (wave_s >> 2)
#define lt2 ((wave_s & 3) * 64 + lane)
#define sub4 (wave_s >> 1)
#define lt4 ((wave_s & 1) * 64 + lane)
__global__ void __launch_bounds__(NTHR, 2) mk_fwd(Args a) {
    extern __shared__ __attribute__((aligned(16))) unsigned char lds[];
    const int G = gridDim.x, bid = blockIdx.x;
    const int wave_s = __builtin_amdgcn_readfirstlane((int)threadIdx.x >> 6);
    if (threadIdx.x < 4) ((unsigned*)(lds + LDS_CTL))[threadIdx.x] = 0u;
    __syncthreads();
    const int lo = a.ph_lo, hi = a.ph_hi;
    XcdBarrier bar; bar.bar = (unsigned*)(G_ws + WS_BAR); bar.x = 0; bar.st = nullptr;
    if (hi - lo > 1) bar = xcd_barrier_post((unsigned*)(G_ws + WS_BAR), (volatile LAS unsigned*)(lds + LDS_CTL), wave_s);
#define IN(k) (lo <= (k) && (k) < hi)
#define MK_HGP() HgP hp; hp.QAb = (const bf16*)(G_ws + WS_QAB); hp.IAb = (const bf16*)(G_ws + WS_IAB); hp.GAs = (const bf16*)(G_ws + WS_GAS); hp.F = G_F; hp.QS = (bf16*)(G_ws + WS_HQS); hp.OI = (float*)(G_ws + WS_HOI); hp.Lb = (float*)(G_ws + WS_HLB); hp.DEC = (float*)(G_ws + WS_HDEC); hp.SPT = (bf16*)(G_ws + WS_HSPT)
#define SEAM(k) do { if (IN(k) && IN((k) + 1)) xcd_barrier(bar, wave_s); } while (0)
    float* ldsf = (float*)lds;

    if (IN(PH_PRO)) {
        constexpr int T_IN = (NPROJ / 128) * (D / 128), T_BA = (D / 128) * (1024 / 128), T_OUT = (D / 128) * (D / 128), T_1 = (DFF / 128) * (D / 128), T_2 = (D / 128) * (DFF / 128), T_C = 4 * 16;
        constexpr int NT = T_IN + 2 * T_BA + T_OUT + T_1 + T_2 + T_C + 2;
        for (int it = bid; it < NT; it += G) {
            int r = it;
            if (r < T_IN) { const int nb = r % (NPROJ / 128), kb = r / (NPROJ / 128), n0 = nb * 128; const int c0 = win_col(n0); const int lim = n0 < C_GATE ? 128 : (n0 == C_GATE ? 24 : 0);
                b_transpose128(G_w_in, IN_COLS, c0 < 0 ? 0 : c0, lim, G_Wt_in, D, n0, kb * 128, tid, ldsf); continue; } r -= T_IN;
            if (r < T_BA) { b_transpose128(G_w_ba, D, (r % 16) * 128, 128, G_Wt_ba, 1024, (r % 16) * 128, (r / 16) * 128, tid, ldsf); continue; } r -= T_BA;
            if (r < T_BA) { b_transpose128(G_w_bb, D, (r % 16) * 128, 128, G_Wt_bb, 1024, (r % 16) * 128, (r / 16) * 128, tid, ldsf); continue; } r -= T_BA;
            if (r < T_OUT) { b_transpose128(G_w_out, D, (r % 16) * 128, 128, G_Wt_out, D, (r % 16) * 128, (r / 16) * 128, tid, ldsf); continue; } r -= T_OUT;
            if (r < T_1) { b_transpose128(G_w1, DFF, (r % 64) * 128, 128, G_Wt_1, D, (r % 64) * 128, (r / 64) * 128, tid, ldsf); continue; } r -= T_1;
            if (r < T_2) { b_transpose128(G_w2, D, (r % 16) * 128, 128, G_Wt_2, DFF, (r % 16) * 128, (r / 16) * 128, tid, ldsf); continue; } r -= T_2;
            if (r >= T_C) { const int w = r - T_C; b_transpose128(w ? (const float*)a.in[26] : (const float*)a.in[23], 128, 0, 128, (bf16*)(G_ws + WS_W2T) + (size_t)w * 16384, 128, 0, 0, tid, ldsf); continue; }
            { const int wh = r >> 4, kb = r & 15;
              b_transpose128((wh >> 1 ? (const float*)a.in[24] : (const float*)a.in[21]) + (size_t)(wh & 1) * 2048 * 128, 128, 0, 128, G_Wc1t + (size_t)wh * 128 * 2048, 2048, 0, kb * 128, tid, ldsf); }
        }
        for (size_t u = (size_t)bid * NTHR + tid; u < (size_t)2 * 4 * 8 * 4096 / 8; u += (size_t)G * NTHR) { bf16* z = u < (size_t)4 * 8 * 4096 / 8 ? G_KCf + u * 8 : G_VCf + (u - (size_t)4 * 8 * 4096 / 8) * 8; *(u32x4*)z = (u32x4){0u, 0u, 0u, 0u}; }
        for (size_t u = (size_t)bid * NTHR + tid; u < (size_t)2 * 256 * 2048 / 8; u += (size_t)G * NTHR) { const size_t w = u / (256 * 256), r = u % (256 * 256); *(u32x4*)(G_XHP + ((size_t)w * XHP_ROWS + 1024) * 2048 + r * 8) = (u32x4){0u, 0u, 0u, 0u}; }
        for (int it = G - 1 - bid; it < 192; it += G) b_mods_part(G_c_p, G_c_s, G_ada_w, (float*)(G_ws + WS_MODP), it % 24, it / 24, tid, ldsf);
    }
    SEAM(PH_PRO);
    if (IN(PH_MRED)) { const float* mp = (const float*)(G_ws + WS_MODP);
        for (int u = bid * NTHR + tid; u < 34 * NMOD; u += G * NTHR) { float s = G_ada_b[u % NMOD];
#pragma unroll
            for (int kc = 0; kc < 8; ++kc) s += mp[(size_t)kc * 34 * NMOD + u];
            G_mods[u] = s; } }
    SEAM(PH_MRED);
    if (IN(PH_NORM1)) { for (int row = bid * 2 + sub2; row < MT; row += G * 2) b_hnorm(G_x_p, G_x_s, G_norm1, G_mods, 0, 1, G_H, row, lt2, ldsf + sub2 * 4); }
    SEAM(PH_NORM1);
    if (IN(PH_INPROJ)) {
        pg8::Gemm g{G_H, G_Wt_in, MT, NPROJ, D, D, nullptr, nullptr};
        EpiInProj E; E.o.QAb = (bf16*)(G_ws + WS_QAB); E.o.F = G_F; E.o.IAb = (bf16*)(G_ws + WS_IAB); E.o.GAs = (bf16*)(G_ws + WS_GAS); E.o.QBr = (float*)(G_ws + WS_QBR); E.o.out = G_out; E.o.XHP = G_XHP; E.o.WINKV = G_winkv;
        E.o.MGAb = (bf16*)(G_ws + WS_MGAB); E.o.MGBb = (bf16*)(G_ws + WS_MGBB); E.o.GATES = G_GATES; E.o.lbl = G_lbl;
        const int ksplit = (bid >> 3) % 6;
        { RangeOrder<pg8::StaticOrder> S; S.B.init(MT, NPROJ, G, bid, D); S.i0 = 0; S.i1 = ksplit;
          pg8::gemm_phase<EpiInProj, RangeOrder<pg8::StaticOrder>, false>((PG8_LAS unsigned char*)lds, g, S, E, nullptr, wave_s); }
        { bf16* panel = G_XHC + (size_t)bid * 256 * 2048; const int L = bid;
          __syncthreads();
          b_xhc_panel(G_cache_cmp, G_pt, panel, L, tid);
          __syncthreads();
          pg8::Gemm gc{panel, G_Wc1t, 256, 512, 2048, 2048, nullptr, nullptr}; OneOrder S; S.pn = L >> 7; EpiGen<FStorePre> Ec; Ec.f.C = G_PREC; Ec.f.rowoff = L * 256; Ec.f.pad = 0; Ec.slab = nullptr; Ec.slab_n = 0; Ec.kslice = 1;
          pg8::gemm_phase<EpiGen<FStorePre>, OneOrder, false>((PG8_LAS unsigned char*)lds, gc, S, Ec, nullptr, wave_s); }
        { RangeOrder<pg8::StaticOrder> S; S.B.init(MT, NPROJ, G, bid, D); S.i0 = ksplit; S.i1 = 1 << 20;
          pg8::gemm_phase<EpiInProj, RangeOrder<pg8::StaticOrder>, false>((PG8_LAS unsigned char*)lds, g, S, E, nullptr, wave_s); }
    }
    SEAM(PH_INPROJ);
    if (IN(PH_MIX1)) {
        b_hgrn_seq_s((const bf16*)(G_ws + WS_QAB), (const bf16*)(G_ws + WS_IAB), G_F, G_state, G_oraw, G_out, bid, tid, ldsf, ldsf + 1024);
        const int NW = G - 10;
        if (bid < NW) for (int it = NW - 1 - bid; it < 1024; it += NW) { const int which = it >> 9, r = it & 511, b = r >> 8, kv = (r >> 7) & 1, Tt = r & 127; const size_t to = (((size_t)b * 2 + kv) * 128 + Tt) * 4096;
            float* wout = (which == 1 && Tt >= 112) ? G_out + O_WINP + ((size_t)b * 512 + 32 * (Tt - 112)) * 512 : nullptr;
            prep_kv_tile(which == 0 ? G_out + O_SELP : G_winkv, which == 0 ? G_ks_g : G_kw_g, (which == 0 ? G_KSf : G_KWf) + to, (which == 0 ? G_VSf : G_VWf) + to, wout, b, kv, Tt, tid, ldsf + 20480); }
        for (int it = bid; it < 32; it += G) prep_kv_sample(G_out, G_winkv, G_ks_g, G_kw_g, it * 32 + (tid >> 4), tid & 15);
        { const size_t n = (size_t)BS * 504 * 512 / 4;
          for (size_t i = (size_t)bid * NTHR + tid; i < n; i += (size_t)G * NTHR) { const size_t b = i / (504 * 128), r = i % (504 * 128); *(f32x4*)(G_out + O_WINS + b * 512 * 512 + r * 4) = *(const f32x4*)(G_cache_win + b * 512 * 512 + 8 * 512 + r * 4); } }
        { MK_HGP();
          if (bid < NW)
#pragma unroll 1
          for (int item = bid; item < 1024; item += NW) hgrn_local(hp, item, (LAS unsigned char*)lds, tid); }
        { pg8::Gemm g{G_XHP, G_Wc1t, 2 * XHP_ROWS, 512, 2048, 2048, nullptr, nullptr}; DiagOrder S; S.n = 10; S.per = 5; S.G = G; S.c = G - 1 - bid; EpiGen<FStorePre> E; E.f.C = G_PREP; E.f.rowoff = 0; E.f.pad = 0; E.slab = nullptr; E.slab_n = 0; E.kslice = 1;
          __syncthreads();
          pg8::gemm_phase<EpiGen<FStorePre>, DiagOrder, false>((PG8_LAS unsigned char*)lds, g, S, E, nullptr, wave_s); }
    }
    SEAM(PH_MIX1);
    if (IN(PH_CFIN)) {
        CmpW cw; cw.kw1 = (const float*)a.in[21]; cw.kb1 = (const float*)a.in[22]; cw.kw2 = (const float*)a.in[23]; cw.vw1 = (const float*)a.in[24]; cw.vb1 = (const float*)a.in[25]; cw.vw2 = (const float*)a.in[26]; cw.kc_g = (const float*)a.in[18];
        { MK_HGP();
          const int bh = bid >> 4, k = (bid & 15) * 8 + wave;
#pragma unroll 1
          for (int e = 0; e < 2; ++e) hgrn_carry(hp, G_out + O_HGP, bh, k, lane + 64 * e); }
        for (int item = bid * 8 + wave; item < 64 + 2048; item += G * 8) b_cfin_mfma(G_PREC, G_PREP, (const bf16*)(G_ws + WS_W2T), cw, G_KCf, G_VCf, G_KCS, G_VCS, item, lane);
    }
    SEAM(PH_CFIN);
    if (IN(PH_ATTN)) {
        for (int row = MP + bid * 2 + sub2; row < MT; row += G * 2) b_hgrn_out(G_oraw, (const bf16*)(G_ws + WS_GAS), G_onorm, G_OA, row, lt2);
        { MK_HGP();
#pragma unroll 1
          for (int item = bid; item < 1024; item += G) hgrn_output(hp, G_onorm, G_OA, item, (LAS unsigned char*)lds, tid); }
        AttnP P; P.QBr = (const float*)(G_ws + WS_QBR); P.qn_g = G_qn_g; P.KSf = G_KSf; P.VSf = G_VSf; P.KWf = G_KWf; P.VWf = G_VWf; P.KCf = G_KCf; P.VCf = G_VCf; P.gates = G_GATES; P.relb = G_relb; P.OB = G_OB; P.OT = (float*)(G_ws + WS_OT); P.IMP = (float*)(G_ws + WS_IMP);
#pragma unroll 1
        for (int k = 0; k < 2; ++k) { const int u = bid, bk = u & 3, m = u >> 2; attn_prompt_unit(P, bk >> 1, bk & 1, k ? m : 127 - m, (LAS unsigned char*)lds, wave, lane); }
    }
    SEAM(PH_ATTN);
    if (IN(PH_SATTN)) {
        SAttnP P; P.QBr = (const float*)(G_ws + WS_QBR); P.qn_g = G_qn_g; P.gates = G_GATES; P.relb = G_relb; P.KCS = G_KCS; P.VCS = G_VCS; P.cache_sel = G_cache_sel; P.cache_win = G_cache_win; P.pt = G_pt; P.selnew = G_out + O_SELS; P.winkv = G_winkv; P.PART = (float*)(G_ws + WS_PART);
        { const int u = bid; attn_sample_unit(P, u >> 3, (u >> 2) & 1, u & 3, (LAS unsigned char*)lds, wave, lane); }
    }
    SEAM(PH_SATTN);
    if (IN(PH_SCOMB)) { for (int idx = bid * 8 + wave; idx < 2048; idx += G * 8) attn_sample_combine((const float*)(G_ws + WS_PART), G_GATES, G_OB, idx, lane); }
    SEAM(PH_SCOMB);
#define SLABP(off) ((float*)(G_ws + WS_SLAB) + (size_t)(off))
    if (IN(PH_BR)) { pg8::Gemm g{G_OA, G_Wt_ba, MT, D, 1024, 1024, G_OB, G_Wt_bb}; PairOrder S; S.init(D, 1024, 4, G, bid);
        EpiBranch E; E.mga = (const bf16*)(G_ws + WS_MGAB); E.mgb = (const bf16*)(G_ws + WS_MGBB); E.T = G_T; E.merged = G_MERGED; E.slab = SLABP(0); E.kslice = 256; E.pad = 0;
        pg8::gemm_phase<EpiBranch, PairOrder, false>((PG8_LAS unsigned char*)lds, g, S, E, nullptr, wave_s); }
    SEAM(PH_BR);
    if (IN(PH_RMERGE)) {
        const float* sa = SLABP(0); const float* sb = SLABP(4 * 256 * 2048);
        for (int u = bid * NTHR + tid; u < 256 * 512; u += G * NTHR) { const int r = u >> 9, c = (u & 511) * 4; f32x4 x = {0.f, 0.f, 0.f, 0.f}, y = x;
#pragma unroll
            for (int ks = 0; ks < 4; ++ks) { x += *(const f32x4*)(sa + ((size_t)ks * 256 + r) * 2048 + c); y += *(const f32x4*)(sb + ((size_t)ks * 256 + r) * 2048 + c); }
            const ushort4 ga = *(const ushort4*)((const bf16*)(G_ws + WS_MGAB) + ((size_t)MP + r) * LMG + c), gb = *(const ushort4*)((const bf16*)(G_ws + WS_MGBB) + ((size_t)MP + r) * LMG + c); ushort4 o;
            o.x = f2bf(bf2f(ga.x) * x[0] + bf2f(gb.x) * y[0]); o.y = f2bf(bf2f(ga.y) * x[1] + bf2f(gb.y) * y[1]); o.z = f2bf(bf2f(ga.z) * x[2] + bf2f(gb.z) * y[2]); o.w = f2bf(bf2f(ga.w) * x[3] + bf2f(gb.w) * y[3]);
            *(ushort4*)(G_MERGED + ((size_t)MP + r) * D + c) = o; }
    }
    SEAM(PH_RMERGE);
    if (IN(PH_OUT)) { pg8::Gemm g{G_MERGED, G_Wt_out, MT, D, D, D, nullptr, nullptr}; MixOrder S; S.init(D, D, 8, G, bid); EpiGen<FRes1> E; E.f.xp = G_x_p; E.f.xs = G_x_s; E.f.mods = G_mods; E.f.X1 = G_X1; E.slab = SLABP(0); E.slab_n = D; E.kslice = 256;
        pg8::gemm_phase<EpiGen<FRes1>, MixOrder, false>((PG8_LAS unsigned char*)lds, g, S, E, nullptr, wave_s); }
    SEAM(PH_OUT);
    if (IN(PH_NORM2)) {
        for (int row = MP + bid * 2 + sub2; row < MT; row += G * 2) b_norm2_sample(G_x_s, SLABP(0), G_norm2, G_mods, G_X1, G_H, row, lt2, ldsf + sub2 * 4);
        for (int row = bid * 2 + sub2; row < MP; row += G * 2) b_hnorm(G_X1, G_X1 + (size_t)MP * D, G_norm2, G_mods, 3, 4, G_H, row, lt2, ldsf + sub2 * 4);
    }
    SEAM(PH_NORM2);
    if (IN(PH_MLP1)) { pg8::Gemm g{G_H, G_Wt_1, MT, DFF, D, D, nullptr, nullptr}; MixOrder S; S.init(DFF, D, 4, G, bid); EpiGen<FRelu2> E; E.f.U = G_U; E.slab = SLABP(0); E.slab_n = DFF; E.kslice = 512;
        pg8::gemm_phase<EpiGen<FRelu2>, MixOrder, false>((PG8_LAS unsigned char*)lds, g, S, E, nullptr, wave_s); }
    SEAM(PH_MLP1);
    if (IN(PH_RU)) {
        const float* su = SLABP(0);
        for (int u = bid * NTHR + tid; u < 256 * 2048; u += G * NTHR) { const int r = u >> 11, c = (u & 2047) * 4; f32x4 x = {0.f, 0.f, 0.f, 0.f};
#pragma unroll
            for (int ks = 0; ks < 4; ++ks) x += *(const f32x4*)(su + ((size_t)ks * 256 + r) * DFF + c);
            ushort4 o; float t; t = fmaxf(x[0], 0.f); o.x = f2bf(t * t); t = fmaxf(x[1], 0.f); o.y = f2bf(t * t); t = fmaxf(x[2], 0.f); o.z = f2bf(t * t); t = fmaxf(x[3], 0.f); o.w = f2bf(t * t);
            *(ushort4*)(G_U + ((size_t)MP + r) * DFF + c) = o; }
    }
    SEAM(PH_RU);
    if (IN(PH_MLP2)) { pg8::Gemm g{G_U, G_Wt_2, MT, D, DFF, DFF, nullptr, nullptr}; MixOrder S; S.init(D, DFF, 16, G, bid); EpiGen<FRes2> E; E.f.X1 = G_X1; E.f.mods = G_mods; E.f.out = G_out; E.slab = SLABP(0); E.slab_n = D; E.kslice = 512;
        pg8::gemm_phase<EpiGen<FRes2>, MixOrder, false>((PG8_LAS unsigned char*)lds, g, S, E, nullptr, wave_s); }
    SEAM(PH_MLP2);
    if (IN(PH_RY)) {
        const float* sy = SLABP(0);
        for (int u = bid * NTHR + tid; u < 256 * 512; u += G * NTHR) { const int r = u >> 9, c = (u & 511) * 4; f32x4 x = {0.f, 0.f, 0.f, 0.f};
#pragma unroll
            for (int ks = 0; ks < 16; ++ks) x += *(const f32x4*)(sy + ((size_t)ks * 256 + r) * 2048 + c);
            const f32x4 xv = *(const f32x4*)(G_X1 + ((size_t)MP + r) * D + c), g2 = *(const f32x4*)(G_mods + (size_t)modrow(MP + r) * NMOD + 5 * D + c);
            *(f32x4*)(G_out + ((size_t)MP + r) * D + c) = xv + g2 * x; }
    }
#undef SLABP
#undef IN
#undef SEAM
}
#undef G_x_p
#undef G_x_s
#undef G_c_p
#undef G_c_s
#undef G_cache_cmp
#undef G_cache_sel
#undef G_cache_win
#undef G_state
#undef G_pt
#undef G_lbl
#undef G_relb
#undef G_ada_w
#undef G_ada_b
#undef G_norm1
#undef G_norm2
#undef G_w_in
#undef G_onorm
#undef G_qn_g
#undef G_ks_g
#undef G_kw_g
#undef G_w_ba
#undef G_w_bb
#undef G_w_out
#undef G_w1
#undef G_w2
#undef G_Wt_in
#undef G_Wt_ba
#undef G_Wt_bb
#undef G_Wt_out
#undef G_Wt_1
#undef G_Wt_2
#undef G_mods
#undef G_H
#undef G_proj
#undef G_winkv
#undef G_QN
#undef G_F
#undef G_oraw
#undef G_OA
#undef G_OB
#undef G_KCP
#undef G_VCP
#undef G_KCS
#undef G_VCS
#undef G_PCMP
#undef G_IDX
#undef G_OCMP
#undef G_OSEL
#undef G_OWIN
#undef G_QNb
#undef G_GATES
#undef G_KSf
#undef G_VSf
#undef G_KWf
#undef G_VWf
#undef G_KCf
#undef G_VCf
#undef G_T
#undef G_MERGED
#undef G_X1
#undef G_U
#undef G_XHC
#undef G_XHP
#undef G_Wc1t
#undef G_PREC
#undef G_PREP
#undef G_out
#undef G_ws
#undef tid
#undef lane
#undef wave
#undef sub2
#undef lt2
#undef sub4
#undef lt4


#ifndef MK_N_LAUNCHES
#define MK_N_LAUNCHES 1
#endif
extern "C" void kernel_launch(void* const* d_in, const int* in_sizes, int n_in, void* d_out, int out_size, void* d_ws, size_t ws_size, hipStream_t stream) {
    (void)in_sizes; (void)out_size;
    static int grid = 0;
    if (grid == 0) {
        if (n_in != 32 || ws_size < WS_END) { fprintf(stderr, "kernel_launch: unexpected inputs (%d) or workspace (%zu < %zu)\n", n_in, ws_size, (size_t)WS_END); grid = -1; return; }
        int dev = 0, cus = 0, per_cu = 0;
        (void)hipGetDevice(&dev); (void)hipDeviceGetAttribute(&cus, hipDeviceAttributeMultiprocessorCount, dev);
        if (hipFuncSetAttribute((const void*)mk_fwd, hipFuncAttributeMaxDynamicSharedMemorySize, LDS_BYTES) != hipSuccess) { fprintf(stderr, "kernel_launch: hipFuncSetAttribute failed\n"); grid = -1; return; }
        if (hipOccupancyMaxActiveBlocksPerMultiprocessor(&per_cu, (const void*)mk_fwd, NTHR, LDS_BYTES) != hipSuccess || per_cu < 1) { fprintf(stderr, "kernel_launch: occupancy query says %d\n", per_cu); }
        (void)hipGetLastError();
        if (cus != 256) { fprintf(stderr, "kernel_launch: built for a 256-CU device, found %d CUs\n", cus); grid = -1; return; }
        grid = 256;
    }
    if (grid < 0) return;
    (void)hipMemsetAsync((char*)d_ws + WS_BAR, 0, XCD_BAR_WORDS * 4, stream);
    Args a{};
    for (int i = 0; i < 32; ++i) a.in[i] = d_in[i];
    a.out = (float*)d_out; a.ws = (unsigned char*)d_ws;
    if (MK_N_LAUNCHES == 1) { a.ph_lo = 0; a.ph_hi = N_PHASES; hipLaunchKernelGGL(mk_fwd, dim3(grid), dim3(NTHR), LDS_BYTES, stream, a); }
    else { for (int k = 0; k < N_PHASES; ++k) { a.ph_lo = k; a.ph_hi = k + 1; hipLaunchKernelGGL(mk_fwd, dim3(grid), dim3(NTHR), LDS_BYTES, stream, a); } }
}
```

```cpp
#include <hip/hip_runtime.h>
#include <stdint.h>
#include <math.h>
#include <cstdio>

namespace pg8 {
#define PG8_LAS __attribute__((address_space(3)))
typedef unsigned short bf16_t;
typedef short bf16x8 __attribute__((ext_vector_type(8)));
typedef float f32x4 __attribute__((ext_vector_type(4)));
typedef unsigned u32x4 __attribute__((ext_vector_type(4)));
constexpr int BM = 256, BK = 64, HALF = 128, HTB = HALF * BK * 2  , STAGE_BYTES = 8 * HTB, NXCD = 8, WGM = 8;

__host__ __device__ __forceinline__ int lds_byte(int r, int c) { const int st = (r >> 4) * 2 + (c >> 5), rr = r & 15, cc = c & 31, ob = rr * 64 + cc * 2; return st * 1024 + (ob ^ (((ob >> 9) & 1) << 5)); }
__host__ __device__ __forceinline__ void stage_rc(int b, int& R, int& C) { const int st = b / 1024, sb = b % 1024, swz = sb ^ (((sb >> 9) & 1) << 5); R = (st >> 1) * 16 + swz / 64; C = (st & 1) * 32 + (swz % 64) / 2; }
__host__ __device__ __forceinline__ int perm32(int rho) { const int n = rho >> 4, i = rho & 15; return 8 * (i >> 2) + 4 * n + (i & 3); }

struct Unit { int pm, pn, k0, nt, sel; };
struct Gemm { const bf16_t* A; const bf16_t* Bt; int M, N, K, ld; const bf16_t* A2; const bf16_t* Bt2; };

struct StaticOrder {
    int nM, nN, nwg, G, c, nt0;
    __host__ __device__ void init(int M, int N, int G_, int c_, int K_ = 0) { nM = M / BM; nN = N / BM; nwg = nM * nN; G = G_; c = c_; nt0 = K_ / BK; }
    __host__ __device__ bool next(int i, Unit& u) const {
        const long L = (long)i * G + c; if (L >= nwg) return false;
        int wgid = (int)L; { const int q = nwg / NXCD, r = nwg % NXCD, xcd = wgid % NXCD, off = wgid / NXCD; wgid = (xcd < r ? xcd * (q + 1) : r * (q + 1) + (xcd - r) * q) + off; }
        const int nig = WGM * nN, gid = wgid / nig, fm = gid * WGM, gsz = (nM - fm) < WGM ? (nM - fm) : WGM;
        u.pm = fm + ((wgid % nig) % gsz); u.pn = (wgid % nig) / gsz; u.k0 = 0; u.nt = nt0; u.sel = 0; return true;
    }
    __device__ __forceinline__ void a_ready(const Unit&) const {}
    __device__ __forceinline__ void done(const Unit&) const {}
};
template <class Epi, class Sched, bool STAMP = false>
__device__ __forceinline__ void gemm_phase(PG8_LAS unsigned char* lds, const Gemm g, const Sched& S, const Epi& E, unsigned long long* stamps, int pg8_wave_id) {
    const int wid = __builtin_amdgcn_readfirstlane(pg8_wave_id), lane = (int)__builtin_amdgcn_mbcnt_hi(~0u, __builtin_amdgcn_mbcnt_lo(~0u, 0u)), tid = wid * 64 + lane, wr = wid >> 2, wc = wid & 3, fr = lane & 15, fq = lane >> 4;
    const int K = g.ld;
    int ts_lo = 0, ts_hi = 0, nts = 0; const unsigned long long rt_entry = STAMP ? (unsigned long long)wall_clock64() : 0ull;
#define PG8_STAMP() do { if (STAMP && wid == 0 && nts < 64) { const unsigned long long _c = (unsigned long long)wall_clock64(); \
        ts_lo = (lane == nts) ? (int)(unsigned)_c : ts_lo; ts_hi = (lane == nts) ? (int)(unsigned)(_c >> 32) : ts_hi; ++nts; } } while (0)
    PG8_STAMP();
    unsigned voffA[2], voffB[2];
#pragma unroll
    for (int i = 0; i < 2; ++i) { int R, C; stage_rc(tid * 16 + i * 8192, R, C); const int Rb = Epi::PERM ? ((R & ~31) + perm32(R & 31)) : R;
        voffA[i] = (unsigned)(R * K + C) * 2u; voffB[i] = (unsigned)(Rb * K + C) * 2u; }
    const size_t kstep = (size_t)(BK * 2);
    const size_t hstep = (size_t)HALF * K * 2;
    const size_t tstep = 2 * hstep;
    const unsigned ldsw = (unsigned)wid * 1024u;
    const int aoff = lds_byte(wr * 64 + fr, fq * 8), boff = lds_byte(wc * 32 + fr, fq * 8);
#define PG8_SA(b, h) (((b) * 2 + (h)) * HTB)
#define PG8_SB(b, h) ((4 + (b) * 2 + (h)) * HTB)
#define PG8_STAGE(bufoff, gbase, voff) do { _Pragma("unroll") for (int _i = 0; _i < 2; ++_i) \
        __builtin_amdgcn_global_load_lds((const unsigned*)((const char*)(gbase) + (voff)[_i]), (PG8_LAS unsigned*)(lds + (bufoff) + ldsw + _i * 8192), 16, 0, 0); } while (0)
#define PG8_LDA(dst, b, h) do { _Pragma("unroll") for (int m = 0; m < 4; ++m) _Pragma("unroll") for (int k = 0; k < 2; ++k) dst[m][k] = *(const PG8_LAS bf16x8*)(lds + PG8_SA(b, h) + aoff + m * 2048 + k * 1024); } while (0)
#define PG8_LDB(dst, b, h) do { _Pragma("unroll") for (int n = 0; n < 2; ++n) _Pragma("unroll") for (int k = 0; k < 2; ++k) dst[n][k] = *(const PG8_LAS bf16x8*)(lds + PG8_SB(b, h) + boff + n * 2048 + k * 1024); } while (0)
#define PG8_MMA(ai, bj, At, Bt) do { __builtin_amdgcn_s_setprio(1); _Pragma("unroll") for (int m = 0; m < 4; ++m) _Pragma("unroll") for (int n = 0; n < 2; ++n) _Pragma("unroll") for (int k = 0; k < 2; ++k) \
        acc[ai][bj][m][n] = __builtin_amdgcn_mfma_f32_16x16x32_bf16(Bt[n][k], At[m][k], acc[ai][bj][m][n], 0, 0, 0); __builtin_amdgcn_s_setprio(0); } while (0)
#define PG8_WAIT_V(n) asm volatile("s_waitcnt vmcnt(" #n ")" ::: "memory")
#define PG8_WAIT_L(n) asm volatile("s_waitcnt lgkmcnt(" #n ")" ::: "memory")
#define PG8_BAR __builtin_amdgcn_s_barrier()
#define PG8_SCHED __builtin_amdgcn_sched_barrier(0)
    Unit cur, nxt; int ui = 0;
    if (!S.next(0, cur)) return;
    f32x4 acc[2][2][4][2];
#pragma unroll
    for (int a = 0; a < 2; ++a)
#pragma unroll
        for (int b = 0; b < 2; ++b)
#pragma unroll
            for (int m = 0; m < 4; ++m)
#pragma unroll
                for (int n = 0; n < 2; ++n) acc[a][b][m][n] = (f32x4){0.f, 0.f, 0.f, 0.f};
    bf16x8 At[4][2], B0[2][2], B1[2][2];
    const char* cA = (const char*)(cur.sel ? g.A2 : g.A) + (size_t)cur.pm * tstep + (size_t)cur.k0 * 2; const char* cB = (const char*)(cur.sel ? g.Bt2 : g.Bt) + (size_t)cur.pn * tstep + (size_t)cur.k0 * 2;
    S.a_ready(cur);
    PG8_STAGE(PG8_SB(0, 0), cB, voffB); PG8_STAGE(PG8_SA(0, 0), cA, voffA); PG8_STAGE(PG8_SB(0, 1), cB + hstep, voffB); PG8_STAGE(PG8_SA(0, 1), cA + hstep, voffA);
    if (wr == 1) PG8_BAR;
    PG8_WAIT_V(4); PG8_BAR;
    PG8_STAGE(PG8_SB(1, 0), cB + kstep, voffB); PG8_STAGE(PG8_SA(1, 0), cA + kstep, voffA); PG8_STAGE(PG8_SB(1, 1), cB + hstep + kstep, voffB);
    PG8_WAIT_V(6); PG8_BAR;
    PG8_STAMP();
    for (;;) {
        const bool has_next = S.next(ui + 1, nxt);
        const char* nA = has_next ? (const char*)(nxt.sel ? g.A2 : g.A) + (size_t)nxt.pm * tstep + (size_t)nxt.k0 * 2 : cA; const char* nB = has_next ? (const char*)(nxt.sel ? g.Bt2 : g.Bt) + (size_t)nxt.pn * tstep + (size_t)nxt.k0 * 2 : cB;
        const int nt = cur.nt;
        for (int t = 0; t < nt; t += 2) {
            const bool last = (t == nt - 2);
            const char* a1 = cA + (size_t)(t + 1) * kstep;
            const char* a2 = last ? nA : cA + (size_t)(t + 2) * kstep; const char* b2 = last ? nB : cB + (size_t)(t + 2) * kstep;
            const char* a3 = a2 + kstep; const char* b3 = b2 + kstep;
            if (last && has_next) S.a_ready(nxt);
            PG8_LDB(B0, 0, 0); PG8_SCHED; PG8_LDA(At, 0, 0); PG8_STAGE(PG8_SA(1, 1), a1 + hstep, voffA);
            PG8_WAIT_L(8); PG8_BAR; PG8_WAIT_L(0); PG8_MMA(0, 0, At, B0); PG8_BAR; PG8_SCHED;
            PG8_LDB(B1, 0, 1); PG8_STAGE(PG8_SB(0, 0), b2, voffB);
            PG8_BAR; PG8_WAIT_L(0); PG8_MMA(0, 1, At, B1); PG8_BAR;
            PG8_LDA(At, 0, 1); PG8_STAGE(PG8_SA(0, 0), a2, voffA);
            PG8_BAR; PG8_WAIT_L(0); PG8_MMA(1, 0, At, B0); PG8_BAR; PG8_SCHED;
            PG8_STAGE(PG8_SB(0, 1), b2 + hstep, voffB);
            PG8_WAIT_V(6); PG8_BAR; PG8_MMA(1, 1, At, B1); PG8_BAR;
            PG8_LDB(B0, 1, 0); PG8_SCHED; PG8_LDA(At, 1, 0); PG8_STAGE(PG8_SA(0, 1), a2 + hstep, voffA);
            PG8_WAIT_L(8); PG8_BAR; PG8_WAIT_L(0); PG8_MMA(0, 0, At, B0); PG8_BAR; PG8_SCHED;
            PG8_LDB(B1, 1, 1); PG8_STAGE(PG8_SB(1, 0), b3, voffB);
            PG8_BAR; PG8_WAIT_L(0); PG8_MMA(0, 1, At, B1); PG8_BAR;
            PG8_LDA(At, 1, 1); PG8_STAGE(PG8_SA(1, 0), a3, voffA);
            PG8_BAR; PG8_WAIT_L(0); PG8_MMA(1, 0, At, B0); PG8_BAR; PG8_SCHED;
            PG8_STAGE(PG8_SB(1, 1), b3 + hstep, voffB);
            PG8_WAIT_V(6); PG8_BAR; PG8_MMA(1, 1, At, B1); PG8_BAR;
        }
        PG8_STAMP();
        if constexpr (!Epi::AFTER_DRAIN) { E(acc, cur, wr, wc, fr, fq); S.done(cur); }
        PG8_STAMP();
        if (!has_next) break;
        if constexpr (Epi::CHAIN) E.rescale(acc, cur, wr, wc, fr, fq);
        else
#pragma unroll
        for (int a = 0; a < 2; ++a)
#pragma unroll
            for (int b = 0; b < 2; ++b)
#pragma unroll
                for (int m = 0; m < 4; ++m)
#pragma unroll
                    for (int n = 0; n < 2; ++n) acc[a][b][m][n] = (f32x4){0.f, 0.f, 0.f, 0.f};
        cur = nxt; cA = nA; cB = nB; ++ui;
    }
    PG8_WAIT_V(0);
    if (wr == 0) PG8_BAR;
    PG8_BAR;
    if constexpr (Epi::AFTER_DRAIN) { E.fused(acc, cur, wr, wc, fr, fq, lds, wid, lane); S.done(cur); }
    PG8_STAMP();
    if (STAMP && wid == 0) { stamps[lane] = lane < nts ? (((unsigned long long)(unsigned)ts_hi << 32) | (unsigned)ts_lo) : 0ull;
        if (lane == 62) stamps[62] = rt_entry; if (lane == 63) stamps[63] = (unsigned long long)wall_clock64(); }
#undef PG8_STAMP
#undef PG8_SA
#undef PG8_SB
#undef PG8_STAGE
#undef PG8_LDA
#undef PG8_LDB
#undef PG8_MMA
#undef PG8_WAIT_V
#undef PG8_WAIT_L
#undef PG8_BAR
#undef PG8_SCHED
}
}

#define XB_TMO      128
#define XB_XCNT(j)  (256  + 64 * (j))
#define XB_XSUB(j)  (1280 + 64 * (j))
#define XB_XGEN(j)  (2304 + 64 * (j))
#define XB_TOP      3328
#define XB_TOPGEN   3392
#define XCD_BAR_WORDS 3456
#define XB_SPIN_CAP (1u << 22)
#define LAS __attribute__((address_space(3)))

__device__ __forceinline__ unsigned xb_ld(unsigned* p)              { return __hip_atomic_load(p, __ATOMIC_RELAXED, __HIP_MEMORY_SCOPE_AGENT); }
__device__ __forceinline__ unsigned xb_add(unsigned* p, unsigned v) { return __hip_atomic_fetch_add(p, v, __ATOMIC_RELAXED, __HIP_MEMORY_SCOPE_AGENT); }
__device__ __forceinline__ unsigned xb_xcc_id() { return (unsigned)__builtin_amdgcn_s_getreg((3 << 11) | 20) & 0xFu; }
#define XB_SPIN(cond, bar) do { unsigned _sp = 0; while (cond) { __builtin_amdgcn_s_sleep(1); \
    if ((++_sp & 255u) == 0u) { if (xb_ld(&(bar)[XB_TMO])) break; if (_sp > XB_SPIN_CAP) { atomicAdd(&(bar)[XB_TMO], 1u); break; } } } } while (0)

#define xb_thread0() (xb_wave_s == 0 && __builtin_amdgcn_mbcnt_hi(~0u, __builtin_amdgcn_mbcnt_lo(~0u, 0u)) == 0u)
struct XcdBarrier {
    unsigned* bar; unsigned x;
    volatile LAS unsigned* st;
};

__device__ __forceinline__ XcdBarrier xcd_barrier_post(unsigned* bar, volatile LAS unsigned* st, int xb_wave_s) {
    XcdBarrier b; b.bar = bar; b.x = xb_xcc_id(); b.st = st;
    if (xb_thread0()) (void)xb_add(&bar[XB_XCNT(b.x)], 1u);
    return b;
}
__device__ __forceinline__ void xcd_barrier_complete(unsigned* bar, unsigned x, unsigned& nloc, unsigned& nx) {
    const unsigned G = gridDim.x * gridDim.y * gridDim.z;
    unsigned sum, cnt, mine, sp = 0u;
    for (;;) {
        sum = 0u; cnt = 0u; mine = 0u;
#pragma unroll
        for (unsigned j = 0; j < 16; ++j) { const unsigned c = xb_ld(&bar[XB_XCNT(j)]); sum += c; cnt += (c > 0u) ? 1u : 0u; mine = (j == x) ? c : mine; }
        if (sum == G) break;
        __builtin_amdgcn_s_sleep(1);
        if ((++sp & 255u) == 0u) { if (xb_ld(&bar[XB_TMO])) break; if (sp > XB_SPIN_CAP) { atomicAdd(&bar[XB_TMO], 1u); break; } }
    }
    nloc = mine > 0u ? mine : 1u; nx = cnt > 0u ? cnt : 1u;
}

__device__ __forceinline__ void xcd_barrier(const XcdBarrier& b, int xb_wave_s) {
    asm volatile("s_waitcnt vmcnt(0)" ::: "memory");
    __syncthreads();
    if (xb_thread0()) {
        unsigned* bar = b.bar;
        __builtin_amdgcn_s_waitcnt(0);
        unsigned nloc = b.st[0], nx = b.st[1];
        if (nloc == 0u) { xcd_barrier_complete(bar, b.x, nloc, nx); b.st[0] = nloc; b.st[1] = nx; }
        const unsigned old = xb_add(&bar[XB_XSUB(b.x)], 1u);
        const unsigned gen = old / nloc;
        if (old + 1u == (gen + 1u) * nloc) {
            __builtin_amdgcn_fence(__ATOMIC_RELEASE, "agent");
            asm volatile("s_waitcnt vmcnt(0)" ::: "memory");
            const unsigned og = xb_add(&bar[XB_TOP], 1u);
            const unsigned tg = og / nx;
            if (og + 1u == (tg + 1u) * nx) {
#pragma unroll
                for (unsigned j = 0; j < 16; ++j) (void)xb_add(&bar[XB_XGEN(j)], 1u);
            }
            XB_SPIN(xb_ld(&bar[XB_XGEN(b.x)]) == gen, bar);
            __builtin_amdgcn_fence(__ATOMIC_ACQUIRE, "agent");
            asm volatile("s_waitcnt vmcnt(0)" ::: "memory");
        } else {
            XB_SPIN(xb_ld(&bar[XB_XGEN(b.x)]) == gen, bar);
            __builtin_amdgcn_fence(__ATOMIC_ACQUIRE, "agent");
            asm volatile("s_waitcnt vmcnt(0)" ::: "memory");
        }
    }
    __syncthreads();
}

typedef unsigned short bf16;
typedef float f32x4 __attribute__((ext_vector_type(4)));
typedef float f32x2 __attribute__((ext_vector_type(2)));
constexpr int D = 2048, TP = 4096, MP = 8192, BS = 32, TS = 8, MS = 256, MT = 8448;
constexpr int PAST = 8192, NPAGE = 64, PAGE = 128, NMOD = 12288, DFF = 8192;
constexpr int NPROJ = 11008;
constexpr int C_QA = 0, C_ZA = 1024, C_IA = 2048, C_GA = 3072, C_QB = 4096, C_KC = 5120, C_VC = 5376, C_KS = 5632, C_VS = 5888, C_KW = 6144, C_VW = 6400, C_MGA = 6656, C_MGB = 8704, C_GATE = 10752;
constexpr int IN_COLS = 10776;
constexpr int LQ = 1024 + 64, LMG = 2048 + 64;
constexpr size_t O_YP = 0, O_YS = 16777216, O_CMPP = 17301504, O_CMPS = 21495808, O_SELP = 21626880, O_SELS = 25821184, O_WINP = 25952256, O_WINS = 26476544, O_HGP = 34865152, O_HGS = 35127296, O_END = 39321600;
constexpr float EPS = 1e-6f;
typedef short bf16x8 __attribute__((ext_vector_type(8)));
typedef float f32x16 __attribute__((ext_vector_type(16)));
typedef float f32x2_t __attribute__((ext_vector_type(2))); typedef __bf16 bf16x2_t __attribute__((ext_vector_type(2)));
typedef unsigned u32x4 __attribute__((ext_vector_type(4)));
constexpr float LOG2E = 1.4426950408889634f;
__device__ __forceinline__ unsigned cvtpk(float lo, float hi) { f32x2_t v = {lo, hi}; bf16x2_t b = __builtin_convertvector(v, bf16x2_t); return __builtin_bit_cast(unsigned, b); }

__device__ __forceinline__ bf16 f2bf(float f) { unsigned u = __float_as_uint(f); u += 0x7FFFu + ((u >> 16) & 1u); return (bf16)(u >> 16); }
__device__ __forceinline__ float bf2f(bf16 b) { return __uint_as_float(((unsigned)b) << 16); }
__device__ __forceinline__ float sigmoidf_(float x) { return __builtin_amdgcn_rcpf(1.0f + __builtin_amdgcn_exp2f(-1.4426950408889634f * x)); }
__device__ __forceinline__ float siluf_(float x) { return x * sigmoidf_(x); }
__device__ __forceinline__ int modrow(int r) { return r < MP ? (r >> 12) : 2 + ((r - MP) >> 3); }
__device__ __forceinline__ int win_col(int n) {
    if (n < C_MGA) return n;
    if (n < C_MGB) return 6680 + (n - C_MGA);
    if (n < C_GATE) return 8728 + (n - C_MGB);
    if (n < C_GATE + 24) return 6656 + (n - C_GATE);
    return -1;
}
__device__ __forceinline__ int rel_bucket(int rel) {
    const int n = rel > 0 ? rel : 0;
    if (n < 16) return n;
    const float nf = (float)n;
    const int large = 16 + (int)(logf(nf / 16.0f) / 2.0794415416798357f * 16.0f);
    return large < 31 ? large : 31;
}
__device__ __forceinline__ float wave_sum(float v) {
#pragma unroll
    for (int o = 32; o >= 1; o >>= 1) v += __shfl_xor(v, o);
    return v;
}
__device__ __forceinline__ float wave_max(float v) {
#pragma unroll
    for (int o = 32; o >= 1; o >>= 1) v = fmaxf(v, __shfl_xor(v, o));
    return v;
}

__device__ __forceinline__ void b_transpose128(const float* __restrict__ W, int ldw, int c0, int lim, bf16* __restrict__ Wt, int K, int n0, int k0, int tid, float* tile) {
#pragma unroll
    for (int p = 0; p < 8; ++p) { const int k = p * 16 + (tid >> 5), n4 = (tid & 31) * 4; f32x4 v = {0.f, 0.f, 0.f, 0.f};
        if (n4 < lim) v = *(const f32x4*)(W + (size_t)(k0 + k) * ldw + c0 + n4);
        float* t = tile + k * 129 + n4; t[0] = v[0]; t[1] = v[1]; t[2] = v[2]; t[3] = v[3]; }
    __syncthreads();
#pragma unroll
    for (int p = 0; p < 4; ++p) { const int n = p * 32 + (tid >> 4), kg = tid & 15; const float* t = tile + (8 * kg) * 129 + n;
        u32x4 w; w.x = cvtpk(t[0], t[129]); w.y = cvtpk(t[2 * 129], t[3 * 129]); w.z = cvtpk(t[4 * 129], t[5 * 129]); w.w = cvtpk(t[6 * 129], t[7 * 129]);
        *(u32x4*)(Wt + (size_t)(n0 + n) * K + k0 + 8 * kg) = w; }
    __syncthreads();
}
__device__ __forceinline__ void b_mods_part(const float* __restrict__ cp, const float* __restrict__ cs, const float* __restrict__ ada_w, float* __restrict__ MODP, int cg, int kc, int tid, float* tbl) {
    const int lane = tid & 63, wave = tid >> 6;
#pragma unroll
    for (int u = 0; u < 4; ++u) { const int s = tid + 512 * u, ln = s & 63, mt = (s >> 6) & 1, ks = s >> 7, m = mt * 32 + (ln & 31), k = ks * 16 + (ln >> 5) * 8;
        f32x4 v0 = {0.f, 0.f, 0.f, 0.f}, v1 = v0;
        if (m < 34) { const float* src = (m < 2 ? cp + m * D : cs + (m - 2) * D) + 256 * kc + k; v0 = *(const f32x4*)src; v1 = *(const f32x4*)(src + 4);
#pragma unroll
            for (int j = 0; j < 4; ++j) { v0[j] = siluf_(v0[j]); v1[j] = siluf_(v1[j]); } }
        u32x4 h, l;
        h.x = cvtpk(v0[0], v0[1]); h.y = cvtpk(v0[2], v0[3]); h.z = cvtpk(v1[0], v1[1]); h.w = cvtpk(v1[2], v1[3]);
        l.x = cvtpk(v0[0] - __uint_as_float(h.x << 16), v0[1] - __uint_as_float(h.x & 0xffff0000u)); l.y = cvtpk(v0[2] - __uint_as_float(h.y << 16), v0[3] - __uint_as_float(h.y & 0xffff0000u));
        l.z = cvtpk(v1[0] - __uint_as_float(h.z << 16), v1[1] - __uint_as_float(h.z & 0xffff0000u)); l.w = cvtpk(v1[2] - __uint_as_float(h.w << 16), v1[3] - __uint_as_float(h.w & 0xffff0000u));
        *(u32x4*)((char*)tbl + (((ks * 2 + mt) * 2 + 0) * 64 + ln) * 16) = h; *(u32x4*)((char*)tbl + (((ks * 2 + mt) * 2 + 1) * 64 + ln) * 16) = l; }
    __syncthreads();
    const int n0 = cg * 512 + wave * 64 + (lane & 31);
    const float* p = ada_w + (size_t)(256 * kc + (lane >> 5) * 8) * NMOD + n0;
    f32x16 acc[2][2];
#pragma unroll
    for (int mt = 0; mt < 2; ++mt)
#pragma unroll
        for (int nt = 0; nt < 2; ++nt)
#pragma unroll
            for (int i = 0; i < 16; ++i) acc[mt][nt][i] = 0.f;
#pragma unroll 1
    for (int kb = 0; kb < 4; ++kb) {
        float w[4][8][2];
#pragma unroll
        for (int ks = 0; ks < 4; ++ks) {
#pragma unroll
            for (int j = 0; j < 8; ++j) { w[ks][j][0] = p[0]; w[ks][j][1] = p[32]; p += NMOD; asm volatile("" : "+v"(p)); }
            p += 8 * NMOD; asm volatile("" : "+v"(p)); }
#pragma unroll
        for (int ks = 0; ks < 4; ++ks) {
            const char* tb = (const char*)tbl + (size_t)((kb * 4 + ks) * 4) * 1024 + lane * 16;
            const bf16x8 a0h = *(const bf16x8*)(tb), a0l = *(const bf16x8*)(tb + 1024), a1h = *(const bf16x8*)(tb + 2048), a1l = *(const bf16x8*)(tb + 3072);
#pragma unroll
            for (int nt = 0; nt < 2; ++nt) {
                u32x4 h, l;
                h.x = cvtpk(w[ks][0][nt], w[ks][1][nt]); h.y = cvtpk(w[ks][2][nt], w[ks][3][nt]); h.z = cvtpk(w[ks][4][nt], w[ks][5][nt]); h.w = cvtpk(w[ks][6][nt], w[ks][7][nt]);
                l.x = cvtpk(w[ks][0][nt] - __uint_as_float(h.x << 16), w[ks][1][nt] - __uint_as_float(h.x & 0xffff0000u)); l.y = cvtpk(w[ks][2][nt] - __uint_as_float(h.y << 16), w[ks][3][nt] - __uint_as_float(h.y & 0xffff0000u));
                l.z = cvtpk(w[ks][4][nt] - __uint_as_float(h.z << 16), w[ks][5][nt] - __uint_as_float(h.z & 0xffff0000u)); l.w = cvtpk(w[ks][6][nt] - __uint_as_float(h.w << 16), w[ks][7][nt] - __uint_as_float(h.w & 0xffff0000u));
                const bf16x8 bh = __builtin_bit_cast(bf16x8, h), bl = __builtin_bit_cast(bf16x8, l);
                acc[0][nt] = __builtin_amdgcn_mfma_f32_32x32x16_bf16(a0h, bh, acc[0][nt], 0, 0, 0); acc[1][nt] = __builtin_amdgcn_mfma_f32_32x32x16_bf16(a1h, bh, acc[1][nt], 0, 0, 0);
                acc[0][nt] = __builtin_amdgcn_mfma_f32_32x32x16_bf16(a0l, bh, acc[0][nt], 0, 0, 0); acc[1][nt] = __builtin_amdgcn_mfma_f32_32x32x16_bf16(a1l, bh, acc[1][nt], 0, 0, 0);
                acc[0][nt] = __builtin_amdgcn_mfma_f32_32x32x16_bf16(a0h, bl, acc[0][nt], 0, 0, 0); acc[1][nt] = __builtin_amdgcn_mfma_f32_32x32x16_bf16(a1h, bl, acc[1][nt], 0, 0, 0);
            }
        }
    }
    float* q = MODP + (size_t)kc * 34 * NMOD + n0; const int hi = lane >> 5;
#pragma unroll
    for (int nt = 0; nt < 2; ++nt) {
#pragma unroll
        for (int i = 0; i < 16; ++i) q[(size_t)((i & 3) + 8 * (i >> 2) + 4 * hi) * NMOD + nt * 32] = acc[0][nt][i];
        if (hi == 0) { q[(size_t)32 * NMOD + nt * 32] = acc[1][nt][0]; q[(size_t)33 * NMOD + nt * 32] = acc[1][nt][1]; }
    }
    __syncthreads();
}
__device__ __forceinline__ void b_hnorm(const float* __restrict__ xa, const float* __restrict__ xb, const float* __restrict__ gain, const float* __restrict__ mods, int sh_idx, int sc_idx, bf16* __restrict__ out, int row, int lt, float* red) {
    const float* x = row < MP ? xa + (size_t)row * D : xb + (size_t)(row - MP) * D;
    float v[8]; float ss = 0.f;
#pragma unroll
    for (int j = 0; j < 8; ++j) { v[j] = x[lt * 8 + j]; ss += v[j] * v[j]; }
    ss = wave_sum(ss); if ((lt & 63) == 0) red[lt >> 6] = ss; __syncthreads();
    ss = red[0] + red[1] + red[2] + red[3];
    const float r = rsqrtf(ss * (1.0f / D) + EPS);
    const float* m = mods + (size_t)modrow(row) * NMOD;
#pragma unroll
    for (int j = 0; j < 8; ++j) { const int c = lt * 8 + j; out[(size_t)row * D + c] = f2bf(v[j] * r * gain[c] * (1.0f + m[sc_idx * D + c]) + m[sh_idx * D + c]); }
    __syncthreads();
}
__device__ __forceinline__ void b_hnorm4(const float* __restrict__ xa, const float* __restrict__ xb, const float* __restrict__ gain, const float* __restrict__ mods, int sh_idx, int sc_idx, bf16* __restrict__ out, int row0, int row_end, int lt, float* red) {
    f32x4 v[4][2], sc[4][2], sh[4][2]; float ss[4];
    const f32x4 g0 = *(const f32x4*)(gain + lt * 8), g1 = *(const f32x4*)(gain + lt * 8 + 4);
#pragma unroll
    for (int k = 0; k < 4; ++k) { const int row = row0 + 512 * k;
        v[k][0] = (f32x4){0.f, 0.f, 0.f, 0.f}; v[k][1] = v[k][0]; sc[k][0] = v[k][0]; sc[k][1] = v[k][0]; sh[k][0] = v[k][0]; sh[k][1] = v[k][0];
        if (row < row_end) { const float* x = (row < MP ? xa + (size_t)row * D : xb + (size_t)(row - MP) * D) + lt * 8; const float* m = mods + (size_t)modrow(row) * NMOD + lt * 8;
            v[k][0] = *(const f32x4*)x; v[k][1] = *(const f32x4*)(x + 4); sc[k][0] = *(const f32x4*)(m + sc_idx * D); sc[k][1] = *(const f32x4*)(m + sc_idx * D + 4); sh[k][0] = *(const f32x4*)(m + sh_idx * D); sh[k][1] = *(const f32x4*)(m + sh_idx * D + 4); } }
#pragma unroll
    for (int k = 0; k < 4; ++k) { float s = 0.f;
#pragma unroll
        for (int j = 0; j < 4; ++j) s += v[k][0][j] * v[k][0][j] + v[k][1][j] * v[k][1][j];
        ss[k] = wave_sum(s); }
    if ((lt & 63) == 0) {
#pragma unroll
        for (int k = 0; k < 4; ++k) red[k * 4 + (lt >> 6)] = ss[k]; }
    __syncthreads();
#pragma unroll
    for (int k = 0; k < 4; ++k) { const int row = row0 + 512 * k;
        if (row < row_end) { const f32x4 t = *(const f32x4*)(red + k * 4); const float r = rsqrtf(((t[0] + t[1]) + (t[2] + t[3])) * (1.0f / D) + EPS);
            const f32x4 a = v[k][0] * r * g0 * (1.0f + sc[k][0]) + sh[k][0], c = v[k][1] * r * g1 * (1.0f + sc[k][1]) + sh[k][1];
            u32x4 w; w.x = cvtpk(a[0], a[1]); w.y = cvtpk(a[2], a[3]); w.z = cvtpk(c[0], c[1]); w.w = cvtpk(c[2], c[3]);
            *(u32x4*)(out + (size_t)row * D + lt * 8) = w; } }
    __syncthreads();
}
__device__ __forceinline__ void b_norm2_sample(const float* __restrict__ xs, const float* __restrict__ slab, const float* __restrict__ gain, const float* __restrict__ mods, float* __restrict__ X1, bf16* __restrict__ out, int row, int lt, float* red) {
    const int r = row - MP; const float* m = mods + (size_t)modrow(row) * NMOD;
    float v[8]; float ss = 0.f;
#pragma unroll
    for (int j = 0; j < 8; ++j) { const int c = lt * 8 + j; float s = 0.f;
#pragma unroll
        for (int ks = 0; ks < 8; ++ks) s += slab[((size_t)ks * 256 + r) * 2048 + c];
        v[j] = xs[(size_t)r * D + c] + m[2 * D + c] * s; X1[(size_t)row * D + c] = v[j]; ss += v[j] * v[j]; }
    ss = wave_sum(ss); if ((lt & 63) == 0) red[lt >> 6] = ss; __syncthreads();
    ss = red[0] + red[1] + red[2] + red[3];
    const float rn = rsqrtf(ss * (1.0f / D) + EPS);
#pragma unroll
    for (int j = 0; j < 8; ++j) { const int c = lt * 8 + j; out[(size_t)row * D + c] = f2bf(v[j] * rn * gain[c] * (1.0f + m[4 * D + c]) + m[3 * D + c]); }
    __syncthreads();
}
__device__ __forceinline__ void b_hgrn_seq(const bf16* __restrict__ QAb, const bf16* __restrict__ IAb, const float* __restrict__ F, const float* __restrict__ state, float* __restrict__ oraw, float* __restrict__ out, int x, int v) {
    const bool pr = x < 16;
    const int b = pr ? (x >> 3) : ((x - 16) >> 3), h = x & 7;
    const int T = pr ? TP : TS; const size_t row0 = pr ? (size_t)b * TP : (size_t)MP + b * TS;
    float S[128];
#pragma unroll
    for (int k = 0; k < 128; ++k) S[k] = pr ? 0.f : state[(((size_t)b * 8 + h) * 128 + k) * 128 + v];
    for (int t = 0; t < T; ++t) {
        const bf16* qp = QAb + (row0 + t) * LQ + h * 128; const float* f = F + (row0 + t) * LQ + h * 128;
        const float vi = bf2f(IAb[(row0 + t) * LQ + h * 128 + v]); float o = 0.f;
#pragma unroll
        for (int k = 0; k < 128; ++k) { const float fk = f[k]; S[k] = fk * S[k] + (1.0f - fk) * vi; o += S[k] * bf2f(qp[k]); }
        oraw[(row0 + t) * 1024 + h * 128 + v] = o;
    }
    float* so = out + (pr ? O_HGP : O_HGS) + ((size_t)b * 8 + h) * 16384;
#pragma unroll
    for (int k = 0; k < 128; ++k) so[k * 128 + v] = S[k];
}
__device__ __forceinline__ void b_hgrn_seq_s(const bf16* __restrict__ QAb, const bf16* __restrict__ IAb, const float* __restrict__ F, const float* __restrict__ state, float* __restrict__ oraw, float* __restrict__ out, int bh, int tid, float* fl, float* ql) {
    const int b = bh >> 3, h = bh & 7; const size_t row0 = (size_t)MP + b * TS;
    if (tid < 128) {
#pragma unroll
        for (int t = 0; t < 8; ++t) { fl[t * 128 + tid] = F[(row0 + t) * LQ + h * 128 + tid]; ql[t * 128 + tid] = bf2f(QAb[(row0 + t) * LQ + h * 128 + tid]); } }
    __syncthreads();
    if (tid < 128) {
        const int v = tid; float S[128];
#pragma unroll
        for (int k = 0; k < 128; ++k) S[k] = state[(((size_t)b * 8 + h) * 128 + k) * 128 + v];
#pragma unroll 1
        for (int t = 0; t < 8; ++t) {
            const float vi = bf2f(IAb[(row0 + t) * LQ + h * 128 + v]); float o = 0.f;
#pragma unroll
            for (int k4 = 0; k4 < 32; ++k4) { const f32x4 f4 = *(const f32x4*)(fl + t * 128 + 4 * k4), q4 = *(const f32x4*)(ql + t * 128 + 4 * k4);
#pragma unroll
                for (int e = 0; e < 4; ++e) { const int k = 4 * k4 + e; S[k] = f4[e] * S[k] + (1.0f - f4[e]) * vi; o += S[k] * q4[e]; }
                if ((k4 & 3) == 3) __builtin_amdgcn_sched_barrier(0); }
            oraw[(row0 + t) * 1024 + h * 128 + v] = o;
        }
        float* so = out + O_HGS + ((size_t)b * 8 + h) * 16384;
#pragma unroll
        for (int k = 0; k < 128; ++k) so[k * 128 + v] = S[k];
    }
    __syncthreads();
}
__device__ __forceinline__ void b_hgrn_out(const float* __restrict__ oraw, const bf16* __restrict__ GAs, const float* __restrict__ onorm, bf16* __restrict__ OA, int row, int tid) {
    float o[4]; float ss = 0.f;
#pragma unroll
    for (int j = 0; j < 4; ++j) { o[j] = oraw[(size_t)row * 1024 + tid * 4 + j]; ss += o[j] * o[j]; }
#pragma unroll
    for (int s = 16; s >= 1; s >>= 1) ss += __shfl_xor(ss, s);
    const float r = rsqrtf(ss * (1.0f / 128) + EPS);
#pragma unroll
    for (int j = 0; j < 4; ++j) { const int c = tid * 4 + j; OA[(size_t)row * 1024 + c] = f2bf(o[j] * r * onorm[c] * bf2f(GAs[(size_t)row * LQ + c])); }
}

template <class F> struct EpiGen {
    static constexpr bool PERM = false, AFTER_DRAIN = false, CHAIN = false;
    F f; float* slab; int slab_n, kslice;
    __device__ __forceinline__ void operator()(const pg8::f32x4 (&acc)[2][2][4][2], const pg8::Unit& u, int wr, int wc, int fr0, int fq0) const {
        int fr = fr0, fq = fq0; asm volatile("" : "+v"(fr), "+v"(fq));
        const int row0 = u.pm * 256 + wr * 64 + fr, col0 = u.pn * 256 + wc * 32 + 4 * fq;
        if (slab != nullptr && u.pm == 32) {
            float* sp = slab + ((size_t)(u.k0 / kslice) * 256 + (row0 - MP)) * slab_n + col0;
#pragma unroll
            for (int ai = 0; ai < 2; ++ai)
#pragma unroll
                for (int m = 0; m < 4; ++m)
#pragma unroll
                    for (int bj = 0; bj < 2; ++bj)
#pragma unroll
                        for (int n = 0; n < 2; ++n) *(f32x4*)(sp + (size_t)(ai * 128 + m * 16) * slab_n + bj * 128 + n * 16) = acc[ai][bj][m][n];
            return;
        }
#pragma unroll
        for (int ai = 0; ai < 2; ++ai)
#pragma unroll
            for (int m = 0; m < 4; ++m)
#pragma unroll
                for (int bj = 0; bj < 2; ++bj)
#pragma unroll
                    for (int n = 0; n < 2; ++n) f(row0 + ai * 128 + m * 16, col0 + bj * 128 + n * 16, acc[ai][bj][m][n]);
    }
};
struct MixOrder {
    pg8::StaticOrder P; int nN, nsl, ntS, kslice;
    __device__ __forceinline__ void init(int N, int K, int nsl_, int G, int c) { P.init(MP, N, G, c, K); nN = N / 256; nsl = nsl_; kslice = K / nsl_; ntS = kslice / 64; }
    __device__ __forceinline__ bool next(int i, pg8::Unit& u) const {
        const bool own = P.c < nN * nsl;
        if (own && i == 0) { const int idx = P.c; u.pm = 32; u.pn = idx % nN; u.k0 = (idx / nN) * kslice; u.nt = ntS; u.sel = 0; return true; }
        return P.next(own ? i - 1 : i, u); }
    __device__ __forceinline__ void a_ready(const pg8::Unit&) const {}
    __device__ __forceinline__ void done(const pg8::Unit&) const {}
};
template <class Base> struct RangeOrder {
    Base B; int i0, i1;
    __device__ __forceinline__ bool next(int i, pg8::Unit& u) const { return (i0 + i < i1) ? B.next(i0 + i, u) : false; }
    __device__ __forceinline__ void a_ready(const pg8::Unit&) const {}
    __device__ __forceinline__ void done(const pg8::Unit&) const {}
};
struct PairOrder {
    pg8::StaticOrder P; int nN, nsl, ntS, kslice;
    __device__ __forceinline__ void init(int N, int K, int nsl_, int G, int c) { P.init(MP, N, G, c, K); nN = N / 256; nsl = nsl_; kslice = K / nsl_; ntS = kslice / 64; }
    __device__ __forceinline__ bool next(int i, pg8::Unit& u) const {
        const bool own = P.c < 2 * nN * nsl; const int j = own ? i - 1 : i;
        if (j < 0) { const int idx = P.c, half = nN * nsl, w = idx >= half ? 1 : 0, id2 = idx - w * half;
            u.pm = 32; u.pn = id2 % nN; u.k0 = (id2 / nN) * kslice; u.nt = ntS; u.sel = w; return true; }
        if (j < 2) { const bool ok = P.next(0, u); u.sel = j; return ok; }
        return false; }
    __device__ __forceinline__ void a_ready(const pg8::Unit&) const {}
    __device__ __forceinline__ void done(const pg8::Unit&) const {}
};
struct EpiBranch {
    static constexpr bool PERM = false, AFTER_DRAIN = false, CHAIN = true;
    const bf16* mga; const bf16* mgb; bf16* merged; float* slab; int kslice, pad;
    __device__ __forceinline__ void operator()(pg8::f32x4 (&acc)[2][2][4][2], const pg8::Unit& u, int wr, int wc, int fr0, int fq0) const {
        int fr = fr0, fq = fq0; asm volatile("" : "+v"(fr), "+v"(fq));
        const int row0 = u.pm * 256 + wr * 64 + fr, col0 = u.pn * 256 + wc * 32 + 4 * fq;
#define EB_LOOP(...) _Pragma("unroll") for (int ai = 0; ai < 2; ++ai) _Pragma("unroll") for (int m = 0; m < 4; ++m) _Pragma("unroll") for (int bj = 0; bj < 2; ++bj) _Pragma("unroll") for (int n = 0; n < 2; ++n) { \
            const int r = row0 + ai * 128 + m * 16, c = col0 + bj * 128 + n * 16; f32x4& v = acc[ai][bj][m][n]; __VA_ARGS__ }
        if (u.pm == 32) { float* sp = slab + ((size_t)u.sel * 4 * 256 + (size_t)(u.k0 / kslice) * 256) * D; EB_LOOP( *(f32x4*)(sp + (size_t)(r - MP) * D + c) = v; ) }
        else if (u.sel == 0) { }
        else { EB_LOOP( const ushort4 g = *(const ushort4*)(mgb + (size_t)r * LMG + c); ushort4 o;
                        o.x = f2bf(fmaxf(bf2f(g.x), 1e-18f) * v[0]); o.y = f2bf(fmaxf(bf2f(g.y), 1e-18f) * v[1]); o.z = f2bf(fmaxf(bf2f(g.z), 1e-18f) * v[2]); o.w = f2bf(fmaxf(bf2f(g.w), 1e-18f) * v[3]); *(ushort4*)(merged + (size_t)r * D + c) = o; ) }
#undef EB_LOOP
    }
    __device__ __forceinline__ void rescale(pg8::f32x4 (&acc)[2][2][4][2], const pg8::Unit& u, int wr, int wc, int fr0, int fq0) const {
        int fr = fr0, fq = fq0; asm volatile("" : "+v"(fr), "+v"(fq));
        const bool chain = (u.sel == 0 && u.pm != 32); const float cf = chain ? 1.f : 0.f;
        const bf16* pa = mga + (size_t)((chain ? u.pm : 0) * 256 + wr * 64 + fr) * LMG + u.pn * 256 + wc * 32 + 4 * fq; const bf16* pb = mgb + (pa - mga);
#pragma unroll
        for (int ai = 0; ai < 2; ++ai) {
            ushort4 ga[4][2][2], gb[4][2][2];
#pragma unroll
            for (int m = 0; m < 4; ++m)
#pragma unroll
                for (int bj = 0; bj < 2; ++bj)
#pragma unroll
                    for (int n = 0; n < 2; ++n) { const size_t o = (size_t)(ai * 128 + m * 16) * LMG + bj * 128 + n * 16; ga[m][bj][n] = *(const ushort4*)(pa + o); gb[m][bj][n] = *(const ushort4*)(pb + o); }
#pragma unroll
            for (int m = 0; m < 4; ++m)
#pragma unroll
                for (int bj = 0; bj < 2; ++bj)
#pragma unroll
                    for (int n = 0; n < 2; ++n) { const ushort4 a_ = ga[m][bj][n], b_ = gb[m][bj][n]; f32x4 t;
                        t[0] = cf * bf2f(a_.x) * __builtin_amdgcn_rcpf(fmaxf(bf2f(b_.x), 1e-18f)); t[1] = cf * bf2f(a_.y) * __builtin_amdgcn_rcpf(fmaxf(bf2f(b_.y), 1e-18f));
                        t[2] = cf * bf2f(a_.z) * __builtin_amdgcn_rcpf(fmaxf(bf2f(b_.z), 1e-18f)); t[3] = cf * bf2f(a_.w) * __builtin_amdgcn_rcpf(fmaxf(bf2f(b_.w), 1e-18f)); acc[ai][bj][m][n] *= t; }
            __builtin_amdgcn_sched_barrier(0);
        }
    }
};
struct FStoreF32 { float* C; int ldc; int pad;
    __device__ __forceinline__ void operator()(int r, int c, f32x4 v) const { *(f32x4*)(C + (size_t)r * ldc + c) = v; } };
struct FGateA { const bf16* mga; float* T;
    __device__ __forceinline__ void operator()(int r, int c, f32x4 v) const { const ushort4 g = *(const ushort4*)(mga + (size_t)r * LMG + c); f32x4 o;
        o[0] = bf2f(g.x) * v[0]; o[1] = bf2f(g.y) * v[1]; o[2] = bf2f(g.z) * v[2]; o[3] = bf2f(g.w) * v[3];
        *(f32x4*)(T + (size_t)r * D + c) = o; } };
struct FGateB { const bf16* mgb; const float* T; bf16* merged;
    __device__ __forceinline__ void operator()(int r, int c, f32x4 v) const { const ushort4 g = *(const ushort4*)(mgb + (size_t)r * LMG + c); const f32x4 t = *(const f32x4*)(T + (size_t)r * D + c); ushort4 o;
        o.x = f2bf(t[0] + bf2f(g.x) * v[0]); o.y = f2bf(t[1] + bf2f(g.y) * v[1]); o.z = f2bf(t[2] + bf2f(g.z) * v[2]); o.w = f2bf(t[3] + bf2f(g.w) * v[3]);
        *(ushort4*)(merged + (size_t)r * D + c) = o; } };
struct FRes1 { const float* xp; const float* xs; const float* mods; float* X1;
    __device__ __forceinline__ void operator()(int r, int c, f32x4 v) const { const float* x = r < MP ? xp + (size_t)r * D : xs + (size_t)(r - MP) * D; const f32x4 xv = *(const f32x4*)(x + c);
        const f32x4 g = *(const f32x4*)(mods + (size_t)modrow(r) * NMOD + 2 * D + c); *(f32x4*)(X1 + (size_t)r * D + c) = xv + g * v; } };
struct FRelu2 { bf16* U;
    __device__ __forceinline__ void operator()(int r, int c, f32x4 v) const { ushort4 o; float a;
        a = fmaxf(v[0], 0.f); o.x = f2bf(a * a); a = fmaxf(v[1], 0.f); o.y = f2bf(a * a); a = fmaxf(v[2], 0.f); o.z = f2bf(a * a); a = fmaxf(v[3], 0.f); o.w = f2bf(a * a);
        *(ushort4*)(U + (size_t)r * DFF + c) = o; } };
struct FRes2 { const float* X1; const float* mods; float* out;
    __device__ __forceinline__ void operator()(int r, int c, f32x4 v) const { const f32x4 xv = *(const f32x4*)(X1 + (size_t)r * D + c);
        const f32x4 g = *(const f32x4*)(mods + (size_t)modrow(r) * NMOD + 5 * D + c); *(f32x4*)(out + (size_t)r * D + c) = xv + g * v; } };

struct InProjOut { bf16* QAb; float* F; bf16* IAb; bf16* GAs; float* QBr; float* out; bf16* XHP; float* WINKV; bf16* MGAb; bf16* MGBb; float* GATES; const float* lbl; };
__device__ __forceinline__ void st_bf16x4(bf16* p, f32x4 v) { typedef unsigned u32x2v __attribute__((ext_vector_type(2))); u32x2v w; w.x = cvtpk(v[0], v[1]); w.y = cvtpk(v[2], v[3]); *(u32x2v*)p = w; }
struct EpiInProj {
    static constexpr bool PERM = false, AFTER_DRAIN = false, CHAIN = false;
    InProjOut o;
#define EPI_LOOP(...) _Pragma("unroll") for (int bj = 0; bj < 2; ++bj) _Pragma("unroll") for (int n = 0; n < 2; ++n) { const int c = ct0 + bj * 128 + n * 16; \
        _Pragma("unroll") for (int ai = 0; ai < 2; ++ai) _Pragma("unroll") for (int m = 0; m < 4; ++m) { const int row = row0 + ai * 128 + m * 16; const f32x4 v = acc[ai][bj][m][n]; __VA_ARGS__ } }
    __device__ __forceinline__ void operator()(const pg8::f32x4 (&acc)[2][2][4][2], const pg8::Unit& u, int wr, int wc, int fr0, int fq0) const {
        int fr = fr0, fq = fq0; asm volatile("" : "+v"(fr), "+v"(fq));
        const int row0 = u.pm * 256 + wr * 64 + fr, ct0 = wc * 32 + 4 * fq, pn = u.pn;
        if (pn < 4) { bf16* p = o.QAb + pn * 256; EPI_LOOP( st_bf16x4(p + (size_t)row * LQ + c, v); ) }
        else if (pn < 8) {
            float* p = o.F + (pn - 4) * 256;
#pragma unroll
            for (int bj = 0; bj < 2; ++bj)
#pragma unroll
                for (int n = 0; n < 2; ++n) { const int c = ct0 + bj * 128 + n * 16; const int cc = (pn - 4) * 256 + c; const f32x4 l0 = *(const f32x4*)(o.lbl + cc), l1 = *(const f32x4*)(o.lbl + 1024 + cc); f32x4 lb;
#pragma unroll
                    for (int j = 0; j < 4; ++j) lb[j] = sigmoidf_(l0[j] - l1[j]);
#pragma unroll
                    for (int ai = 0; ai < 2; ++ai)
#pragma unroll
                        for (int m = 0; m < 4; ++m) { const int row = row0 + ai * 128 + m * 16; const f32x4 v = acc[ai][bj][m][n]; f32x4 f;
#pragma unroll
                            for (int j = 0; j < 4; ++j) f[j] = lb[j] + (1.0f - lb[j]) * sigmoidf_(v[j]);
                            *(f32x4*)(p + (size_t)row * LQ + c) = f; } }
        }
        else if (pn < 12) { bf16* p = o.IAb + (pn - 8) * 256; EPI_LOOP( st_bf16x4(p + (size_t)row * LQ + c, v); ) }
        else if (pn < 16) { bf16* p = o.GAs + (pn - 12) * 256; EPI_LOOP( f32x4 s; s[0] = siluf_(v[0]); s[1] = siluf_(v[1]); s[2] = siluf_(v[2]); s[3] = siluf_(v[3]); st_bf16x4(p + (size_t)row * LQ + c, s); ) }
        else if (pn < 20) { float* p = o.QBr + (pn - 16) * 256; EPI_LOOP( *(f32x4*)(p + (size_t)row * LQ + c) = v; ) }
        else if (pn < 22) { const int w = pn & 1; const bool pr = u.pm < 32; float* p = o.out + (pr ? O_CMPP : O_CMPS) + w * 256 - (pr ? (size_t)0 : (size_t)MP * 512); bf16* xp = o.XHP + (size_t)w * 1280 * 2048;
            EPI_LOOP( *(f32x4*)(p + (size_t)row * 512 + c) = v;
                      { const int kv = c >> 7, d = c & 127; size_t r; int j; if (pr) { const int b = row >> 12, t = row & 4095; r = ((size_t)b * 256 + (t >> 4)) * 2 + kv; j = t & 15; } else { const int lrow = row - MP; r = 1024 + (size_t)(lrow >> 3) * 2 + kv; j = lrow & 7; }
                        st_bf16x4(xp + r * 2048 + j * 128 + d, v); } ) }
        else if (pn < 24) { const int w = pn & 1; const bool pr = u.pm < 32; float* p = o.out + (pr ? O_SELP : O_SELS) + w * 256 - (pr ? (size_t)0 : (size_t)MP * 512); EPI_LOOP( *(f32x4*)(p + (size_t)row * 512 + c) = v; ) }
        else if (pn < 26) { float* p = o.WINKV + (pn & 1) * 256; EPI_LOOP( *(f32x4*)(p + (size_t)row * 512 + c) = v; ) }
        else if (pn < 42) { bf16* p = (pn < 34) ? o.MGAb + (pn - 26) * 256 : o.MGBb + (pn - 34) * 256;
            EPI_LOOP( f32x4 s; s[0] = sigmoidf_(v[0]); s[1] = sigmoidf_(v[1]); s[2] = sigmoidf_(v[2]); s[3] = sigmoidf_(v[3]); st_bf16x4(p + (size_t)row * LMG + c, s); ) }
        else { EPI_LOOP( if (c < 24) { f32x4 s; s[0] = sigmoidf_(v[0]); s[1] = sigmoidf_(v[1]); s[2] = sigmoidf_(v[2]); s[3] = sigmoidf_(v[3]); *(f32x4*)(o.GATES + (size_t)row * 24 + c) = s; } ) }
    }
#undef EPI_LOOP
};

constexpr int NTHR = 512;
constexpr int LDS_STAGE = 131072;
constexpr int LDS_CTL = LDS_STAGE;
constexpr int LDS_BYTES = 163840;
enum { PH_PRO = 0, PH_MRED, PH_NORM1, PH_INPROJ, PH_MIX1, PH_CFIN, PH_ATTN, PH_SATTN, PH_SCOMB, PH_BR, PH_RMERGE, PH_OUT, PH_NORM2, PH_MLP1, PH_RU, PH_MLP2, PH_RY, N_PHASES };


__device__ __forceinline__ int crow(int r, int hi) { return (r & 3) + 8 * (r >> 2) + 4 * hi; }
constexpr int AL_BIAS = LDS_CTL + 64;
constexpr int AL_LX = AL_BIAS + 4 * 132 * 4;
constexpr int AL_FX = AL_LX + 8 * 32 * 4;
constexpr int AL_SEL = AL_FX + 8 * 32 * 4;
constexpr int AL_IMPA = AL_SEL + 32 * 2 * 4;
constexpr int AL_IMPB = AL_IMPA + 32 * 64 * 4;
constexpr int AL_SCT = AL_IMPB + 32 * 64 * 4;
constexpr int AL_END = AL_SCT + 32 * 64 * 4;
static_assert(AL_END <= LDS_BYTES, "attention LDS control region");

struct AttnP { const float* QBr; const float* qn_g; const bf16* KSf; const bf16* VSf; const bf16* KWf; const bf16* VWf; const bf16* KCf; const bf16* VCf; const float* gates; const float* relb; bf16* OB; float* OT; float* IMP; };

__device__ __forceinline__ void dma_copy(LAS unsigned char* dst, const bf16* src, int nchunks  , int wave, int lane) {
    for (int c = wave; c < nchunks; c += 8) __builtin_amdgcn_global_load_lds((const unsigned*)((const char*)src + c * 1024 + lane * 16), (LAS unsigned*)(dst + c * 1024), 16, 0, 0);
}
#define AT_WAITV0() asm volatile("s_waitcnt vmcnt(0)" ::: "memory")
#define AT_BAR() do { asm volatile("s_waitcnt vmcnt(0) lgkmcnt(0)" ::: "memory"); __builtin_amdgcn_s_barrier(); asm volatile("" ::: "memory"); } while (0)

__device__ __forceinline__ f32x16 at_qk(const LAS unsigned char* kb, const bf16x8 (&qf)[8], int lane) {
    f32x16 p = {0.f, 0.f, 0.f, 0.f, 0.f, 0.f, 0.f, 0.f, 0.f, 0.f, 0.f, 0.f, 0.f, 0.f, 0.f, 0.f};
#pragma unroll
    for (int s = 0; s < 8; ++s) { const bf16x8 kf = *(const LAS bf16x8*)(kb + s * 1024 + lane * 16); p = __builtin_amdgcn_mfma_f32_32x32x16_bf16(kf, qf[s], p, 0, 0, 0); if (s == 3) __builtin_amdgcn_sched_barrier(0); }
    return p;
}
__device__ __forceinline__ void at_pv(f32x16 (&o)[4], const f32x16& e, const LAS unsigned char* vb, int lane) {
#pragma unroll
    for (int ks = 0; ks < 2; ++ks) {
        u32x4 w; w.x = cvtpk(e[8 * ks + 0], e[8 * ks + 1]); w.y = cvtpk(e[8 * ks + 2], e[8 * ks + 3]); w.z = cvtpk(e[8 * ks + 4], e[8 * ks + 5]); w.w = cvtpk(e[8 * ks + 6], e[8 * ks + 7]);
        const bf16x8 pf = __builtin_bit_cast(bf16x8, w);
#pragma unroll
        for (int dt = 0; dt < 4; ++dt) { const bf16x8 vf = *(const LAS bf16x8*)(vb + (ks * 4 + dt) * 1024 + lane * 16); o[dt] = __builtin_amdgcn_mfma_f32_32x32x16_bf16(pf, vf, o[dt], 0, 0, 0); }
    }
}
template <int MODE> __device__ __forceinline__ float at_exp(f32x16& p, int tok, int key0  , int hi, const LAS float* bias_g, float b31, int maxrel, bool keep) {
    float sum = 0.f;
#pragma unroll
    for (int r = 0; r < 16; ++r) {
        float e;
        if (MODE == 0) e = __builtin_amdgcn_exp2f(p[r] + b31);
        else { const int rel = tok - (key0 + crow(r, hi)); const bool ok = rel >= 0 && rel < maxrel; const int ix = rel < 0 ? 0 : (rel > 128 ? 128 : rel); e = ok ? __builtin_amdgcn_exp2f(p[r] + bias_g[ix]) : 0.f; }
        e = keep ? e : 0.f; p[r] = e; sum += e;
    }
    return sum;
}

__device__ __forceinline__ void load_q_frags(bf16x8 (&qf)[8], const float* qrow, const float* qn_g, int hi) {
    f32x4 x[8], y[8]; float ss = 0.f;
#pragma unroll
    for (int s = 0; s < 8; ++s) { x[s] = *(const f32x4*)(qrow + 16 * s + 8 * hi); y[s] = *(const f32x4*)(qrow + 16 * s + 8 * hi + 4);
        ss += (x[s][0] * x[s][0] + x[s][1] * x[s][1]) + (x[s][2] * x[s][2] + x[s][3] * x[s][3]) + (y[s][0] * y[s][0] + y[s][1] * y[s][1]) + (y[s][2] * y[s][2] + y[s][3] * y[s][3]); }
    ss += __shfl_xor(ss, 32);
    const float r = rsqrtf(ss * (1.0f / 128) + EPS) * (0.08838834764831845f * LOG2E);
#pragma unroll
    for (int s = 0; s < 8; ++s) { const f32x4 g0 = *(const f32x4*)(qn_g + 16 * s + 8 * hi), g1 = *(const f32x4*)(qn_g + 16 * s + 8 * hi + 4);
        u32x4 w; w.x = cvtpk(x[s][0] * g0[0] * r, x[s][1] * g0[1] * r); w.y = cvtpk(x[s][2] * g0[2] * r, x[s][3] * g0[3] * r); w.z = cvtpk(y[s][0] * g1[0] * r, y[s][1] * g1[1] * r); w.w = cvtpk(y[s][2] * g1[2] * r, y[s][3] * g1[3] * r);
        qf[s] = __builtin_bit_cast(bf16x8, w); }
}
__device__ __forceinline__ void at_stage_tile(LAS unsigned char* slot, const bf16* Kf, const bf16* Vf, int j, int wave, int lane) {
#pragma unroll
    for (int c = 0; c < 2; ++c) { const int ch = wave + 8 * c;
        __builtin_amdgcn_global_load_lds((const unsigned*)((const char*)(Kf + (size_t)j * 8192) + ch * 1024 + lane * 16), (LAS unsigned*)(slot + ch * 1024), 16, 0, 0);
        __builtin_amdgcn_global_load_lds((const unsigned*)((const char*)(Vf + (size_t)j * 8192) + ch * 1024 + lane * 16), (LAS unsigned*)(slot + 16384 + ch * 1024), 16, 0, 0); }
}
__device__ __forceinline__ void attn_prompt_unit(const AttnP& P0, int b, int kv, int i, LAS unsigned char* lds, int wave, int lane0) {
    int lane = lane0; asm volatile("" : "+v"(lane));
    AttnP P = P0;
    asm volatile("" : "+s"(P.QBr), "+s"(P.qn_g), "+s"(P.KSf), "+s"(P.VSf), "+s"(P.KWf), "+s"(P.VWf), "+s"(P.KCf), "+s"(P.VCf));
    asm volatile("" : "+s"(P.gates), "+s"(P.relb), "+s"(P.OB), "+s"(P.OT));
    const int rg = wave & 3, par = wave >> 2, q = lane & 31, hi = lane >> 5, tid = wave * 64 + lane;
    const int tok = 32 * i + 8 * rg + (q >> 2), g = q & 3, head = kv * 4 + g, cur = i >> 1;
    const size_t row = (size_t)b * TP + tok;
    LAS float* biasT = (LAS float*)(lds + AL_BIAS); LAS float* lx = (LAS float*)(lds + AL_LX); LAS float* fx = (LAS float*)(lds + AL_FX); LAS unsigned* selw = (LAS unsigned*)(lds + AL_SEL);
    LAS float* impA = (LAS float*)(lds + AL_IMPA); LAS float* impB = (LAS float*)(lds + AL_IMPB); LAS float* scT = (LAS float*)(lds + AL_SCT);
    const size_t seqkv = (size_t)b * 2 + kv;
    int nct = ((2 * i + 3) >> 6) + 1; nct = nct > 4 ? 4 : nct;
    dma_copy(lds, P.KCf + seqkv * 8 * 4096, nct * 16, wave, lane);
    dma_copy(lds + 65536, P.VCf + seqkv * 8 * 4096, nct * 16, wave, lane);
    float bv0 = 0.f, bv1 = 0.f;
    { const int u0 = tid, u1 = tid + NTHR; bv0 = P.relb[rel_bucket(u0 % 129) * 8 + kv * 4 + u0 / 129]; if (u1 < 4 * 129) bv1 = P.relb[rel_bucket(u1 % 129) * 8 + kv * 4 + u1 / 129]; }
    const float g0 = P.gates[row * 24 + head * 3 + 0], g1 = P.gates[row * 24 + head * 3 + 1], g2 = P.gates[row * 24 + head * 3 + 2];
    bf16x8 qf[8];
    load_q_frags(qf, P.QBr + row * LQ + head * 128, P.qn_g, hi);
    { const int u0 = tid, u1 = tid + NTHR; biasT[(u0 / 129) * 132 + u0 % 129] = bv0 * LOG2E; if (u1 < 4 * 129) biasT[(u1 / 129) * 132 + u1 % 129] = bv1 * LOG2E; }
    const LAS float* bias_g = biasT + g * 132;
    f32x16 ob[4], ot[4];
#pragma unroll
    for (int dt = 0; dt < 4; ++dt) { ob[dt] = (f32x16){0.f, 0.f, 0.f, 0.f, 0.f, 0.f, 0.f, 0.f, 0.f, 0.f, 0.f, 0.f, 0.f, 0.f, 0.f, 0.f}; ot[dt] = ob[dt]; }

    {
        AT_BAR();
        float lsum = 0.f;
#pragma unroll
        for (int t = 0; t < 2; ++t) {
            const int ct = par + 2 * t;
            if (ct < nct) {
#pragma unroll
                for (int sub = 0; sub < 2; ++sub) {
                    f32x16 sc = at_qk(lds + ct * 16384 + sub * 8192, qf, lane);
#pragma unroll
                    for (int r = 0; r < 16; ++r) { const int c = 64 * ct + 32 * sub + crow(r, hi); const int rel = tok - (16 * c + 31); const int ix = rel < 0 ? 0 : (rel > 128 ? 128 : rel);
                        const float e = rel >= 0 ? __builtin_amdgcn_exp2f(sc[r] + bias_g[ix]) : 0.f; lsum += e; sc[r] = e; }
                    ob[2 * t + sub] = sc;
                }
            }
        }
        lsum += __shfl_xor(lsum, 32);
        if (hi == 0) lx[wave * 32 + q] = lsum;
        AT_BAR();
        const float ltot = lx[rg * 32 + q] + lx[(rg + 4) * 32 + q];
        const float inv = 1.0f / fmaxf(ltot, 1e-30f);
#pragma unroll
        for (int t = 0; t < 2; ++t) {
            const int ct = par + 2 * t;
            if (ct < nct) {
#pragma unroll
                for (int sub = 0; sub < 2; ++sub) {
                    f32x16 sc = ob[2 * t + sub];
#pragma unroll
                    for (int r = 0; r < 16; ++r) { sc[r] *= inv; ob[2 * t + sub][r] = 0.f; }
#pragma unroll
                    for (int m = 0; m < 4; ++m) { float sa = (sc[4 * m] + sc[4 * m + 1]) + (sc[4 * m + 2] + sc[4 * m + 3]), sb = sc[4 * m + 3];
                        sa += __shfl_xor(sa, 1); sa += __shfl_xor(sa, 2); sb += __shfl_xor(sb, 1); sb += __shfl_xor(sb, 2);
                        if (g == 0) { const int s = 16 * ct + 8 * sub + 2 * m + hi; impA[(8 * rg + (q >> 2)) * 64 + s] = sa; impB[(8 * rg + (q >> 2)) * 64 + s] = sb; } }
#pragma unroll
                    for (int r = 0; r < 16; ++r) sc[r] *= g0;
                    at_pv(ot, sc, lds + 65536 + ct * 16384 + sub * 8192, lane);
                }
            }
        }
        AT_BAR();
#pragma unroll 1
        for (int tt = 0; tt < 4; ++tt) {
            const int tl = 4 * wave + tt, s = lane; float score = -INFINITY;
            if (s <= cur) { const float a = impA[tl * 64 + s] + (s > 0 ? impB[tl * 64 + s - 1] : 0.f); const bool forced = (s == 0) || (s == cur) || (s == cur - 1); score = a + (forced ? 1.0e6f : 0.f); }
            scT[tl * 64 + s] = score;
        }
        asm volatile("s_waitcnt lgkmcnt(0)" ::: "memory"); __builtin_amdgcn_wave_barrier();
#pragma unroll 1
        for (int tt = 0; tt < 4; ++tt) {
            const int tl = 4 * wave + tt, s = lane; const float score = scT[tl * 64 + s]; int rank = 0;
#pragma unroll 2
            for (int t4 = 0; t4 < 16; ++t4) { const f32x4 u4 = *(const LAS f32x4*)(scT + tl * 64 + 4 * t4);
#pragma unroll
                for (int e = 0; e < 4; ++e) { const int t = 4 * t4 + e; rank += (u4[e] > score || (u4[e] == score && t < s)) ? 1 : 0; } }
            const unsigned long long m = __ballot(rank < 16);
            if (lane == 0) { selw[tl * 2] = (unsigned)m; selw[tl * 2 + 1] = (unsigned)(m >> 32); }
        }
        AT_BAR();
    }
    const unsigned long long smask = ((unsigned long long)selw[(8 * rg + (q >> 2)) * 2 + 1] << 32) | selw[(8 * rg + (q >> 2)) * 2];
    const float b31 = bias_g[128];
    const int t0 = 32 * i + 8 * rg;

#pragma unroll 1
    for (int br = 1; br <= 2; ++br) {
        const bf16* Kf = (br == 1 ? P.KSf : P.KWf) + seqkv * 128 * 4096; const bf16* Vf = (br == 1 ? P.VSf : P.VWf) + seqkv * 128 * 4096;
        const int j0 = (br == 1) ? 0 : ((32 * i >= 511) ? ((32 * i - 511) >> 6) : 0);
        const int ntile = cur - j0 + 1; const int maxrel = (br == 1) ? 0x40000000 : 512;
        float lsum = 0.f;
        at_stage_tile(lds, Kf, Vf, j0, wave, lane);
        if (ntile > 1) at_stage_tile(lds + 32768, Kf, Vf, j0 + 1, wave, lane);
        if (ntile > 2) at_stage_tile(lds + 65536, Kf, Vf, j0 + 2, wave, lane);
#pragma unroll 1
        for (int t = 0; t < ntile; ++t) {
            const int ahead = ntile - 1 - t;
            if (ahead >= 2) asm volatile("s_waitcnt vmcnt(8)" ::: "memory"); else if (ahead == 1) asm volatile("s_waitcnt vmcnt(4)" ::: "memory"); else asm volatile("s_waitcnt vmcnt(0)" ::: "memory");
            asm volatile("s_waitcnt lgkmcnt(0)" ::: "memory"); __builtin_amdgcn_s_barrier(); asm volatile("" ::: "memory");
            if (t + 3 < ntile) at_stage_tile(lds + ((t + 3) & 3) * 32768, Kf, Vf, j0 + t + 3, wave, lane);
            const int j = j0 + t;
            const bool keep = (br == 1) ? (((smask >> j) & 1ull) != 0ull) : true;
            const int relmin = t0 - (64 * j + 63), relmax = t0 + 7 - 64 * j;
            const bool skip = (br == 2) && (relmin > 511);
            if (__ballot(keep) != 0ull && !skip) {
                const LAS unsigned char* kb = lds + (t & 3) * 32768 + par * 8192; const LAS unsigned char* vb = kb + 16384;
                f32x16 p0 = at_qk(kb, qf, lane);
                if (relmin >= 128 && relmax < maxrel) lsum += at_exp<0>(p0, tok, 64 * j + 32 * par, hi, bias_g, b31, maxrel, keep);
                else lsum += at_exp<1>(p0, tok, 64 * j + 32 * par, hi, bias_g, b31, maxrel, keep);
                at_pv(ob, p0, vb, lane);
            }
        }
        lsum += __shfl_xor(lsum, 32);
        if (hi == 0) lx[wave * 32 + q] = lsum;
        AT_BAR();
        { const float ltot = lx[rg * 32 + q] + lx[(rg + 4) * 32 + q]; const float f = (br == 1 ? g1 : g2) / fmaxf(ltot, 1e-30f); if (hi == 0) fx[wave * 32 + q] = f; }
        asm volatile("s_waitcnt lgkmcnt(0)" ::: "memory"); __builtin_amdgcn_wave_barrier();
#pragma unroll
        for (int m = 0; m < 4; ++m) { const f32x4 fv = *(const LAS f32x4*)(fx + wave * 32 + 8 * m + 4 * hi);
#pragma unroll
            for (int dt = 0; dt < 4; ++dt)
#pragma unroll
                for (int e = 0; e < 4; ++e) { ot[dt][4 * m + e] += fv[e] * ob[dt][4 * m + e]; ob[dt][4 * m + e] = 0.f; } }
        AT_BAR();
        if (br == 1) {   }
    }
    LAS float* obuf = (LAS float*)lds;
    if (par == 1) {
#pragma unroll
        for (int dt = 0; dt < 4; ++dt)
#pragma unroll
            for (int r = 0; r < 16; ++r) obuf[(rg * 32 + crow(r, hi)) * 128 + 32 * dt + q] = ot[dt][r];
    }
    AT_BAR();
    if (par == 0) {
#pragma unroll
        for (int dt = 0; dt < 4; ++dt)
#pragma unroll
            for (int r = 0; r < 16; ++r) { LAS float* o = obuf + (rg * 32 + crow(r, hi)) * 128 + 32 * dt + q; *o = *o + ot[dt][r]; }
    }
    AT_BAR();
    for (int u = tid; u < 2048; u += NTHR) {
        const int rr = u >> 4, ch = u & 15, rgg = rr >> 5, qq = rr & 31;
        const f32x4 a = *(const LAS f32x4*)(obuf + rr * 128 + ch * 8), c = *(const LAS f32x4*)(obuf + rr * 128 + ch * 8 + 4);
        u32x4 w; w.x = cvtpk(a[0], a[1]); w.y = cvtpk(a[2], a[3]); w.z = cvtpk(c[0], c[1]); w.w = cvtpk(c[2], c[3]);
        *(u32x4*)(P.OB + ((size_t)b * TP + 32 * i + 8 * rgg + (qq >> 2)) * 1024 + (kv * 4 + (qq & 3)) * 128 + ch * 8) = w;
    }
    AT_BAR();
}

__device__ __forceinline__ void prep_kv_tile(float* __restrict__ T, const float* __restrict__ gain, bf16* __restrict__ Kf, bf16* __restrict__ Vf, float* __restrict__ wout, int b, int kv, int Tt, int tid, float* kl  ) {
    const int key = tid >> 4, part = tid & 15, lane = tid & 63, x = tid >> 6, l31 = lane & 31, h = lane >> 5;
    float* rowp = T + ((size_t)b * TP + 32 * Tt + key) * 512 + kv * 128 + part * 8;
    f32x4 k0 = *(const f32x4*)rowp, k1 = *(const f32x4*)(rowp + 4);
    float ss = (k0[0] * k0[0] + k0[1] * k0[1]) + (k0[2] * k0[2] + k0[3] * k0[3]) + (k1[0] * k1[0] + k1[1] * k1[1]) + (k1[2] * k1[2] + k1[3] * k1[3]);
    ss += __shfl_xor(ss, 1); ss += __shfl_xor(ss, 2); ss += __shfl_xor(ss, 4); ss += __shfl_xor(ss, 8);
    const float r = rsqrtf(ss * (1.0f / 128) + EPS); const f32x4 g0 = *(const f32x4*)(gain + part * 8), g1 = *(const f32x4*)(gain + part * 8 + 4);
    k0 = k0 * g0 * r; k1 = k1 * g1 * r;
    *(f32x4*)rowp = k0; *(f32x4*)(rowp + 4) = k1;
    *(f32x4*)(kl + key * 132 + part * 8) = k0; *(f32x4*)(kl + key * 132 + part * 8 + 4) = k1;
    if (wout != nullptr) { float* wo = wout + (size_t)key * 512 + kv * 128 + part * 8; *(f32x4*)wo = k0; *(f32x4*)(wo + 4) = k1;
        *(f32x4*)(wo + 256) = *(const f32x4*)(rowp + 256); *(f32x4*)(wo + 260) = *(const f32x4*)(rowp + 260); }
    __syncthreads();
    { const float* s = kl + l31 * 132 + 16 * x + 8 * h; const f32x4 a0 = *(const f32x4*)s, a1 = *(const f32x4*)(s + 4);
      u32x4 w; w.x = cvtpk(a0[0], a0[1]); w.y = cvtpk(a0[2], a0[3]); w.z = cvtpk(a1[0], a1[1]); w.w = cvtpk(a1[2], a1[3]); *(u32x4*)(Kf + (size_t)(x * 64 + lane) * 8) = w; }
    { const int ks = x >> 2, dt = x & 3; const float* vb = T + ((size_t)b * TP + 32 * Tt) * 512 + 256 + kv * 128 + 32 * dt + l31; float v[8];
#pragma unroll
      for (int j = 0; j < 8; ++j) v[j] = vb[(size_t)(16 * ks + 8 * (j >> 2) + 4 * h + (j & 3)) * 512];
      u32x4 w; w.x = cvtpk(v[0], v[1]); w.y = cvtpk(v[2], v[3]); w.z = cvtpk(v[4], v[5]); w.w = cvtpk(v[6], v[7]); *(u32x4*)(Vf + (size_t)((ks * 4 + dt) * 64 + lane) * 8) = w; }
    __syncthreads();
}
__device__ __forceinline__ void prep_kv_sample(float* __restrict__ out, float* __restrict__ WINKV, const float* __restrict__ ks_g, const float* __restrict__ kw_g, int grp, int part) {
    const int which = grp >> 9, r = (grp >> 1) & 255, kv = grp & 1;
    float* rowp = (which == 0 ? out + O_SELS + (size_t)r * 512 : WINKV + ((size_t)MP + r) * 512) + kv * 128 + part * 8;
    f32x4 k0 = *(const f32x4*)rowp, k1 = *(const f32x4*)(rowp + 4);
    float ss = (k0[0] * k0[0] + k0[1] * k0[1]) + (k0[2] * k0[2] + k0[3] * k0[3]) + (k1[0] * k1[0] + k1[1] * k1[1]) + (k1[2] * k1[2] + k1[3] * k1[3]);
    ss += __shfl_xor(ss, 1); ss += __shfl_xor(ss, 2); ss += __shfl_xor(ss, 4); ss += __shfl_xor(ss, 8);
    const float* gain = which == 0 ? ks_g : kw_g;
    const float rr = rsqrtf(ss * (1.0f / 128) + EPS); const f32x4 g0 = *(const f32x4*)(gain + part * 8), g1 = *(const f32x4*)(gain + part * 8 + 4);
    k0 = k0 * g0 * rr; k1 = k1 * g1 * rr;
    *(f32x4*)rowp = k0; *(f32x4*)(rowp + 4) = k1;
    if (which == 1) { float* wo = out + O_WINS + ((size_t)(r >> 3) * 512 + 504 + (r & 7)) * 512 + kv * 128 + part * 8; *(f32x4*)wo = k0; *(f32x4*)(wo + 4) = k1;
        *(f32x4*)(wo + 256) = *(const f32x4*)(rowp + 256); *(f32x4*)(wo + 260) = *(const f32x4*)(rowp + 260); }
}
template <class SrcK, class SrcV> __device__ __forceinline__ void pack_tile(bf16* Kf, bf16* Vf, const SrcK& sk, const SrcV& sv, int tid) {
    const int lane = tid & 63, x = tid >> 6, l31 = lane & 31, h = lane >> 5;
    { const int s = x; u32x4 w; float v[8];
#pragma unroll
        for (int j = 0; j < 8; ++j) v[j] = sk(l31, 16 * s + 8 * h + j);
        w.x = cvtpk(v[0], v[1]); w.y = cvtpk(v[2], v[3]); w.z = cvtpk(v[4], v[5]); w.w = cvtpk(v[6], v[7]); *(u32x4*)(Kf + (size_t)(s * 64 + lane) * 8) = w; }
    { const int ks = x >> 2, dt = x & 3; u32x4 w; float v[8];
#pragma unroll
        for (int j = 0; j < 8; ++j) v[j] = sv(16 * ks + 8 * (j >> 2) + 4 * h + (j & 3), 32 * dt + l31);
        w.x = cvtpk(v[0], v[1]); w.y = cvtpk(v[2], v[3]); w.z = cvtpk(v[4], v[5]); w.w = cvtpk(v[6], v[7]); *(u32x4*)(Vf + (size_t)((ks * 4 + dt) * 64 + lane) * 8) = w; }
}
struct SrcRowsLim { const float* base; size_t stride; int lim; __device__ __forceinline__ float operator()(int key, int d) const { return key < lim ? base[(size_t)key * stride + d] : 0.f; } };

constexpr int XHC_ROWS = 32768, XHP_ROWS = 1280;
__device__ __forceinline__ void b_xhc_panel(const float* __restrict__ cache, const int* __restrict__ pt, bf16* __restrict__ panel, int L, int tid) {
    const int w = L >> 7, p = L & 127, b = p >> 2, lane16 = tid & 15, x = tid >> 4;
    const int ptv = pt[b * NPAGE + (p & 3) * 16 + lane16];
#pragma unroll 1
    for (int pg2 = 0; pg2 < 16; pg2 += 2) {
        const size_t base0 = (size_t)__builtin_amdgcn_readlane(ptv, pg2) * PAGE, base1 = (size_t)__builtin_amdgcn_readlane(ptv, pg2 + 1) * PAGE;
        f32x4 xa[16], ya[16];
#pragma unroll
        for (int i = 0; i < 16; ++i) {
            const int seg = (pg2 * 8 + i) * 32 + x; const int r = seg >> 4, j = seg & 15, n7 = (r >> 1) & 7, kv = r & 1;
            const float* s = cache + ((i < 8 ? base0 : base1) + n7 * 16 + j) * 512 + w * 256 + kv * 128 + lane16 * 8;
            xa[i] = *(const f32x4*)s; ya[i] = *(const f32x4*)(s + 4);
        }
#pragma unroll
        for (int i = 0; i < 16; ++i) {
            const int seg = (pg2 * 8 + i) * 32 + x; const int r = seg >> 4, j = seg & 15;
            u32x4 o; o.x = cvtpk(xa[i][0], xa[i][1]); o.y = cvtpk(xa[i][2], xa[i][3]); o.z = cvtpk(ya[i][0], ya[i][1]); o.w = cvtpk(ya[i][2], ya[i][3]);
            *(u32x4*)(panel + (size_t)r * 2048 + j * 128 + lane16 * 8) = o;
        }
    }
}
struct OneOrder {
    int pn;
    __device__ __forceinline__ bool next(int i, pg8::Unit& u) const { if (i > 0) return false; u.pm = 0; u.pn = pn; u.k0 = 0; u.nt = 32; u.sel = 0; return true; }
    __device__ __forceinline__ void a_ready(const pg8::Unit&) const {}
    __device__ __forceinline__ void done(const pg8::Unit&) const {}
};
struct DiagOrder {
    int n, per, G, c;
    __device__ __forceinline__ bool next(int i, pg8::Unit& u) const { const int L = i * G + c; if (L >= n) return false; u.pm = L; u.pn = L / per; u.k0 = 0; u.nt = 32; u.sel = 0; return true; }
    __device__ __forceinline__ void a_ready(const pg8::Unit&) const {}
    __device__ __forceinline__ void done(const pg8::Unit&) const {}
};
struct FStorePre { float* C; int rowoff, pad; __device__ __forceinline__ void operator()(int r, int c, f32x4 v) const { *(f32x4*)(C + (size_t)(rowoff + r) * 256 + (c & 255)) = v; } };
struct CmpW { const float *kw1, *kb1, *kw2, *vw1, *vb1, *vw2, *kc_g; };
__device__ __forceinline__ void b_cfin(const float* __restrict__ PREC, const float* __restrict__ PREP, const CmpW& cw, float* __restrict__ KCP, float* __restrict__ VCP, float* __restrict__ KCS, float* __restrict__ VCS,
                                       int grp, int tid, float* hid, float* red) {
    const int NP = 2040;
    float* dst[4]; int w = 0;
#pragma unroll
    for (int r4 = 0; r4 < 4; ++r4) {
        int x = grp * 4 + r4; bool pr; int b, i, kv; const float *p0, *p1;
        if (x < NP) { pr = true; kv = x & 1; x >>= 1; i = x % 255; x /= 255; b = x & 1; w = x >> 1;
            p0 = PREP + ((size_t)w * XHP_ROWS + ((size_t)b * 256 + i) * 2 + kv) * 256; p1 = PREP + ((size_t)w * XHP_ROWS + ((size_t)b * 256 + i + 1) * 2 + kv) * 256 + 128; }
        else { x -= NP; pr = false; kv = x & 1; x >>= 1; i = x & 511; x >>= 9; b = x & 31; w = x >> 5;
            p0 = PREC + ((size_t)w * XHC_ROWS + ((size_t)b * 512 + i) * 2 + kv) * 256;
            p1 = (i < 511) ? PREC + ((size_t)w * XHC_ROWS + ((size_t)b * 512 + i + 1) * 2 + kv) * 256 + 128 : PREP + ((size_t)w * XHP_ROWS + 1024 + b * 2 + kv) * 256 + 128; }
        const float* b1 = w ? cw.vb1 : cw.kb1;
        hid[r4 * 128 + tid] = siluf_(p0[tid] + p1[tid] + b1[tid]);
        dst[r4] = pr ? (w ? VCP : KCP) + (((size_t)b * 256 + i) * 2 + kv) * 128 : (w ? VCS : KCS) + (((size_t)b * 512 + i) * 2 + kv) * 128;
    }
    __syncthreads();
    const float* w2 = w ? cw.vw2 : cw.kw2;
    float o[4] = {0.f, 0.f, 0.f, 0.f};
    for (int k = 0; k < 128; ++k) { const float wv = w2[k * 128 + tid];
#pragma unroll
        for (int r4 = 0; r4 < 4; ++r4) o[r4] += hid[r4 * 128 + k] * wv; }
#pragma unroll
    for (int r4 = 0; r4 < 4; ++r4) { const float ss = wave_sum(o[r4] * o[r4]); if ((tid & 63) == 0) red[r4 * 2 + (tid >> 6)] = ss; }
    __syncthreads();
#pragma unroll
    for (int r4 = 0; r4 < 4; ++r4) { float v = o[r4]; if (w == 0) v = v * rsqrtf((red[r4 * 2] + red[r4 * 2 + 1]) * (1.0f / 128) + EPS) * cw.kc_g[tid]; dst[r4][tid] = v; }
    __syncthreads();
}

__device__ __forceinline__ void b_cfin_mfma(const float* __restrict__ PREC, const float* __restrict__ PREP, const bf16* __restrict__ W2T, const CmpW& cw,
                                            bf16* __restrict__ KCf, bf16* __restrict__ VCf, float* __restrict__ KCS, float* __restrict__ VCS, int item, int lane) {
    const int l31 = lane & 31, hi = lane >> 5;
    int x, xmax;
    if (item < 64) { const int w0 = item >> 5; x = 1020 * w0 + 32 * (item & 31) + l31; xmax = 1020 * w0 + 1019; } else { x = 2040 + 32 * (item - 64) + l31; xmax = 2040 + 65535; }
    const bool valid = x <= xmax; x = valid ? x : xmax;
    bool pr; int b, i, kv, w; const float *p0, *p1; float* dst;
    if (x < 2040) { int y = x; pr = true; kv = y & 1; y >>= 1; i = y % 255; y /= 255; b = y & 1; w = y >> 1;
        p0 = PREP + ((size_t)w * XHP_ROWS + ((size_t)b * 256 + i) * 2 + kv) * 256; p1 = PREP + ((size_t)w * XHP_ROWS + ((size_t)b * 256 + i + 1) * 2 + kv) * 256 + 128;
        dst = nullptr; }
    else { int y = x - 2040; pr = false; kv = y & 1; y >>= 1; i = y & 511; y >>= 9; b = y & 31; w = y >> 5;
        p0 = PREC + ((size_t)w * XHC_ROWS + ((size_t)b * 512 + i) * 2 + kv) * 256;
        p1 = (i < 511) ? PREC + ((size_t)w * XHC_ROWS + ((size_t)b * 512 + i + 1) * 2 + kv) * 256 + 128 : PREP + ((size_t)w * XHP_ROWS + 1024 + b * 2 + kv) * 256 + 128;
        dst = (w ? VCS : KCS) + (((size_t)b * 512 + i) * 2 + kv) * 128; }
    (void)pr;
    const int wu = __builtin_amdgcn_readfirstlane(w);
    const float* b1 = wu ? cw.vb1 : cw.kb1; const bf16* wt = W2T + (size_t)wu * 16384;
    f32x16 d[4];
#pragma unroll
    for (int cb = 0; cb < 4; ++cb) d[cb] = (f32x16){0.f, 0.f, 0.f, 0.f, 0.f, 0.f, 0.f, 0.f, 0.f, 0.f, 0.f, 0.f, 0.f, 0.f, 0.f, 0.f};
    f32x4 pa[16], pc[16];
#pragma unroll
    for (int s = 0; s < 8; ++s) { const int k0 = 16 * s + 8 * hi; pa[2 * s] = *(const f32x4*)(p0 + k0); pa[2 * s + 1] = *(const f32x4*)(p0 + k0 + 4); pc[2 * s] = *(const f32x4*)(p1 + k0); pc[2 * s + 1] = *(const f32x4*)(p1 + k0 + 4); }
#pragma unroll
    for (int s = 0; s < 8; ++s) {
        const int k0 = 16 * s + 8 * hi;
        const f32x4 a0 = pa[2 * s], a1 = pa[2 * s + 1], c0 = pc[2 * s], c1 = pc[2 * s + 1], e0 = *(const f32x4*)(b1 + k0), e1 = *(const f32x4*)(b1 + k0 + 4);
        u32x4 hw; hw.x = cvtpk(siluf_(a0[0] + c0[0] + e0[0]), siluf_(a0[1] + c0[1] + e0[1])); hw.y = cvtpk(siluf_(a0[2] + c0[2] + e0[2]), siluf_(a0[3] + c0[3] + e0[3]));
        hw.z = cvtpk(siluf_(a1[0] + c1[0] + e1[0]), siluf_(a1[1] + c1[1] + e1[1])); hw.w = cvtpk(siluf_(a1[2] + c1[2] + e1[2]), siluf_(a1[3] + c1[3] + e1[3]));
        const bf16x8 hf = __builtin_bit_cast(bf16x8, hw);
#pragma unroll
        for (int cb = 0; cb < 4; ++cb) { const bf16x8 wf = *(const bf16x8*)(wt + (size_t)(32 * cb + l31) * 128 + k0); d[cb] = __builtin_amdgcn_mfma_f32_32x32x16_bf16(wf, hf, d[cb], 0, 0, 0); }
    }
    float rs = 1.0f;
    if (wu == 0) { float ss = 0.f;
#pragma unroll
        for (int cb = 0; cb < 4; ++cb)
#pragma unroll
            for (int r = 0; r < 16; ++r) ss += d[cb][r] * d[cb][r];
        ss += __shfl_xor(ss, 32); rs = rsqrtf(ss * (1.0f / 128) + EPS); }
    const bool prm = (item < 64);
    if (valid) {
#pragma unroll
        for (int cb = 0; cb < 4; ++cb)
#pragma unroll
            for (int m = 0; m < 4; ++m) { const int col = 32 * cb + 8 * m + 4 * hi; f32x4 o;
#pragma unroll
                for (int e = 0; e < 4; ++e) o[e] = d[cb][4 * m + e] * rs;
                if (wu == 0) { const f32x4 gg = *(const f32x4*)(cw.kc_g + col); o = o * gg; }
                if (!prm) *(f32x4*)(dst + col) = o;
                else { const int T = i >> 5, kl = i & 31; bf16* tb = (wu ? VCf : KCf) + (((size_t)b * 2 + kv) * 8 + T) * 4096;
                    if (wu == 0) { typedef unsigned u32x2v __attribute__((ext_vector_type(2))); u32x2v pk; pk.x = cvtpk(o[0], o[1]); pk.y = cvtpk(o[2], o[3]);
                        *(u32x2v*)(tb + (size_t)((2 * cb + (m >> 1)) * 64 + kl + 32 * (m & 1)) * 8 + 4 * hi) = pk; }
                    else { const int ks = kl >> 4, kk = kl & 15, hh = (kk >> 2) & 1, jj = (kk >> 3) * 4 + (kk & 3);
#pragma unroll
                        for (int e = 0; e < 4; ++e) { const int dcol = col + e; tb[(size_t)(((ks * 4 + (dcol >> 5)) * 64) + (dcol & 31) + 32 * hh) * 8 + jj] = f2bf(o[e]); } } }
            }
    }
}

constexpr int HG_QPP = 0, HG_KPP = 17408, HG_KET = 34816, HG_VT = 53248, HG_QSUM = 71680;
constexpr int HG_RS = 136, HG_TS = 72;
struct HgP { const bf16* QAb; const bf16* IAb; const bf16* GAs; const float* F; bf16* QS; float* OI; float* Lb; float* DEC; bf16* SPT; };

__device__ __forceinline__ bf16x8 hg_pack8(const float (&v)[16], int o) { u32x4 w; w.x = cvtpk(v[o], v[o + 1]); w.y = cvtpk(v[o + 2], v[o + 3]); w.z = cvtpk(v[o + 4], v[o + 5]); w.w = cvtpk(v[o + 6], v[o + 7]); return __builtin_bit_cast(bf16x8, w); }

__device__ __forceinline__ void hgrn_local(const HgP& P0, int item, LAS unsigned char* lds, int tid) {
    HgP P = P0; asm volatile("" : "+s"(P.QAb), "+s"(P.IAb), "+s"(P.F), "+s"(P.QS), "+s"(P.OI), "+s"(P.Lb), "+s"(P.DEC));
    const int b = item >> 9, h = (item >> 6) & 7, c = item & 63; const size_t row0 = (size_t)b * TP + 64 * c;
    const int lane = tid & 63, wave = __builtin_amdgcn_readfirstlane(tid >> 6), l31 = lane & 31, hi = lane >> 5;
    const int k0 = 2 * lane, to = wave;
    LAS bf16* QPP = (LAS bf16*)(lds + HG_QPP); LAS bf16* KPP = (LAS bf16*)(lds + HG_KPP); LAS bf16* KET = (LAS bf16*)(lds + HG_KET); LAS bf16* VT = (LAS bf16*)(lds + HG_VT);
    LAS float* qsum = (LAS float*)(lds + HG_QSUM);
    f32x2 fk[8]; unsigned q2[8], v2[8];
#pragma unroll
    for (int i = 0; i < 8; ++i) { const size_t r = (row0 + 8 * to + i) * LQ + h * 128 + k0; fk[i] = *(const f32x2*)(P.F + r); q2[i] = *(const unsigned*)(P.QAb + r); v2[i] = *(const unsigned*)(P.IAb + r); }
    float bl0[8], bl1[8];
    { float r0 = 0.f, r1 = 0.f;
#pragma unroll
        for (int i = 0; i < 8; ++i) { r0 += __logf(fk[i][0]); r1 += __logf(fk[i][1]); bl0[i] = r0; bl1[i] = r1; }
        *(LAS f32x2*)(qsum + to * 128 + k0) = (f32x2){r0, r1}; }
    asm volatile("s_waitcnt lgkmcnt(0)" ::: "memory"); __builtin_amdgcn_s_barrier(); asm volatile("" ::: "memory");
    float pre0 = 0.f, pre1 = 0.f, bend0 = 0.f, bend1 = 0.f;
#pragma unroll
    for (int j = 0; j < 8; ++j) { const f32x2 s = *(const LAS f32x2*)(qsum + j * 128 + k0); bend0 += s[0]; bend1 += s[1]; pre0 += (j < to) ? s[0] : 0.f; pre1 += (j < to) ? s[1] : 0.f; }
    {
        float ke0[8], ke1[8];
#pragma unroll
        for (int i = 0; i < 8; ++i) {
            const int t = 8 * to + i; const float eb0 = pre0 + bl0[i], eb1 = pre1 + bl1[i];
            const float qa = bf2f((bf16)(q2[i] & 0xffffu)), qb = bf2f((bf16)(q2[i] >> 16)), ka = 1.0f - fk[i][0], kb = 1.0f - fk[i][1];
            *(unsigned*)(P.QS + (row0 + t) * 1024 + h * 128 + k0) = cvtpk(qa * __expf(eb0), qb * __expf(eb1));
            *(LAS unsigned*)(QPP + t * HG_RS + k0) = cvtpk(qa * __expf(fminf(eb0 - 0.5f * bend0, 80.f)), qb * __expf(fminf(eb1 - 0.5f * bend1, 80.f)));
            *(LAS unsigned*)(KPP + t * HG_RS + k0) = cvtpk(ka * __expf(fminf(0.5f * bend0 - eb0, 80.f)), kb * __expf(fminf(0.5f * bend1 - eb1, 80.f)));
            ke0[i] = ka * __expf(bend0 - eb0); ke1[i] = kb * __expf(bend1 - eb1);
        }
        { u32x4 w; w.x = cvtpk(ke0[0], ke0[1]); w.y = cvtpk(ke0[2], ke0[3]); w.z = cvtpk(ke0[4], ke0[5]); w.w = cvtpk(ke0[6], ke0[7]); *(LAS u32x4*)(KET + k0 * HG_TS + 8 * to) = w; }
        { u32x4 w; w.x = cvtpk(ke1[0], ke1[1]); w.y = cvtpk(ke1[2], ke1[3]); w.z = cvtpk(ke1[4], ke1[5]); w.w = cvtpk(ke1[6], ke1[7]); *(LAS u32x4*)(KET + (k0 + 1) * HG_TS + 8 * to) = w; }
        { u32x4 w; w.x = (v2[0] & 0xffffu) | (v2[1] << 16); w.y = (v2[2] & 0xffffu) | (v2[3] << 16); w.z = (v2[4] & 0xffffu) | (v2[5] << 16); w.w = (v2[6] & 0xffffu) | (v2[7] << 16); *(LAS u32x4*)(VT + k0 * HG_TS + 8 * to) = w; }
        { u32x4 w; w.x = (v2[0] >> 16) | (v2[1] & 0xffff0000u); w.y = (v2[2] >> 16) | (v2[3] & 0xffff0000u); w.z = (v2[4] >> 16) | (v2[5] & 0xffff0000u); w.w = (v2[6] >> 16) | (v2[7] & 0xffff0000u); *(LAS u32x4*)(VT + (k0 + 1) * HG_TS + 8 * to) = w; }
        if (to == 7) *(f32x2*)(P.DEC + (size_t)item * 128 + k0) = (f32x2){__expf(bend0), __expf(bend1)};
    }
    asm volatile("s_waitcnt lgkmcnt(0)" ::: "memory"); __builtin_amdgcn_s_barrier(); asm volatile("" ::: "memory");
    const int tb = (wave < 4) ? 1 : 0, vb = wave & 3;
    f32x16 z = {0.f, 0.f, 0.f, 0.f, 0.f, 0.f, 0.f, 0.f, 0.f, 0.f, 0.f, 0.f, 0.f, 0.f, 0.f, 0.f};
#pragma unroll 1
    for (int sb = 0; sb <= tb; ++sb) {
        f32x16 x = {0.f, 0.f, 0.f, 0.f, 0.f, 0.f, 0.f, 0.f, 0.f, 0.f, 0.f, 0.f, 0.f, 0.f, 0.f, 0.f};
#pragma unroll
        for (int st = 0; st < 8; ++st) { const bf16x8 af = *(const LAS bf16x8*)(KPP + (32 * sb + l31) * HG_RS + 16 * st + 8 * hi), bf = *(const LAS bf16x8*)(QPP + (32 * tb + l31) * HG_RS + 16 * st + 8 * hi);
            x = __builtin_amdgcn_mfma_f32_32x32x16_bf16(af, bf, x, 0, 0, 0); }
        if (sb == tb) {
#pragma unroll
            for (int r = 0; r < 16; ++r) x[r] = (crow(r, hi) <= l31) ? x[r] : 0.f;
        }
#pragma unroll
        for (int ks = 0; ks < 2; ++ks) {
            u32x4 w; w.x = cvtpk(x[8 * ks + 0], x[8 * ks + 1]); w.y = cvtpk(x[8 * ks + 2], x[8 * ks + 3]); w.z = cvtpk(x[8 * ks + 4], x[8 * ks + 5]); w.w = cvtpk(x[8 * ks + 6], x[8 * ks + 7]);
            typedef unsigned u32x2v __attribute__((ext_vector_type(2)));
            const LAS bf16* vp = VT + (32 * vb + l31) * HG_TS + 32 * sb + 16 * ks + 4 * hi;
            const u32x2v lo = *(const LAS u32x2v*)vp, hh = *(const LAS u32x2v*)(vp + 8);
            u32x4 vv; vv.x = lo.x; vv.y = lo.y; vv.z = hh.x; vv.w = hh.y;
            z = __builtin_amdgcn_mfma_f32_32x32x16_bf16(__builtin_bit_cast(bf16x8, w), __builtin_bit_cast(bf16x8, vv), z, 0, 0, 0);
        }
    }
    { float* o = P.OI + (row0 + 32 * tb) * 1024 + h * 128 + 32 * vb + l31;
#pragma unroll
        for (int r = 0; r < 16; ++r) o[(size_t)crow(r, hi) * 1024] = z[r]; }
    const int nt = (wave < 4) ? 1 : 3, t0 = (wave < 4) ? wave : 4 + 3 * (wave - 4);
#pragma unroll 1
    for (int ti = 0; ti < nt; ++ti) {
        const int kb = (t0 + ti) >> 2, vb2 = (t0 + ti) & 3;
        f32x16 d = {0.f, 0.f, 0.f, 0.f, 0.f, 0.f, 0.f, 0.f, 0.f, 0.f, 0.f, 0.f, 0.f, 0.f, 0.f, 0.f};
#pragma unroll
        for (int st = 0; st < 4; ++st) { const bf16x8 af = *(const LAS bf16x8*)(KET + (32 * kb + l31) * HG_TS + 16 * st + 8 * hi), bf = *(const LAS bf16x8*)(VT + (32 * vb2 + l31) * HG_TS + 16 * st + 8 * hi);
            d = __builtin_amdgcn_mfma_f32_32x32x16_bf16(af, bf, d, 0, 0, 0); }
        float* o = P.Lb + (size_t)item * 16384 + (size_t)(32 * kb) * 128 + 32 * vb2 + l31;
#pragma unroll
        for (int r = 0; r < 16; ++r) o[crow(r, hi) * 128] = d[r];
    }
    asm volatile("s_waitcnt lgkmcnt(0)" ::: "memory"); __builtin_amdgcn_s_barrier(); asm volatile("" ::: "memory");
}
__device__ __forceinline__ void hgrn_carry(const HgP& P, float* hg_out, int bh, int k, int v) {
    const float* lb = P.Lb + (size_t)bh * 64 * 16384 + (size_t)k * 128;
    const float* dc = P.DEC + (size_t)bh * 64 * 128 + k;
    bf16* sp = P.SPT + (size_t)bh * 64 * 16384 + (size_t)k * 128;
    float L[64], dd[64];
#pragma unroll
    for (int c = 0; c < 64; ++c) { L[c] = (lb + (size_t)c * 16384)[v]; dd[c] = dc[c * 128]; }
    float S = 0.f;
#pragma unroll
    for (int c = 0; c < 64; ++c) { (sp + (size_t)c * 16384)[v] = f2bf(S); S = dd[c] * S + L[c]; }
    hg_out[(size_t)bh * 16384 + (size_t)k * 128 + v] = S;
}
__device__ __forceinline__ void hgrn_output(const HgP& P0, const float* onorm0, bf16* OA0, int item, LAS unsigned char* lds, int tid) {
    HgP P = P0; const float* onorm = onorm0; bf16* OA = OA0; asm volatile("" : "+s"(P.GAs), "+s"(P.QS), "+s"(P.OI), "+s"(P.SPT), "+s"(onorm), "+s"(OA));
    const int b = item >> 9, h = (item >> 6) & 7, c = item & 63; const size_t row0 = (size_t)b * TP + 64 * c;
    const int lane = tid & 63, wave = __builtin_amdgcn_readfirstlane(tid >> 6), l31 = lane & 31, hi = lane >> 5, tb = wave >> 2, vb = wave & 3;
    f32x16 acc;
    { const float* o = P.OI + (row0 + 32 * tb) * 1024 + h * 128 + 32 * vb + l31;
#pragma unroll
        for (int r = 0; r < 16; ++r) acc[r] = o[(size_t)crow(r, hi) * 1024]; }
    bf16x8 af[8];
#pragma unroll
    for (int st = 0; st < 8; ++st) af[st] = *(const bf16x8*)(P.QS + (row0 + 32 * tb + l31) * 1024 + h * 128 + 16 * st + 8 * hi);
    const int t = tid >> 3, sg = tid & 7;
    const bf16x8 gq0 = *(const bf16x8*)(P.GAs + (row0 + t) * LQ + h * 128 + 16 * sg), gq1 = *(const bf16x8*)(P.GAs + (row0 + t) * LQ + h * 128 + 16 * sg + 8);
    f32x4 onv[4];
#pragma unroll
    for (int j = 0; j < 4; ++j) onv[j] = *(const f32x4*)(onorm + h * 128 + 16 * sg + 4 * j);
    LAS bf16* sl = (LAS bf16*)(lds + 40960);
#pragma unroll
    for (int c4 = 0; c4 < 4; ++c4) { const int e = (c4 * 512 + tid) * 8; *(LAS u32x4*)(sl + (e >> 7) * 136 + (e & 127)) = *(const u32x4*)(P.SPT + (size_t)item * 16384 + e); }
    asm volatile("s_waitcnt vmcnt(0) lgkmcnt(0)" ::: "memory"); __builtin_amdgcn_s_barrier(); asm volatile("" ::: "memory");
#pragma unroll
    for (int st = 0; st < 8; ++st) {
        const LAS bf16* sp = sl + (16 * st + 8 * hi) * 136 + 32 * vb + l31;
        u32x4 w; w.x = (unsigned)sp[0] | ((unsigned)sp[136] << 16); w.y = (unsigned)sp[2 * 136] | ((unsigned)sp[3 * 136] << 16); w.z = (unsigned)sp[4 * 136] | ((unsigned)sp[5 * 136] << 16); w.w = (unsigned)sp[6 * 136] | ((unsigned)sp[7 * 136] << 16);
        acc = __builtin_amdgcn_mfma_f32_32x32x16_bf16(af[st], __builtin_bit_cast(bf16x8, w), acc, 0, 0, 0);
    }
    LAS float* ol = (LAS float*)lds;
#pragma unroll
    for (int r = 0; r < 16; ++r) ol[(32 * tb + crow(r, hi)) * 132 + 32 * vb + l31] = acc[r];
    asm volatile("s_waitcnt lgkmcnt(0)" ::: "memory"); __builtin_amdgcn_s_barrier(); asm volatile("" ::: "memory");
    {
        float o[16]; float ss = 0.f;
#pragma unroll
        for (int j = 0; j < 16; ++j) { o[j] = ol[t * 132 + 16 * sg + j]; ss += o[j] * o[j]; }
        ss += __shfl_xor(ss, 1); ss += __shfl_xor(ss, 2); ss += __shfl_xor(ss, 4);
        const float r = rsqrtf(ss * (1.0f / 128) + EPS);
#pragma unroll
        for (int j = 0; j < 16; ++j) o[j] = o[j] * r * onv[j >> 2][j & 3] * bf2f((bf16)(j < 8 ? gq0[j & 7] : gq1[j & 7]));
        bf16* dst = OA + (row0 + t) * 1024 + h * 128 + 16 * sg;
        *(bf16x8*)dst = hg_pack8(o, 0); *(bf16x8*)(dst + 8) = hg_pack8(o, 8);
    }
    asm volatile("s_waitcnt lgkmcnt(0)" ::: "memory"); __builtin_amdgcn_s_barrier(); asm volatile("" ::: "memory");
}

constexpr int SA_IMP = AL_IMPA;
constexpr int SA_UL = AL_END;
constexpr int SA_SM = SA_UL + 136 * 4;
constexpr int SA_END = SA_SM + 8 * 5 * 4;
static_assert(SA_END <= LDS_BYTES, "sample attention LDS control region");
struct SAttnP { const float* QBr; const float* qn_g; const float* gates; const float* relb; const float* KCS; const float* VCS; const float* cache_sel; const float* cache_win; const int* pt; const float* selnew; const float* winkv; float* PART; };
struct STile { const float* kp; const float* vp; int stride; int kmax; int k0; };

__device__ __forceinline__ bf16x8 sa_kfrag(const float* rowp, int s, int hi) {
    const f32x4 a = *(const f32x4*)(rowp + 16 * s + 8 * hi), c = *(const f32x4*)(rowp + 16 * s + 8 * hi + 4);
    u32x4 w; w.x = cvtpk(a[0], a[1]); w.y = cvtpk(a[2], a[3]); w.z = cvtpk(c[0], c[1]); w.w = cvtpk(c[2], c[3]); return __builtin_bit_cast(bf16x8, w);
}
__device__ __forceinline__ f32x16 sa_qk(const STile& T, const bf16x8 (&qf)[8], int l31, int hi) {
    const int kl = l31 < T.kmax ? l31 : T.kmax; const float* rowp = T.kp + (size_t)kl * T.stride;
    f32x16 p = {0.f, 0.f, 0.f, 0.f, 0.f, 0.f, 0.f, 0.f, 0.f, 0.f, 0.f, 0.f, 0.f, 0.f, 0.f, 0.f};
#pragma unroll
    for (int s = 0; s < 8; ++s) p = __builtin_amdgcn_mfma_f32_32x32x16_bf16(sa_kfrag(rowp, s, hi), qf[s], p, 0, 0, 0);
    return p;
}
__device__ __forceinline__ void sa_pv(f32x16 (&o)[4], const f32x16& e, const STile& T, int l31, int hi) {
#pragma unroll
    for (int ks = 0; ks < 2; ++ks) {
        u32x4 w; w.x = cvtpk(e[8 * ks + 0], e[8 * ks + 1]); w.y = cvtpk(e[8 * ks + 2], e[8 * ks + 3]); w.z = cvtpk(e[8 * ks + 4], e[8 * ks + 5]); w.w = cvtpk(e[8 * ks + 6], e[8 * ks + 7]);
        const bf16x8 pf = __builtin_bit_cast(bf16x8, w);
        f32x4 vv[8];
#pragma unroll
        for (int j = 0; j < 8; ++j) { int key = 16 * ks + 8 * (j >> 2) + 4 * hi + (j & 3); key = key < T.kmax ? key : T.kmax; vv[j] = *(const f32x4*)(T.vp + (size_t)key * T.stride + 4 * l31); }
#pragma unroll
        for (int dt = 0; dt < 4; ++dt) {
            u32x4 x; x.x = cvtpk(vv[0][dt], vv[1][dt]); x.y = cvtpk(vv[2][dt], vv[3][dt]); x.z = cvtpk(vv[4][dt], vv[5][dt]); x.w = cvtpk(vv[6][dt], vv[7][dt]);
            o[dt] = __builtin_amdgcn_mfma_f32_32x32x16_bf16(pf, __builtin_bit_cast(bf16x8, x), o[dt], 0, 0, 0);
        }
    }
}
template <int BR> __device__ __forceinline__ float sa_exp(f32x16& p, int k0, int hi, int qoff, const LAS float* bias_g, bool keep) {
    float sum = 0.f;
#pragma unroll
    for (int r = 0; r < 16; ++r) {
        const int kidx = k0 + crow(r, hi); const int rel = (BR == 0) ? qoff - (16 * kidx + 31) : qoff - kidx;
        const bool ok = rel >= 0 && (BR != 2 || rel < 512) && keep; const int ix = rel < 0 ? 0 : (rel > 128 ? 128 : rel);
        const float e = ok ? __builtin_amdgcn_exp2f(p[r] + bias_g[ix]) : 0.f; p[r] = e; sum += e;
    }
    return sum;
}
__device__ __forceinline__ void sa_reduce_store(f32x16 (&o)[4], float lsum, float* part_br, LAS unsigned char* lds, int wave, int lane, bool zero_it) {
    const int l31 = lane & 31, hi = lane >> 5, tid = wave * 64 + lane;
    LAS float* ob = (LAS float*)lds;
    LAS float* lx = (LAS float*)(lds + AL_LX);
    lsum += __shfl_xor(lsum, 32);
    if (hi == 0) lx[wave * 32 + l31] = lsum;
#pragma unroll
    for (int r = 0; r < 16; ++r) *(LAS f32x4*)(ob + (wave * 32 + crow(r, hi)) * 128 + 4 * l31) = (f32x4){o[0][r], o[1][r], o[2][r], o[3][r]};
    AT_BAR();
    for (int u = tid; u < 32 * 128; u += NTHR) { float s = 0.f;
#pragma unroll
        for (int w = 0; w < 8; ++w) s += ob[w * 4096 + u];
        part_br[(u >> 7) * 132 + (u & 127)] = zero_it ? 0.f : s; }
    if (tid < 32) { float s = 0.f;
#pragma unroll
        for (int w = 0; w < 8; ++w) s += lx[w * 32 + tid];
        part_br[tid * 132 + 128] = zero_it ? 0.f : s; }
    AT_BAR();
}

__device__ __forceinline__ void attn_sample_unit(const SAttnP& P0, int b, int kv, int part, LAS unsigned char* lds, int wave, int lane) {
    SAttnP P = P0;
    asm volatile("" : "+s"(P.QBr), "+s"(P.qn_g), "+s"(P.gates), "+s"(P.relb), "+s"(P.KCS), "+s"(P.VCS), "+s"(P.cache_sel));
    asm volatile("" : "+s"(P.cache_win), "+s"(P.pt), "+s"(P.selnew), "+s"(P.winkv), "+s"(P.PART));
    const int l31 = lane & 31, hi = lane >> 5, tid = wave * 64 + lane;
    const int t = l31 >> 2, g = l31 & 3, head = kv * 4 + g, qpos = PAST + t;
    const size_t row = (size_t)MP + b * TS + t;
    LAS float* biasT = (LAS float*)(lds + AL_BIAS); LAS float* lx = (LAS float*)(lds + AL_LX); LAS float* imp = (LAS float*)(lds + SA_IMP);
    LAS int* ulist = (LAS int*)(lds + SA_UL); LAS unsigned* smw = (LAS unsigned*)(lds + SA_SM);
    float bv0 = 0.f, bv1 = 0.f;
    { const int u0 = tid, u1 = tid + NTHR; bv0 = P.relb[rel_bucket(u0 % 129) * 8 + kv * 4 + u0 / 129]; if (u1 < 4 * 129) bv1 = P.relb[rel_bucket(u1 % 129) * 8 + kv * 4 + u1 / 129]; }
    bf16x8 qf[8];
    load_q_frags(qf, P.QBr + row * LQ + head * 128, P.qn_g, hi);
    { const int u0 = tid, u1 = tid + NTHR; biasT[(u0 / 129) * 132 + u0 % 129] = bv0 * LOG2E; if (u1 < 4 * 129) biasT[(u1 / 129) * 132 + u1 % 129] = bv1 * LOG2E; }
    const LAS float* bias_g = biasT + g * 132;
    float* pbuf = P.PART + (((size_t)b * 2 + kv) * 4 + part) * (3 * 32 * 132);
    f32x16 o[4];
#pragma unroll
    for (int dt = 0; dt < 4; ++dt) o[dt] = (f32x16){0.f, 0.f, 0.f, 0.f, 0.f, 0.f, 0.f, 0.f, 0.f, 0.f, 0.f, 0.f, 0.f, 0.f, 0.f, 0.f};
    AT_BAR();
    {
        float lsum = 0.f; f32x16 ex[2];
#pragma unroll
        for (int i = 0; i < 2; ++i) { const int u = 2 * wave + i;
            STile T; T.kp = P.KCS + (((size_t)b * 512 + 32 * u) * 2 + kv) * 128; T.vp = nullptr; T.stride = 256; T.kmax = 31; T.k0 = 32 * u;
            ex[i] = sa_qk(T, qf, l31, hi); lsum += sa_exp<0>(ex[i], T.k0, hi, qpos, bias_g, true);
        }
        const float lkeep = lsum;
        lsum += __shfl_xor(lsum, 32);
        if (hi == 0) lx[wave * 32 + l31] = lsum;
        AT_BAR();
        float ltot = 0.f;
#pragma unroll
        for (int w = 0; w < 8; ++w) ltot += lx[w * 32 + l31];
        const float inv = 1.0f / fmaxf(ltot, 1e-30f);
#pragma unroll
        for (int i = 0; i < 2; ++i) { const int u = 2 * wave + i;
            STile T; T.kp = nullptr; T.vp = P.VCS + (((size_t)b * 512 + 32 * u) * 2 + kv) * 128; T.stride = 256; T.kmax = 31; T.k0 = 32 * u;
#pragma unroll
            for (int r = 0; r < 16; ++r) { const float pn = ex[i][r] * inv; float v = pn + __shfl_xor(pn, 1); v += __shfl_xor(v, 2); if (g == 0) imp[t * 512 + T.k0 + crow(r, hi)] = v; }
            if (part == 0) sa_pv(o, ex[i], T, l31, hi);
        }
        AT_BAR();
        sa_reduce_store(o, lkeep, pbuf + 0 * (32 * 132), lds, wave, lane, part != 0);
#pragma unroll
        for (int dt = 0; dt < 4; ++dt) o[dt] = (f32x16){0.f, 0.f, 0.f, 0.f, 0.f, 0.f, 0.f, 0.f, 0.f, 0.f, 0.f, 0.f, 0.f, 0.f, 0.f, 0.f};
        {
            const int tk = wave; float sc3[3];
#pragma unroll
            for (int j = 0; j < 3; ++j) { const int s = lane + 64 * j; float v = -INFINITY;
                if (s <= 128) { float a = 0.f; const LAS float* ip = imp + tk * 512 + 4 * s; asm volatile("" : "+v"(ip));
#pragma unroll
                    for (int c = -1; c <= 3; ++c) if (4 * s + c >= 0 && 4 * s + c < 512) a += ip[c];
                    const bool forced = (s == 0) || (s == 128) || (s == 127); v = a + (forced ? 1.0e6f : 0.f); }
                sc3[j] = v; }
            LAS float* scT = (LAS float*)lds + tk * 192;
#pragma unroll
            for (int j = 0; j < 3; ++j) scT[lane + 64 * j] = sc3[j];
            asm volatile("s_waitcnt lgkmcnt(0)" ::: "memory"); __builtin_amdgcn_wave_barrier();
            int rk[3] = {0, 0, 0};
#pragma unroll 2
            for (int t4 = 0; t4 < 33; ++t4) { const f32x4 u4 = *(const LAS f32x4*)(scT + 4 * t4);
#pragma unroll
                for (int e = 0; e < 4; ++e) { const int tt = 4 * t4 + e;
#pragma unroll
                    for (int j = 0; j < 3; ++j) { const int s = lane + 64 * j; rk[j] += (u4[e] > sc3[j] || (u4[e] == sc3[j] && tt < s)) ? 1 : 0; } } }
            const unsigned long long m0 = __ballot(rk[0] < 16), m1 = __ballot(rk[1] < 16), m2 = __ballot(rk[2] < 16 && lane == 0);
            if (lane == 0) { smw[tk * 5] = (unsigned)m0; smw[tk * 5 + 1] = (unsigned)(m0 >> 32); smw[tk * 5 + 2] = (unsigned)m1; smw[tk * 5 + 3] = (unsigned)(m1 >> 32); smw[tk * 5 + 4] = (unsigned)(m2 & 1ull); }
        }
        AT_BAR();
    }
    const unsigned long long s0 = ((unsigned long long)smw[t * 5 + 1] << 32) | smw[t * 5], s1 = ((unsigned long long)smw[t * 5 + 3] << 32) | smw[t * 5 + 2]; const unsigned s2 = smw[t * 5 + 4];
    int nblk;
    {
        unsigned long long u0 = 0ull, u1 = 0ull; unsigned u2 = 0u;
#pragma unroll
        for (int k = 0; k < 8; ++k) { u0 |= ((unsigned long long)smw[k * 5 + 1] << 32) | smw[k * 5]; u1 |= ((unsigned long long)smw[k * 5 + 3] << 32) | smw[k * 5 + 2]; u2 |= smw[k * 5 + 4]; }
        const int n0 = __popcll(u0), n1 = __popcll(u1); nblk = n0 + n1 + (int)(u2 & 1u);
        if (wave == 0) {
            const unsigned long long below = (lane == 0) ? 0ull : (~0ull >> (64 - lane));
            if ((u0 >> lane) & 1ull) ulist[__popcll(u0 & below)] = lane;
            if ((u1 >> lane) & 1ull) ulist[n0 + __popcll(u1 & below)] = 64 + lane;
            if (lane == 0 && (u2 & 1u)) ulist[n0 + n1] = 128;
        }
    }
    AT_BAR();
    {
        const int rp = 3 - part;
        float lsum = 0.f; const int nmine = (nblk - rp + 3) >> 2;
#pragma unroll 1
        for (int it = wave; it < 2 * nmine; it += 8) {
            const int s = ulist[rp + 4 * (it >> 1)], sub = it & 1;
            if (s == 128 && sub == 1) continue;
            STile T;
            if (s < 128) { const size_t pg = (size_t)P.pt[b * NPAGE + (s >> 1)] * PAGE + (s & 1) * 64 + sub * 32; T.kp = P.cache_sel + pg * 512 + kv * 128; T.vp = T.kp + 256; T.stride = 512; T.kmax = 31; }
            else { T.kp = P.selnew + (size_t)b * TS * 512 + kv * 128; T.vp = T.kp + 256; T.stride = 512; T.kmax = 7; }
            T.k0 = 64 * s + 32 * sub;
            const bool keep = (s < 64) ? (((s0 >> s) & 1ull) != 0ull) : (s < 128 ? (((s1 >> (s - 64)) & 1ull) != 0ull) : ((s2 & 1u) != 0u));
            f32x16 sc = sa_qk(T, qf, l31, hi); lsum += sa_exp<1>(sc, T.k0, hi, qpos, bias_g, keep);
            sa_pv(o, sc, T, l31, hi);
        }
        sa_reduce_store(o, lsum, pbuf + 1 * (32 * 132), lds, wave, lane, false);
#pragma unroll
        for (int dt = 0; dt < 4; ++dt) o[dt] = (f32x16){0.f, 0.f, 0.f, 0.f, 0.f, 0.f, 0.f, 0.f, 0.f, 0.f, 0.f, 0.f, 0.f, 0.f, 0.f, 0.f};
    }
    {
        float lsum = 0.f;
#pragma unroll 1
        for (int u = (3 - part) + 4 * wave; u < 17; u += 32) {
            STile T;
            if (u < 16) { T.kp = P.cache_win + ((size_t)b * 512 + 32 * u) * 512 + kv * 128; T.vp = T.kp + 256; T.stride = 512; T.kmax = 31; }
            else { T.kp = P.winkv + ((size_t)MP + b * TS) * 512 + kv * 128; T.vp = T.kp + 256; T.stride = 512; T.kmax = 7; }
            T.k0 = 32 * u;
            f32x16 sc = sa_qk(T, qf, l31, hi); lsum += sa_exp<2>(sc, T.k0, hi, 512 + t, bias_g, true);
            sa_pv(o, sc, T, l31, hi);
        }
        sa_reduce_store(o, lsum, pbuf + 2 * (32 * 132), lds, wave, lane, false);
    }
}
__device__ __forceinline__ void attn_sample_combine(const float* PART, const float* gates, bf16* OB, int idx  , int lane) {
    const int rl = idx >> 3, head = idx & 7, b = rl >> 3, t = rl & 7, kv = head >> 2, g = head & 3, r = t * 4 + g;
    const float* base = PART + ((size_t)b * 2 + kv) * 4 * (3 * 32 * 132);
    float acc0 = 0.f, acc1 = 0.f;
#pragma unroll
    for (int br = 0; br < 3; ++br) {
        float l = 0.f, a0 = 0.f, a1 = 0.f;
#pragma unroll
        for (int p = 0; p < 4; ++p) { const float* q = base + ((size_t)p * 3 + br) * (32 * 132) + r * 132; l += q[128]; a0 += q[lane]; a1 += q[lane + 64]; }
        const float f = gates[((size_t)MP + rl) * 24 + head * 3 + br] / fmaxf(l, 1e-30f); acc0 += f * a0; acc1 += f * a1;
    }
    OB[((size_t)MP + rl) * 1024 + head * 128 + lane] = f2bf(acc0); OB[((size_t)MP + rl) * 1024 + head * 128 + lane + 64] = f2bf(acc1);
}

constexpr size_t al256(size_t x) { return (x + 255) & ~(size_t)255; }
constexpr size_t WS_BAR = 0;
constexpr size_t WS_WT_IN = al256(WS_BAR + XCD_BAR_WORDS * 4);
constexpr size_t WS_WT_BA = al256(WS_WT_IN + (size_t)NPROJ * D * 2);
constexpr size_t WS_WT_BB = al256(WS_WT_BA + (size_t)D * 1024 * 2);
constexpr size_t WS_WT_OUT = al256(WS_WT_BB + (size_t)D * 1024 * 2);
constexpr size_t WS_WT_1 = al256(WS_WT_OUT + (size_t)D * D * 2);
constexpr size_t WS_WT_2 = al256(WS_WT_1 + (size_t)DFF * D * 2);
constexpr size_t WS_MODS = al256(WS_WT_2 + (size_t)D * DFF * 2);
constexpr size_t WS_H = al256(WS_MODS + (size_t)34 * NMOD * 4);
constexpr size_t WS_PROJ = al256(WS_H + (size_t)MT * D * 2);
constexpr size_t WS_WINKV = al256(WS_PROJ + (size_t)0);
constexpr size_t WS_QN = al256(WS_WINKV + (size_t)MT * 512 * 4);
constexpr size_t WS_F = al256(WS_QN + (size_t)0);
constexpr size_t WS_ORAW = al256(WS_F + (size_t)MT * LQ * 4);
constexpr size_t WS_OA = al256(WS_ORAW + (size_t)MT * 1024 * 4);
constexpr size_t WS_OB = al256(WS_OA + (size_t)MT * 1024 * 2);
constexpr size_t WS_KCP = al256(WS_OB + (size_t)MT * 1024 * 2);
constexpr size_t WS_VCP = al256(WS_KCP + (size_t)0);
constexpr size_t WS_KCS = al256(WS_VCP + (size_t)0);
constexpr size_t WS_VCS = al256(WS_KCS + (size_t)32 * 512 * 256 * 4);
constexpr size_t WS_PCMP = al256(WS_VCS + (size_t)32 * 512 * 256 * 4);
constexpr size_t WS_IDX = al256(WS_PCMP + (size_t)0);
constexpr size_t WS_OCMP = al256(WS_IDX + (size_t)0);
constexpr size_t WS_OSEL = al256(WS_OCMP + (size_t)0);
constexpr size_t WS_OWIN = al256(WS_OSEL + (size_t)0);
constexpr size_t WS_T = al256(WS_OWIN + (size_t)0);
constexpr size_t WS_MERGED = al256(WS_T + (size_t)MT * D * 4);
constexpr size_t WS_X1 = al256(WS_MERGED + (size_t)MT * D * 2);
constexpr size_t WS_U = al256(WS_X1 + (size_t)MT * D * 4);
constexpr size_t WS_QNB = al256(WS_U + (size_t)MT * DFF * 2);
constexpr size_t WS_GATES = al256(WS_QNB + (size_t)0);
constexpr size_t WS_KSF = al256(WS_GATES + (size_t)MT * 24 * 4);
constexpr size_t WS_VSF = al256(WS_KSF + (size_t)4 * 128 * 4096 * 2);
constexpr size_t WS_KWF = al256(WS_VSF + (size_t)4 * 128 * 4096 * 2);
constexpr size_t WS_VWF = al256(WS_KWF + (size_t)4 * 128 * 4096 * 2);
constexpr size_t WS_KCF = al256(WS_VWF + (size_t)4 * 128 * 4096 * 2);
constexpr size_t WS_VCF = al256(WS_KCF + (size_t)4 * 8 * 4096 * 2);
constexpr size_t WS_OT = al256(WS_VCF + (size_t)4 * 8 * 4096 * 2);
constexpr size_t WS_IMP = al256(WS_OT + (size_t)0);
constexpr size_t WS_XHC = al256(WS_IMP + (size_t)0);
constexpr size_t WS_XHP = al256(WS_XHC + (size_t)256 * 256 * 2048 * 2);
constexpr size_t WS_WC1T = al256(WS_XHP + (size_t)2 * XHP_ROWS * 2048 * 2);
constexpr size_t WS_PREC = al256(WS_WC1T + (size_t)512 * 2048 * 2);
constexpr size_t WS_PREP = al256(WS_PREC + (size_t)2 * XHC_ROWS * 256 * 4);
constexpr size_t WS_HQS = al256(WS_PREP + (size_t)2 * XHP_ROWS * 256 * 4);
constexpr size_t WS_HOI = al256(WS_HQS + (size_t)MP * 1024 * 2);
constexpr size_t WS_HLB = al256(WS_HOI + (size_t)MP * 1024 * 4);
constexpr size_t WS_HDEC = al256(WS_HLB + (size_t)1024 * 16384 * 4);
constexpr size_t WS_HSPT = al256(WS_HDEC + (size_t)1024 * 128 * 4);
constexpr size_t WS_PART = al256(WS_HSPT + (size_t)1024 * 16384 * 2);
constexpr size_t WS_SLAB = al256(WS_PART + (size_t)64 * 4 * 3 * 32 * 132 * 4);
constexpr size_t WS_MODP = al256(WS_SLAB + (size_t)16 * 256 * 2048 * 4);
constexpr size_t WS_QAB = al256(WS_MODP + (size_t)8 * 34 * NMOD * 4);
constexpr size_t WS_IAB = al256(WS_QAB + (size_t)MT * LQ * 2);
constexpr size_t WS_GAS = al256(WS_IAB + (size_t)MT * LQ * 2);
constexpr size_t WS_QBR = al256(WS_GAS + (size_t)MT * LQ * 2);
constexpr size_t WS_MGAB = al256(WS_QBR + (size_t)MT * LQ * 4);
constexpr size_t WS_MGBB = al256(WS_MGAB + (size_t)MT * LMG * 2);
constexpr size_t WS_W2T = al256(WS_MGBB + (size_t)MT * LMG * 2);
constexpr size_t WS_END = al256(WS_W2T + (size_t)2 * 16384 * 2);

struct Args { const void* in[32]; float* out; unsigned char* ws; int ph_lo, ph_hi; };

#define G_x_p ((const float*)a.in[0])
#define G_x_s ((const float*)a.in[1])
#define G_c_p ((const float*)a.in[2])
#define G_c_s ((const float*)a.in[3])
#define G_cache_cmp ((const float*)a.in[4])
#define G_cache_sel ((const float*)a.in[5])
#define G_cache_win ((const float*)a.in[6])
#define G_state ((const float*)a.in[7])
#define G_pt ((const int*)a.in[8])
#define G_lbl ((const float*)a.in[9])
#define G_relb ((const float*)a.in[10])
#define G_ada_w ((const float*)a.in[11])
#define G_ada_b ((const float*)a.in[12])
#define G_norm1 ((const float*)a.in[13])
#define G_norm2 ((const float*)a.in[14])
#define G_w_in ((const float*)a.in[15])
#define G_onorm ((const float*)a.in[16])
#define G_qn_g ((const float*)a.in[17])
#define G_ks_g ((const float*)a.in[19])
#define G_kw_g ((const float*)a.in[20])
#define G_w_ba ((const float*)a.in[27])
#define G_w_bb ((const float*)a.in[28])
#define G_w_out ((const float*)a.in[29])
#define G_w1 ((const float*)a.in[30])
#define G_w2 ((const float*)a.in[31])
#define G_Wt_in ((bf16*)(a.ws + WS_WT_IN))
#define G_Wt_ba ((bf16*)(a.ws + WS_WT_BA))
#define G_Wt_bb ((bf16*)(a.ws + WS_WT_BB))
#define G_Wt_out ((bf16*)(a.ws + WS_WT_OUT))
#define G_Wt_1 ((bf16*)(a.ws + WS_WT_1))
#define G_Wt_2 ((bf16*)(a.ws + WS_WT_2))
#define G_mods ((float*)(a.ws + WS_MODS))
#define G_H ((bf16*)(a.ws + WS_H))
#define G_proj ((float*)(a.ws + WS_PROJ))
#define G_winkv ((float*)(a.ws + WS_WINKV))
#define G_QN ((float*)(a.ws + WS_QN))
#define G_F ((float*)(a.ws + WS_F))
#define G_oraw ((float*)(a.ws + WS_ORAW))
#define G_OA ((bf16*)(a.ws + WS_OA))
#define G_OB ((bf16*)(a.ws + WS_OB))
#define G_KCP ((float*)(a.ws + WS_KCP))
#define G_VCP ((float*)(a.ws + WS_VCP))
#define G_KCS ((float*)(a.ws + WS_KCS))
#define G_VCS ((float*)(a.ws + WS_VCS))
#define G_PCMP ((float*)(a.ws + WS_PCMP))
#define G_IDX ((int*)(a.ws + WS_IDX))
#define G_OCMP ((float*)(a.ws + WS_OCMP))
#define G_OSEL ((float*)(a.ws + WS_OSEL))
#define G_OWIN ((float*)(a.ws + WS_OWIN))
#define G_QNb ((bf16*)(a.ws + WS_QNB))
#define G_GATES ((float*)(a.ws + WS_GATES))
#define G_KSf ((bf16*)(a.ws + WS_KSF))
#define G_VSf ((bf16*)(a.ws + WS_VSF))
#define G_KWf ((bf16*)(a.ws + WS_KWF))
#define G_VWf ((bf16*)(a.ws + WS_VWF))
#define G_KCf ((bf16*)(a.ws + WS_KCF))
#define G_VCf ((bf16*)(a.ws + WS_VCF))
#define G_T ((float*)(a.ws + WS_T))
#define G_MERGED ((bf16*)(a.ws + WS_MERGED))
#define G_X1 ((float*)(a.ws + WS_X1))
#define G_U ((bf16*)(a.ws + WS_U))
#define G_XHC ((bf16*)(a.ws + WS_XHC))
#define G_XHP ((bf16*)(a.ws + WS_XHP))
#define G_Wc1t ((bf16*)(a.ws + WS_WC1T))
#define G_PREC ((float*)(a.ws + WS_PREC))
#define G_PREP ((float*)(a.ws + WS_PREP))
#define G_out (a.out)
#define G_ws (a.ws)
#define lane ((int)__builtin_amdgcn_mbcnt_hi(~0u, __builtin_amdgcn_mbcnt_lo(~0u, 0u)))
#define wave (wave_s)
#define tid (wave_s * 64 + lane)
#define sub2 (wave_s >> 2)
#define lt2 ((wave_s & 3) * 64 + lane)
#define sub4 (wave_s >> 1)
#define lt4 ((wave_s & 1) * 64 + lane)
__global__ void __launch_bounds__(NTHR, 2) mk_fwd(Args a) {
    extern __shared__ __attribute__((aligned(16))) unsigned char lds[];
    const int G = gridDim.x, bid = blockIdx.x;
    const int wave_s = __builtin_amdgcn_readfirstlane((int)threadIdx.x >> 6);
    if (threadIdx.x < 4) ((unsigned*)(lds + LDS_CTL))[threadIdx.x] = 0u;
    __syncthreads();
    const int lo = a.ph_lo, hi = a.ph_hi;
    XcdBarrier bar; bar.bar = (unsigned*)(G_ws + WS_BAR); bar.x = 0; bar.st = nullptr;
    if (hi - lo > 1) bar = xcd_barrier_post((unsigned*)(G_ws + WS_BAR), (volatile LAS unsigned*)(lds + LDS_CTL), wave_s);
#define IN(k) (lo <= (k) && (k) < hi)
#define MK_HGP() HgP hp; hp.QAb = (const bf16*)(G_ws + WS_QAB); hp.IAb = (const bf16*)(G_ws + WS_IAB); hp.GAs = (const bf16*)(G_ws + WS_GAS); hp.F = G_F; hp.QS = (bf16*)(G_ws + WS_HQS); hp.OI = (float*)(G_ws + WS_HOI); hp.Lb = (float*)(G_ws + WS_HLB); hp.DEC = (float*)(G_ws + WS_HDEC); hp.SPT = (bf16*)(G_ws + WS_HSPT)
#define SEAM(k) do { if (IN(k) && IN((k) + 1)) xcd_barrier(bar, wave_s); } while (0)
    float* ldsf = (float*)lds;

    struct TD { const float* src; bf16* dst; int ldw, K, lim; };
    auto pipe_tiles = [&](int it, const int end, const int stride, auto&& decode) {
            const int lk = tid >> 5, n4 = (tid & 31) * 4;
            if (it < end) {
                TD d = decode(it); f32x4 v[8];
#pragma unroll
                for (int p = 0; p < 8; ++p) { v[p] = (f32x4){0.f, 0.f, 0.f, 0.f}; if (n4 < d.lim) v[p] = *(const f32x4*)(d.src + (size_t)(p * 16 + lk) * d.ldw + n4); }
#pragma unroll 1
                for (;;) {
#pragma unroll
                    for (int p = 0; p < 8; ++p) { float* t = ldsf + (p * 16 + lk) * 129 + n4; t[0] = v[p][0]; t[1] = v[p][1]; t[2] = v[p][2]; t[3] = v[p][3]; }
                    __syncthreads();
                    const int nx = it + stride; const bool has = nx < end; const TD dn = decode(has ? nx : it);
                    if (has) {
#pragma unroll
                        for (int p = 0; p < 8; ++p) { v[p] = (f32x4){0.f, 0.f, 0.f, 0.f}; if (n4 < dn.lim) v[p] = *(const f32x4*)(dn.src + (size_t)(p * 16 + lk) * dn.ldw + n4); }
                    }
#pragma unroll
                    for (int p = 0; p < 4; ++p) { const int n = p * 32 + (tid >> 4), kg = tid & 15; const float* t = ldsf + (8 * kg) * 129 + n;
                        u32x4 w; w.x = cvtpk(t[0], t[129]); w.y = cvtpk(t[2 * 129], t[3 * 129]); w.z = cvtpk(t[4 * 129], t[5 * 129]); w.w = cvtpk(t[6 * 129], t[7 * 129]);
                        *(u32x4*)(d.dst + (size_t)n * d.K + 8 * kg) = w; }
                    __syncthreads();
                    if (!has) break;
                    it = nx; d = dn;
                }
            }
    };
    constexpr int T_2S = 0, T_2P = (D / 128) * (DFF / 128) - T_2S;
    constexpr int T_1S = (DFF / 128) * (D / 128), T_1P = (DFF / 128) * (D / 128) - T_1S;
    if (IN(PH_PRO)) {
        constexpr int T_IN = (NPROJ / 128) * (D / 128), T_BA = (D / 128) * (1024 / 128), T_OUT = (D / 128) * (D / 128), T_1 = (DFF / 128) * (D / 128), T_2 = (D / 128) * (DFF / 128), T_C = 4 * 16;
        constexpr int NT = T_IN + 2 * T_BA + T_OUT + T_1P + T_2P + T_C + 2;
        constexpr int NT0 = 64 * 14;
        auto decode = [&](int it) -> TD {
            int r = it; TD d;
            if (r < T_IN) { const int nb = r % (NPROJ / 128), kb = r / (NPROJ / 128), n0 = nb * 128; const int c0 = win_col(n0); d.lim = n0 < C_GATE ? 128 : (n0 == C_GATE ? 24 : 0);
                d.src = G_w_in + (size_t)(kb * 128) * IN_COLS + (c0 < 0 ? 0 : c0); d.ldw = IN_COLS; d.dst = G_Wt_in + (size_t)n0 * D + kb * 128; d.K = D; return d; } r -= T_IN;
            d.lim = 128;
            if (r < T_BA) { d.src = G_w_ba + (size_t)((r / 16) * 128) * D + (r % 16) * 128; d.ldw = D; d.dst = G_Wt_ba + (size_t)((r % 16) * 128) * 1024 + (r / 16) * 128; d.K = 1024; return d; } r -= T_BA;
            if (r < T_BA) { d.src = G_w_bb + (size_t)((r / 16) * 128) * D + (r % 16) * 128; d.ldw = D; d.dst = G_Wt_bb + (size_t)((r % 16) * 128) * 1024 + (r / 16) * 128; d.K = 1024; return d; } r -= T_BA;
            if (r < T_OUT) { d.src = G_w_out + (size_t)((r / 16) * 128) * D + (r % 16) * 128; d.ldw = D; d.dst = G_Wt_out + (size_t)((r % 16) * 128) * D + (r / 16) * 128; d.K = D; return d; } r -= T_OUT;
            if (r < T_1P) { const int q = r + T_1S; d.src = G_w1 + (size_t)((q / 64) * 128) * DFF + (q % 64) * 128; d.ldw = DFF; d.dst = G_Wt_1 + (size_t)((q % 64) * 128) * D + (q / 64) * 128; d.K = D; return d; } r -= T_1P;
            if (r < T_2P) { const int q = r + T_2S; d.src = G_w2 + (size_t)((q / 16) * 128) * D + (q % 16) * 128; d.ldw = D; d.dst = G_Wt_2 + (size_t)((q % 16) * 128) * DFF + (q / 16) * 128; d.K = DFF; return d; } r -= T_2P;
            if (r >= T_C) { const int w = r - T_C; d.src = w ? (const float*)a.in[26] : (const float*)a.in[23]; d.ldw = 128; d.dst = (bf16*)(G_ws + WS_W2T) + (size_t)w * 16384; d.K = 128; return d; }
            { const int wh = r >> 4, kb = r & 15;
              d.src = (wh >> 1 ? (const float*)a.in[24] : (const float*)a.in[21]) + (size_t)(wh & 1) * 2048 * 128 + (size_t)(kb * 128) * 128; d.ldw = 128; d.dst = G_Wc1t + (size_t)wh * 128 * 2048 + kb * 128; d.K = 2048; return d; }
        };
        pipe_tiles(bid < 64 ? bid : NT0 + bid - 64, bid < 64 ? NT0 : NT, bid < 64 ? 64 : 192, decode);
        for (size_t u = (size_t)bid * NTHR + tid; u < (size_t)2 * 4 * 8 * 4096 / 8; u += (size_t)G * NTHR) { bf16* z = u < (size_t)4 * 8 * 4096 / 8 ? G_KCf + u * 8 : G_VCf + (u - (size_t)4 * 8 * 4096 / 8) * 8; *(u32x4*)z = (u32x4){0u, 0u, 0u, 0u}; }
        for (size_t u = (size_t)bid * NTHR + tid; u < (size_t)2 * 256 * 2048 / 8; u += (size_t)G * NTHR) { const size_t w = u / (256 * 256), r = u % (256 * 256); *(u32x4*)(G_XHP + ((size_t)w * XHP_ROWS + 1024) * 2048 + r * 8) = (u32x4){0u, 0u, 0u, 0u}; }
        for (int it = G - 1 - bid; it < 192; it += G) b_mods_part(G_c_p, G_c_s, G_ada_w, (float*)(G_ws + WS_MODP), it % 24, it / 24, tid, ldsf);
    }
    SEAM(PH_PRO);
    if (IN(PH_MRED)) { const float* mp = (const float*)(G_ws + WS_MODP);
        for (int u = bid * NTHR + tid; u < 34 * NMOD; u += G * NTHR) { float s = G_ada_b[u % NMOD];
#pragma unroll
            for (int kc = 0; kc < 8; ++kc) s += mp[(size_t)kc * 34 * NMOD + u];
            G_mods[u] = s; } }
    SEAM(PH_MRED);
    if (IN(PH_NORM1)) { for (int row = bid * 2 + sub2; row < MT; row += G * 8) b_hnorm4(G_x_p, G_x_s, G_norm1, G_mods, 0, 1, G_H, row, MT, lt2, ldsf + sub2 * 16); }
    SEAM(PH_NORM1);
    if (IN(PH_INPROJ)) {
        pg8::Gemm g{G_H, G_Wt_in, MT, NPROJ, D, D, nullptr, nullptr};
        EpiInProj E; E.o.QAb = (bf16*)(G_ws + WS_QAB); E.o.F = G_F; E.o.IAb = (bf16*)(G_ws + WS_IAB); E.o.GAs = (bf16*)(G_ws + WS_GAS); E.o.QBr = (float*)(G_ws + WS_QBR); E.o.out = G_out; E.o.XHP = G_XHP; E.o.WINKV = G_winkv;
        E.o.MGAb = (bf16*)(G_ws + WS_MGAB); E.o.MGBb = (bf16*)(G_ws + WS_MGBB); E.o.GATES = G_GATES; E.o.lbl = G_lbl;
        const int ksplit = (bid >> 3) % 6;
        { RangeOrder<pg8::StaticOrder> S; S.B.init(MT, NPROJ, G, bid, D); S.i0 = 0; S.i1 = ksplit;
          pg8::gemm_phase<EpiInProj, RangeOrder<pg8::StaticOrder>, false>((PG8_LAS unsigned char*)lds, g, S, E, nullptr, wave_s); }
        { bf16* panel = G_XHC + (size_t)bid * 256 * 2048; const int L = bid;
          __syncthreads();
          b_xhc_panel(G_cache_cmp, G_pt, panel, L, tid);
          __syncthreads();
          pg8::Gemm gc{panel, G_Wc1t, 256, 512, 2048, 2048, nullptr, nullptr}; OneOrder S; S.pn = L >> 7; EpiGen<FStorePre> Ec; Ec.f.C = G_PREC; Ec.f.rowoff = L * 256; Ec.f.pad = 0; Ec.slab = nullptr; Ec.slab_n = 0; Ec.kslice = 1;
          pg8::gemm_phase<EpiGen<FStorePre>, OneOrder, false>((PG8_LAS unsigned char*)lds, gc, S, Ec, nullptr, wave_s); }
        { RangeOrder<pg8::StaticOrder> S; S.B.init(MT, NPROJ, G, bid, D); S.i0 = ksplit; S.i1 = 1 << 20;
          pg8::gemm_phase<EpiInProj, RangeOrder<pg8::StaticOrder>, false>((PG8_LAS unsigned char*)lds, g, S, E, nullptr, wave_s); }
        if (bid >= 139) { __syncthreads();
            auto dec1 = [&](int q) -> TD { TD d; d.lim = 128; d.src = G_w1 + (size_t)((q / 64) * 128) * DFF + (q % 64) * 128; d.ldw = DFF; d.dst = G_Wt_1 + (size_t)((q % 64) * 128) * D + (q / 64) * 128; d.K = D; return d; };
            pipe_tiles(bid - 139, T_1S, 117, dec1); }
    }
    SEAM(PH_INPROJ);
    if (IN(PH_MIX1)) {
        b_hgrn_seq_s((const bf16*)(G_ws + WS_QAB), (const bf16*)(G_ws + WS_IAB), G_F, G_state, G_oraw, G_out, bid, tid, ldsf, ldsf + 1024);
        const int NW = G - 10;
        if (bid < NW) for (int it = NW - 1 - bid; it < 1024; it += NW) { const int which = it >> 9, r = it & 511, b = r >> 8, kv = (r >> 7) & 1, Tt = r & 127; const size_t to = (((size_t)b * 2 + kv) * 128 + Tt) * 4096;
            float* wout = (which == 1 && Tt >= 112) ? G_out + O_WINP + ((size_t)b * 512 + 32 * (Tt - 112)) * 512 : nullptr;
            prep_kv_tile(which == 0 ? G_out + O_SELP : G_winkv, which == 0 ? G_ks_g : G_kw_g, (which == 0 ? G_KSf : G_KWf) + to, (which == 0 ? G_VSf : G_VWf) + to, wout, b, kv, Tt, tid, ldsf + 20480); }
        for (int it = bid; it < 32; it += G) prep_kv_sample(G_out, G_winkv, G_ks_g, G_kw_g, it * 32 + (tid >> 4), tid & 15);
        { const size_t n = (size_t)BS * 504 * 512 / 4;
          for (size_t i = (size_t)bid * NTHR + tid; i < n; i += (size_t)G * NTHR) { const size_t b = i / (504 * 128), r = i % (504 * 128); *(f32x4*)(G_out + O_WINS + b * 512 * 512 + r * 4) = *(const f32x4*)(G_cache_win + b * 512 * 512 + 8 * 512 + r * 4); } }
        { MK_HGP();
          if (bid < NW)
#pragma unroll 1
          for (int item = bid; item < 1024; item += NW) hgrn_local(hp, item, (LAS unsigned char*)lds, tid); }
        { pg8::Gemm g{G_XHP, G_Wc1t, 2 * XHP_ROWS, 512, 2048, 2048, nullptr, nullptr}; DiagOrder S; S.n = 10; S.per = 5; S.G = G; S.c = G - 1 - bid; EpiGen<FStorePre> E; E.f.C = G_PREP; E.f.rowoff = 0; E.f.pad = 0; E.slab = nullptr; E.slab_n = 0; E.kslice = 1;
          __syncthreads();
          pg8::gemm_phase<EpiGen<FStorePre>, DiagOrder, false>((PG8_LAS unsigned char*)lds, g, S, E, nullptr, wave_s); }
    }
    SEAM(PH_MIX1);
    if (IN(PH_CFIN)) {
        CmpW cw; cw.kw1 = (const float*)a.in[21]; cw.kb1 = (const float*)a.in[22]; cw.kw2 = (const float*)a.in[23]; cw.vw1 = (const float*)a.in[24]; cw.vb1 = (const float*)a.in[25]; cw.vw2 = (const float*)a.in[26]; cw.kc_g = (const float*)a.in[18];
        { MK_HGP();
          const int bh = bid >> 4, k = (bid & 15) * 8 + wave;
#pragma unroll 1
          for (int e = 0; e < 2; ++e) hgrn_carry(hp, G_out + O_HGP, bh, k, lane + 64 * e); }
        for (int item = bid * 8 + wave; item < 64 + 2048; item += G * 8) b_cfin_mfma(G_PREC, G_PREP, (const bf16*)(G_ws + WS_W2T), cw, G_KCf, G_VCf, G_KCS, G_VCS, item, lane);
    }
    SEAM(PH_CFIN);
    if (IN(PH_ATTN)) {
        for (int row = MP + bid * 2 + sub2; row < MT; row += G * 2) b_hgrn_out(G_oraw, (const bf16*)(G_ws + WS_GAS), G_onorm, G_OA, row, lt2);
        { MK_HGP();
#pragma unroll 1
          for (int item = bid; item < 1024; item += G) hgrn_output(hp, G_onorm, G_OA, item, (LAS unsigned char*)lds, tid); }
        AttnP P; P.QBr = (const float*)(G_ws + WS_QBR); P.qn_g = G_qn_g; P.KSf = G_KSf; P.VSf = G_VSf; P.KWf = G_KWf; P.VWf = G_VWf; P.KCf = G_KCf; P.VCf = G_VCf; P.gates = G_GATES; P.relb = G_relb; P.OB = G_OB; P.OT = (float*)(G_ws + WS_OT); P.IMP = (float*)(G_ws + WS_IMP);
#pragma unroll 1
        for (int k = 0; k < 2; ++k) { const int u = bid, bk = u & 3, m = u >> 2; attn_prompt_unit(P, bk >> 1, bk & 1, k ? m : 127 - m, (LAS unsigned char*)lds, wave, lane); }
    }
    SEAM(PH_ATTN);
    if (IN(PH_SATTN)) {
        SAttnP P; P.QBr = (const float*)(G_ws + WS_QBR); P.qn_g = G_qn_g; P.gates = G_GATES; P.relb = G_relb; P.KCS = G_KCS; P.VCS = G_VCS; P.cache_sel = G_cache_sel; P.cache_win = G_cache_win; P.pt = G_pt; P.selnew = G_out + O_SELS; P.winkv = G_winkv; P.PART = (float*)(G_ws + WS_PART);
        { const int g = ((bid >> 5) << 3) | (bid & 7), part = (bid >> 3) & 3; attn_sample_unit(P, g >> 1, g & 1, part, (LAS unsigned char*)lds, wave, lane); }
    }
    SEAM(PH_SATTN);
    if (IN(PH_SCOMB)) { for (int idx = bid * 8 + wave; idx < 2048; idx += G * 8) attn_sample_combine((const float*)(G_ws + WS_PART), G_GATES, G_OB, idx, lane); }
    SEAM(PH_SCOMB);
#define SLABP(off) ((float*)(G_ws + WS_SLAB) + (size_t)(off))
    if (IN(PH_BR)) { if (T_2S > 0 && bid >= 64) { const int q = bid - 64; b_transpose128(G_w2, D, (q % 16) * 128, 128, G_Wt_2, DFF, (q % 16) * 128, (q / 16) * 128, tid, ldsf); }
        pg8::Gemm g{G_OA, G_Wt_ba, MT, D, 1024, 1024, G_OB, G_Wt_bb}; PairOrder S; S.init(D, 1024, 4, G, bid);
        EpiBranch E; E.mga = (const bf16*)(G_ws + WS_MGAB); E.mgb = (const bf16*)(G_ws + WS_MGBB); E.merged = G_MERGED; E.slab = SLABP(0); E.kslice = 256; E.pad = 0;
        pg8::gemm_phase<EpiBranch, PairOrder, false>((PG8_LAS unsigned char*)lds, g, S, E, nullptr, wave_s); }
    SEAM(PH_BR);
    if (IN(PH_RMERGE)) {
        const float* sa = SLABP(0); const float* sb = SLABP(4 * 256 * 2048);
        for (int u = bid * NTHR + tid; u < 256 * 512; u += G * NTHR) { const int r = u >> 9, c = (u & 511) * 4; f32x4 x = {0.f, 0.f, 0.f, 0.f}, y = x;
#pragma unroll
            for (int ks = 0; ks < 4; ++ks) { x += *(const f32x4*)(sa + ((size_t)ks * 256 + r) * 2048 + c); y += *(const f32x4*)(sb + ((size_t)ks * 256 + r) * 2048 + c); }
            const ushort4 ga = *(const ushort4*)((const bf16*)(G_ws + WS_MGAB) + ((size_t)MP + r) * LMG + c), gb = *(const ushort4*)((const bf16*)(G_ws + WS_MGBB) + ((size_t)MP + r) * LMG + c); ushort4 o;
            o.x = f2bf(bf2f(ga.x) * x[0] + bf2f(gb.x) * y[0]); o.y = f2bf(bf2f(ga.y) * x[1] + bf2f(gb.y) * y[1]); o.z = f2bf(bf2f(ga.z) * x[2] + bf2f(gb.z) * y[2]); o.w = f2bf(bf2f(ga.w) * x[3] + bf2f(gb.w) * y[3]);
            *(ushort4*)(G_MERGED + ((size_t)MP + r) * D + c) = o; }
    }
    SEAM(PH_RMERGE);
    if (IN(PH_OUT)) { if (T_2S > 0 && bid >= 64) { const int q = 192 + bid - 64; b_transpose128(G_w2, D, (q % 16) * 128, 128, G_Wt_2, DFF, (q % 16) * 128, (q / 16) * 128, tid, ldsf); }
        pg8::Gemm g{G_MERGED, G_Wt_out, MT, D, D, D, nullptr, nullptr}; MixOrder S; S.init(D, D, 8, G, bid); EpiGen<FRes1> E; E.f.xp = G_x_p; E.f.xs = G_x_s; E.f.mods = G_mods; E.f.X1 = G_X1; E.slab = SLABP(0); E.slab_n = D; E.kslice = 256;
        pg8::gemm_phase<EpiGen<FRes1>, MixOrder, false>((PG8_LAS unsigned char*)lds, g, S, E, nullptr, wave_s); }
    SEAM(PH_OUT);
    if (IN(PH_NORM2)) {
        for (int row = MP + bid * 2 + sub2; row < MT; row += G * 2) b_norm2_sample(G_x_s, SLABP(0), G_norm2, G_mods, G_X1, G_H, row, lt2, ldsf + sub2 * 4);
        for (int row = bid * 2 + sub2; row < MP; row += G * 8) b_hnorm4(G_X1, G_X1 + (size_t)MP * D, G_norm2, G_mods, 3, 4, G_H, row, MP, lt2, ldsf + sub2 * 16);
    }
    SEAM(PH_NORM2);
    if (IN(PH_MLP1)) { if (T_2S > 0 && bid >= 128) { for (int q = 384 + (bid - 128) * 2; q < 384 + (bid - 128) * 2 + 2; ++q) b_transpose128(G_w2, D, (q % 16) * 128, 128, G_Wt_2, DFF, (q % 16) * 128, (q / 16) * 128, tid, ldsf); }
        pg8::Gemm g{G_H, G_Wt_1, MT, DFF, D, D, nullptr, nullptr}; MixOrder S; S.init(DFF, D, 4, G, bid); EpiGen<FRelu2> E; E.f.U = G_U; E.slab = SLABP(0); E.slab_n = DFF; E.kslice = 512;
        pg8::gemm_phase<EpiGen<FRelu2>, MixOrder, false>((PG8_LAS unsigned char*)lds, g, S, E, nullptr, wave_s); }
    SEAM(PH_MLP1);
    if (IN(PH_RU)) {
        const float* su = SLABP(0);
        for (int u = bid * NTHR + tid; u < 256 * 2048; u += G * NTHR) { const int r = u >> 11, c = (u & 2047) * 4; f32x4 x = {0.f, 0.f, 0.f, 0.f};
#pragma unroll
            for (int ks = 0; ks < 4; ++ks) x += *(const f32x4*)(su + ((size_t)ks * 256 + r) * DFF + c);
            ushort4 o; float t; t = fmaxf(x[0], 0.f); o.x = f2bf(t * t); t = fmaxf(x[1], 0.f); o.y = f2bf(t * t); t = fmaxf(x[2], 0.f); o.z = f2bf(t * t); t = fmaxf(x[3], 0.f); o.w = f2bf(t * t);
            *(ushort4*)(G_U + ((size_t)MP + r) * DFF + c) = o; }
    }
    SEAM(PH_RU);
    if (IN(PH_MLP2)) { pg8::Gemm g{G_U, G_Wt_2, MT, D, DFF, DFF, nullptr, nullptr}; MixOrder S; S.init(D, DFF, 16, G, bid); EpiGen<FRes2> E; E.f.X1 = G_X1; E.f.mods = G_mods; E.f.out = G_out; E.slab = SLABP(0); E.slab_n = D; E.kslice = 512;
        pg8::gemm_phase<EpiGen<FRes2>, MixOrder, false>((PG8_LAS unsigned char*)lds, g, S, E, nullptr, wave_s); }
    SEAM(PH_MLP2);
    if (IN(PH_RY)) {
        const float* sy = SLABP(0);
        for (int u = bid * NTHR + tid; u < 256 * 512; u += G * NTHR) { const int r = u >> 9, c = (u & 511) * 4; f32x4 x = {0.f, 0.f, 0.f, 0.f};
#pragma unroll
            for (int ks = 0; ks < 16; ++ks) x += *(const f32x4*)(sy + ((size_t)ks * 256 + r) * 2048 + c);
            const f32x4 xv = *(const f32x4*)(G_X1 + ((size_t)MP + r) * D + c), g2 = *(const f32x4*)(G_mods + (size_t)modrow(MP + r) * NMOD + 5 * D + c);
            *(f32x4*)(G_out + ((size_t)MP + r) * D + c) = xv + g2 * x; }
    }
#undef SLABP
#undef IN
#undef SEAM
}
#undef G_x_p
#undef G_x_s
#undef G_c_p
#undef G_c_s
#undef G_cache_cmp
#undef G_cache_sel
#undef G_cache_win
#undef G_state
#undef G_pt
#undef G_lbl
#undef G_relb
#undef G_ada_w
#undef G_ada_b
#undef G_norm1
#undef G_norm2
#undef G_w_in
#undef G_onorm
#undef G_qn_g
#undef G_ks_g
#undef G_kw_g
#undef G_w_ba
#undef G_w_bb
#undef G_w_out
#undef G_w1
#undef G_w2
#undef G_Wt_in
#undef G_Wt_ba
#undef G_Wt_bb
#undef G_Wt_out
#undef G_Wt_1
#undef G_Wt_2
#undef G_mods
#undef G_H
#undef G_proj
#undef G_winkv
#undef G_QN
#undef G_F
#undef G_oraw
#undef G_OA
#undef G_OB
#undef G_KCP
#undef G_VCP
#undef G_KCS
#undef G_VCS
#undef G_PCMP
#undef G_IDX
#undef G_OCMP
#undef G_OSEL
#undef G_OWIN
#undef G_QNb
#undef G_GATES
#undef G_KSf
#undef G_VSf
#undef G_KWf
#undef G_VWf
#undef G_KCf
#undef G_VCf
#undef G_T
#undef G_MERGED
#undef G_X1
#undef G_U
#undef G_XHC
#undef G_XHP
#undef G_Wc1t
#undef G_PREC
#undef G_PREP
#undef G_out
#undef G_ws
#undef tid
#undef lane
#undef wave
#undef sub2
#undef lt2
#undef sub4
#undef lt4


#ifndef MK_N_LAUNCHES
#define MK_N_LAUNCHES 1
#endif
extern "C" void kernel_launch(void* const* d_in, const int* in_sizes, int n_in, void* d_out, int out_size, void* d_ws, size_t ws_size, hipStream_t stream) {
    (void)in_sizes; (void)out_size;
    static int grid = 0;
    if (grid == 0) {
        if (n_in != 32 || ws_size < WS_END) { fprintf(stderr, "kernel_launch: unexpected inputs (%d) or workspace (%zu < %zu)\n", n_in, ws_size, (size_t)WS_END); grid = -1; return; }
        int dev = 0, cus = 0, per_cu = 0;
        (void)hipGetDevice(&dev); (void)hipDeviceGetAttribute(&cus, hipDeviceAttributeMultiprocessorCount, dev);
        if (hipFuncSetAttribute((const void*)mk_fwd, hipFuncAttributeMaxDynamicSharedMemorySize, LDS_BYTES) != hipSuccess) { fprintf(stderr, "kernel_launch: hipFuncSetAttribute failed\n"); grid = -1; return; }
        if (hipOccupancyMaxActiveBlocksPerMultiprocessor(&per_cu, (const void*)mk_fwd, NTHR, LDS_BYTES) != hipSuccess || per_cu < 1) { fprintf(stderr, "kernel_launch: occupancy query says %d\n", per_cu); }
        (void)hipGetLastError();
        if (cus != 256) { fprintf(stderr, "kernel_launch: built for a 256-CU device, found %d CUs\n", cus); grid = -1; return; }
        grid = 256;
    }
    if (grid < 0) return;
    (void)hipMemsetAsync((char*)d_ws + WS_BAR, 0, XCD_BAR_WORDS * 4, stream);
    Args a{};
    for (int i = 0; i < 32; ++i) a.in[i] = d_in[i];
    a.out = (float*)d_out; a.ws = (unsigned char*)d_ws;
    if (MK_N_LAUNCHES == 1) { a.ph_lo = 0; a.ph_hi = N_PHASES; hipLaunchKernelGGL(mk_fwd, dim3(grid), dim3(NTHR), LDS_BYTES, stream, a); }
    else { for (int k = 0; k < N_PHASES; ++k) { a.ph_lo = k; a.ph_hi = k + 1; hipLaunchKernelGGL(mk_fwd, dim3(grid), dim3(NTHR), LDS_BYTES, stream, a); } }
}
```
